# Optimizing an MI355X kernel written in HIP

```python
import math
import jax, jax.numpy as jnp
from jax import lax
import numpy as np

D_MODEL = 2048
BATCH = 2
SEQ = 8192
DEPTH = 2

GRID_W = 64
CTX_LEN = 256
N_EVEN = (DEPTH + 1) // 2
N_ODD = DEPTH // 2
N_MOD = 6
EPS = 1e-6

HG_WIDTH = D_MODEL // 2
HG_HEAD_DIM = 128
HG_HEADS = HG_WIDTH // HG_HEAD_DIM
HG_CHUNK = 64
S5_WIDTH = D_MODEL - HG_WIDTH
S5_GROUP = 16
S5_GROUPS = S5_WIDTH // S5_GROUP
S5_STATE = 64
EVEN_IN = 5 * HG_WIDTH + S5_WIDTH

DN_QK_HEADS = 16
DN_V_HEADS = 32
DN_HEAD_DIM = 128
DN_QK = DN_QK_HEADS * DN_HEAD_DIM
DN_V = DN_V_HEADS * DN_HEAD_DIM
DN_QKV = 2 * DN_QK + DN_V
DN_CONV = 3
DN_CHUNK = 64
ODD_IN = DN_QKV + DN_V + 4 * DN_V_HEADS

N_EXPERTS = 16
EXPERT_FF = 1024
EC_CAPACITY = 2

kernel_name = 'hybrid_hgrn2_s5_gdn_ec_moe_dit'


def rmsnorm(x, g):
    xf = x.astype(jnp.float32)
    y = xf * lax.rsqrt(jnp.mean(xf * xf, axis=-1, keepdims=True) + EPS)
    return (y * g.astype(jnp.float32)).astype(x.dtype)


def modulate(h, shift, scale):
    return h * (1 + scale) + shift


def l2norm(a):
    return a * lax.rsqrt(jnp.sum(a * a, axis=-1, keepdims=True) + EPS)


def to_bwd(a, L):
    return jnp.concatenate([jnp.flip(a[:, :L], axis=1), jnp.flip(a[:, L:], axis=1)], axis=1)


def identity(a):
    return a


def hgrn2_chunk(q, k, v, log_f):
    B, T, H, K = q.shape
    V = v.shape[-1]
    C = HG_CHUNK
    n = T // C
    blk = lambda a: jnp.moveaxis(a.reshape(B, n, C, H, a.shape[-1]), 3, 1)
    q, k, v, log_f = blk(q), blk(k), blk(v), blk(log_f)
    b = jnp.cumsum(log_f, axis=3)
    ref = b[:, :, :, C // 2 - 1:C // 2]
    att = jnp.einsum('bhntk,bhnsk->bhnts', q * jnp.exp(b - ref), k * jnp.exp(ref - b))
    att = jnp.where(jnp.tril(jnp.ones((C, C), bool)), att, 0.0)
    b_last = b[:, :, :, -1]
    kv = jnp.einsum('bhnsk,bhnsv->bhnkv', k * jnp.exp(b_last[:, :, :, None] - b), v)

    def step(S, xs):
        dec, kv_c = xs
        return S * dec[..., None] + kv_c, S

    _, s_start = lax.scan(step, jnp.zeros((B, H, K, V), jnp.float32),
                          (jnp.moveaxis(jnp.exp(b_last), 2, 0), jnp.moveaxis(kv, 2, 0)))
    s_start = jnp.moveaxis(s_start, 0, 2)
    o = (jnp.einsum('bhnts,bhnsv->bhntv', att, v)
         + jnp.einsum('bhntk,bhnkv->bhntv', q * jnp.exp(b), s_start))
    return jnp.moveaxis(o, 1, 3).reshape(B, T, H, V)


def hgrn2_mixer(p, L, lb, norm_g):
    B, T, _ = p.shape
    heads = lambda a: a.astype(jnp.float32).reshape(B, T, HG_HEADS, HG_HEAD_DIM)
    q, f_f, f_b, i, g = jnp.split(p, 5, axis=-1)
    q, i = heads(q), heads(i)

    def direction(fz, lb_d, reorder):
        lbh = lb_d.astype(jnp.float32).reshape(HG_HEADS, HG_HEAD_DIM)
        f = lbh + (1.0 - lbh) * jax.nn.sigmoid(heads(fz))
        y = hgrn2_chunk(reorder(q), reorder(1.0 - f), reorder(i), reorder(jnp.log(f)))
        return reorder(y)

    o = direction(f_f, lb[0], identity) + direction(f_b, lb[1], lambda a: to_bwd(a, L))
    o = rmsnorm(o, norm_g) * jax.nn.silu(heads(g))
    return o.reshape(B, T, HG_WIDTH).astype(p.dtype)


def s5_combine(e1, e2):
    a1, b1 = e1
    a2, b2 = e2
    return a1 * a2, a2 * b1 + b2


def s5_mixer(u, L, a_re, a_im, log_dt, b_re, b_im, c_re, c_im, d_skip, glu_w, glu_b):
    B, T, _ = u.shape
    f32 = jnp.float32
    uf = u.astype(f32).reshape(B, T, S5_GROUPS, S5_GROUP)

    def direction(dd, reorder):
        A = lax.complex(a_re[dd].astype(f32), a_im[dd].astype(f32))
        dt = jnp.exp(log_dt[dd].astype(f32))[:, None]
        A_bar = jnp.exp(A * dt)
        B_bar = ((A_bar - 1.0) / A)[..., None] * lax.complex(b_re[dd].astype(f32), b_im[dd].astype(f32))
        bu = jnp.einsum('btgc,gpc->btgp', reorder(uf).astype(jnp.complex64), B_bar)
        a_seq = jnp.broadcast_to(A_bar, (1, T, S5_GROUPS, S5_STATE))
        _, states = lax.associative_scan(s5_combine, (a_seq, bu), axis=1)
        Cm = lax.complex(c_re[dd].astype(f32), c_im[dd].astype(f32))
        y = jnp.einsum('btgp,gcp->btgc', states, Cm).real
        return reorder(y)

    y = direction(0, identity) + direction(1, lambda a: to_bwd(a, L)) + d_skip.astype(f32) * uf
    y = jax.nn.gelu(y)
    y = y * jax.nn.sigmoid(jnp.einsum('btgc,gce->btge', y, glu_w.astype(f32)) + glu_b.astype(f32))
    return y.reshape(B, T, S5_WIDTH).astype(u.dtype)


def short_conv(a, w, rows):
    B, T, Ch = a.shape
    img = a.reshape(B, rows, T // rows, Ch)
    y = lax.conv_general_dilated(img, w[:, :, None, :].astype(a.dtype), window_strides=(1, 1),
                                 padding='SAME', dimension_numbers=('NHWC', 'HWIO', 'NHWC'),
                                 feature_group_count=Ch)
    return y.reshape(B, T, Ch)


def delta_chunk(q, k, v, g, beta):
    B, T, H, K = q.shape
    V = v.shape[-1]
    C = DN_CHUNK
    n = T // C
    blk = lambda a: jnp.moveaxis(a.reshape((B, n, C, H) + a.shape[3:]), 3, 1)
    q = blk(q) * K ** -0.5
    k, v, g, beta = blk(k), blk(v), blk(g), blk(beta)
    gc = jnp.cumsum(g, axis=-1)
    incl = jnp.tril(jnp.ones((C, C), bool))
    strict = jnp.tril(jnp.ones((C, C), bool), -1)
    diff = gc[..., :, None] - gc[..., None, :]
    decay = jnp.where(incl, jnp.exp(jnp.where(incl, diff, 0.0)), 0.0)
    kb = k * beta[..., None]
    a_mat = jnp.where(strict, jnp.einsum('bhnik,bhnjk->bhnij', kb, k) * decay, 0.0)
    eye = jnp.eye(C, dtype=jnp.float32)
    t_mat = lax.linalg.triangular_solve(eye + a_mat, jnp.broadcast_to(eye, a_mat.shape),
                                        left_side=True, lower=True)
    u = t_mat @ (v * beta[..., None])
    w = t_mat @ (kb * jnp.exp(gc)[..., None])
    qk = jnp.einsum('bhnik,bhnjk->bhnij', q, k) * decay
    q_dec = q * jnp.exp(gc)[..., None]
    k_dec = k * jnp.exp(gc[..., -1:] - gc)[..., None]
    g_last = jnp.exp(gc[..., -1])

    def step(S, xs):
        u_c, w_c, qk_c, qd_c, kd_c, gl_c = xs
        v_new = u_c - jnp.einsum('bhck,bhkv->bhcv', w_c, S)
        o = jnp.einsum('bhck,bhkv->bhcv', qd_c, S) + jnp.einsum('bhcs,bhsv->bhcv', qk_c, v_new)
        S = S * gl_c[..., None, None] + jnp.einsum('bhck,bhcv->bhkv', kd_c, v_new)
        return S, o

    xs = tuple(jnp.moveaxis(a, 2, 0) for a in (u, w, qk, q_dec, k_dec, g_last))
    _, o = lax.scan(step, jnp.zeros((B, H, K, V), jnp.float32), xs)
    return jnp.transpose(o, (1, 0, 3, 2, 4)).reshape(B, T, H, V)


def deltanet_mixer(h_all, L, rows, w_in, conv_w, a_log, dt_bias, norm_g, w_out):
    f32 = jnp.float32
    p = h_all @ w_in
    B, T, _ = p.shape
    conv_in = p[..., :DN_QKV]
    qkv = jax.nn.silu(jnp.concatenate([short_conv(conv_in[:, :L], conv_w, 1),
                                       short_conv(conv_in[:, L:], conv_w, rows)], axis=1)).astype(f32)
    q, k, v = jnp.split(qkv, [DN_QK, 2 * DN_QK], axis=-1)
    Hv = DN_V_HEADS
    z, b_f, b_b, a_f, a_b = jnp.split(p[..., DN_QKV:].astype(f32),
                                      [DN_V, DN_V + Hv, DN_V + 2 * Hv, DN_V + 3 * Hv], axis=-1)
    rep = DN_V_HEADS // DN_QK_HEADS
    q = jnp.repeat(l2norm(q.reshape(B, T, DN_QK_HEADS, DN_HEAD_DIM)), rep, axis=2)
    k = jnp.repeat(l2norm(k.reshape(B, T, DN_QK_HEADS, DN_HEAD_DIM)), rep, axis=2)
    v = v.reshape(B, T, DN_V_HEADS, DN_HEAD_DIM)

    def direction(dd, b_z, a_z, reorder):
        beta = jax.nn.sigmoid(b_z)
        g = -jnp.exp(a_log[dd].astype(f32)) * jax.nn.softplus(a_z + dt_bias[dd].astype(f32))
        return reorder(delta_chunk(reorder(q), reorder(k), reorder(v), reorder(g), reorder(beta)))

    o = direction(0, b_f, a_f, identity) + direction(1, b_b, a_b, lambda a: to_bwd(a, L))
    o = rmsnorm(o, norm_g) * jax.nn.silu(z.reshape(B, T, DN_V_HEADS, DN_HEAD_DIM))
    return o.reshape(B, T, DN_V).astype(h_all.dtype) @ w_out


def ec_moe(h, router_w, w_gate, w_up, w_down):
    B, n, D = h.shape
    cap = EC_CAPACITY * n // N_EXPERTS
    aff = jax.nn.softmax(jnp.einsum('bnd,de->bne', h, router_w).astype(jnp.float32), axis=-1)
    gate, idx = lax.top_k(jnp.swapaxes(aff, 1, 2), cap)
    xs = jax.vmap(lambda hb, ib: hb[ib])(h, idx)
    hid = jax.nn.silu(jnp.einsum('becd,edf->becf', xs, w_gate)) * jnp.einsum('becd,edf->becf', xs, w_up)
    y = jnp.einsum('becf,efd->becd', hid, w_down) * gate[..., None].astype(h.dtype)
    return jax.vmap(lambda ib, yb: jnp.zeros((n, D), yb.dtype).at[ib.reshape(-1)].add(yb.reshape(-1, D)))(idx, y)


def setup_inputs(seed: int = 0) -> dict:
    key = jax.random.key(seed)
    ks = iter(jax.random.split(key, 48))
    nrm = lambda shape, scale: jax.random.normal(next(ks), shape, jnp.float32) * scale
    D, G, P, Cg = D_MODEL, S5_GROUPS, S5_STATE, S5_GROUP
    n_idx = jnp.arange(P, dtype=jnp.float32)
    return {
        'x': nrm((BATCH, SEQ, D), 1.0),
        'c': nrm((BATCH, D), 1.0),
        'ctx': nrm((BATCH, CTX_LEN, D), 1.0),
        'c_ctx': nrm((D,), 1.0),
        'mod_w': nrm((DEPTH, D, N_MOD * D), 0.5 * D ** -0.5),
        'mod_b': nrm((DEPTH, N_MOD * D), 0.02),
        'norm_g': 1.0 + nrm((DEPTH, 4, D), 0.02),
        'ev_w_in': nrm((N_EVEN, D, EVEN_IN), D ** -0.5),
        'ev_w_out': nrm((N_EVEN, HG_WIDTH + S5_WIDTH, D), (HG_WIDTH + S5_WIDTH) ** -0.5),
        'hg_lb': 1.0 + nrm((N_EVEN + 1, 2, HG_WIDTH), 0.1),
        'hg_norm_g': 1.0 + nrm((N_EVEN, HG_HEAD_DIM), 0.02),
        's5_a_re': -0.5 + nrm((N_EVEN, 2, G, P), 0.01),
        's5_a_im': math.pi * n_idx + nrm((N_EVEN, 2, G, P), 0.01),
        's5_log_dt': jax.random.uniform(next(ks), (N_EVEN, 2, G), jnp.float32, math.log(1e-3), math.log(1e-1)),
        's5_b_re': nrm((N_EVEN, 2, G, P, Cg), (2 * Cg) ** -0.5),
        's5_b_im': nrm((N_EVEN, 2, G, P, Cg), (2 * Cg) ** -0.5),
        's5_c_re': nrm((N_EVEN, 2, G, Cg, P), (2 * P) ** -0.5),
        's5_c_im': nrm((N_EVEN, 2, G, Cg, P), (2 * P) ** -0.5),
        's5_d': nrm((N_EVEN, G, Cg), 1.0),
        's5_glu_w': nrm((N_EVEN, G, Cg, Cg), Cg ** -0.5),
        's5_glu_b': nrm((N_EVEN, G, Cg), 0.02),
        'od_w_in': nrm((N_ODD, D, ODD_IN), D ** -0.5),
        'od_conv_w': nrm((N_ODD, DN_CONV, DN_CONV, DN_QKV), 1.0 / DN_CONV),
        'od_a_log': jnp.log(jax.random.uniform(next(ks), (N_ODD, 2, DN_V_HEADS), jnp.float32, 1.0, 16.0)),
        'od_dt_bias': 1.0 + nrm((N_ODD, 2, DN_V_HEADS), 0.1),
        'od_norm_g': 1.0 + nrm((N_ODD, DN_HEAD_DIM), 0.02),
        'od_w_out': nrm((N_ODD, DN_V, D), DN_V ** -0.5),
        'router_w': nrm((DEPTH, D, N_EXPERTS), D ** -0.5),
        'moe_w_gate': nrm((DEPTH, N_EXPERTS, D, EXPERT_FF), D ** -0.5),
        'moe_w_up': nrm((DEPTH, N_EXPERTS, D, EXPERT_FF), D ** -0.5),
        'moe_w_down': nrm((DEPTH, N_EXPERTS, EXPERT_FF, D), EXPERT_FF ** -0.5),
    }


def reference(x, c, ctx, c_ctx, mod_w, mod_b, norm_g, ev_w_in, ev_w_out, hg_lb, hg_norm_g,
              s5_a_re, s5_a_im, s5_log_dt, s5_b_re, s5_b_im, s5_c_re, s5_c_im, s5_d, s5_glu_w, s5_glu_b,
              od_w_in, od_conv_w, od_a_log, od_dt_bias, od_norm_g, od_w_out,
              router_w, moe_w_gate, moe_w_up, moe_w_down):
    L = ctx.shape[1]
    N = x.shape[1]
    rows = N // GRID_W
    lb_all = jnp.cumsum(jax.nn.softmax(hg_lb.astype(jnp.float32), axis=0), axis=0)
    sc = jax.nn.silu(c)
    scc = jax.nn.silu(c_ctx)
    for layer in range(DEPTH):
        last = layer == DEPTH - 1
        j = layer // 2
        m_lat = jnp.split((sc @ mod_w[layer] + mod_b[layer])[:, None, :], N_MOD, axis=-1)
        m_ctx = jnp.split(scc @ mod_w[layer] + mod_b[layer], N_MOD, axis=-1)
        g_pre_mix, g_post_mix, g_pre_ffn, g_post_ffn = norm_g[layer]
        h_all = jnp.concatenate([modulate(rmsnorm(ctx, g_pre_mix), m_ctx[0], m_ctx[1]),
                                 modulate(rmsnorm(x, g_pre_mix), m_lat[0], m_lat[1])], axis=1)
        if layer % 2 == 0:
            p = h_all @ ev_w_in[j]
            o_hg = hgrn2_mixer(p[..., :5 * HG_WIDTH], L, lb_all[j], hg_norm_g[j])
            o_s5 = s5_mixer(p[..., 5 * HG_WIDTH:], L, s5_a_re[j], s5_a_im[j], s5_log_dt[j], s5_b_re[j],
                            s5_b_im[j], s5_c_re[j], s5_c_im[j], s5_d[j], s5_glu_w[j], s5_glu_b[j])
            o = jnp.concatenate([o_hg, o_s5], axis=-1) @ ev_w_out[j]
        else:
            o = deltanet_mixer(h_all, L, rows, od_w_in[j], od_conv_w[j], od_a_log[j], od_dt_bias[j],
                               od_norm_g[j], od_w_out[j])
        o = rmsnorm(o, g_post_mix)
        x = x + m_lat[2] * o[:, L:]
        if not last:
            ctx = ctx + m_ctx[2] * o[:, :L]
        h = modulate(rmsnorm(x, g_pre_ffn), m_lat[3], m_lat[4])
        x = x + m_lat[5] * rmsnorm(ec_moe(h, router_w[layer], moe_w_gate[layer], moe_w_up[layer], moe_w_down[layer]), g_post_ffn)
        if not last:
            hc = modulate(rmsnorm(ctx, g_pre_ffn), m_ctx[3], m_ctx[4])
            ctx = ctx + m_ctx[5] * rmsnorm(ec_moe(hc, router_w[layer], moe_w_gate[layer], moe_w_up[layer], moe_w_down[layer]), g_post_ffn)
    return x
```

```cpp
#include <hip/hip_runtime.h>
#include <cstdio>
#include <cstdint>
#define DI __device__ __forceinline__
#define LAS __attribute__((address_space(3)))
typedef unsigned short bf16_t;
typedef short bf16x8 __attribute__((ext_vector_type(8)));
typedef float f32x4 __attribute__((ext_vector_type(4)));
typedef float f32x2 __attribute__((ext_vector_type(2)));
typedef unsigned u32x4 __attribute__((ext_vector_type(4)));
typedef unsigned u32x2 __attribute__((ext_vector_type(2)));
typedef __bf16 bfx2 __attribute__((ext_vector_type(2)));
typedef short s16x4 __attribute__((ext_vector_type(4)));

DI unsigned pk2(float lo, float hi) { f32x2 v = {lo, hi}; bfx2 b = __builtin_convertvector(v, bfx2); return __builtin_bit_cast(unsigned, b); }
DI bf16_t f2bf(float f) { return (bf16_t)(pk2(f, 0.f) & 0xffffu); }
DI unsigned cvt4_fp8(float a, float b, float c, float d) { int w = 0; w = __builtin_amdgcn_cvt_pk_fp8_f32(a, b, w, false); w = __builtin_amdgcn_cvt_pk_fp8_f32(c, d, w, true); return (unsigned)w; }
DI float bf2f(unsigned h) { return __uint_as_float(h << 16); }
DI float bflo(unsigned w) { return __uint_as_float(w << 16); }
DI float bfhi(unsigned w) { return __uint_as_float(w & 0xffff0000u); }
DI float rcpf_(float x) { return __builtin_amdgcn_rcpf(x); }
DI float sigmoidf_(float x) { return rcpf_(1.0f + __expf(-x)); }
DI float siluf_(float x) { return x * rcpf_(1.0f + __expf(-x)); }
template <int CTRL> DI float dppf(float x) { return __builtin_bit_cast(float, __builtin_amdgcn_mov_dpp(__builtin_bit_cast(int, x), CTRL, 0xf, 0xf, true)); }
DI float xor1f(float x) { return dppf<0xB1>(x); }
DI float xor2f(float x) { return dppf<0x4E>(x); }
DI float row8_sum(float x) { x += dppf<0xB1>(x); x += dppf<0x4E>(x); x += dppf<0x141>(x); return x; }
DI float row16_sum(float x) { x = row8_sum(x); x += dppf<0x128>(x); return x; }
DI float row16_max(float x) { x = fmaxf(x, dppf<0xB1>(x)); x = fmaxf(x, dppf<0x4E>(x)); x = fmaxf(x, dppf<0x141>(x)); x = fmaxf(x, dppf<0x128>(x)); return x; }
DI float wave_sum(float v) {
    v = row16_sum(v);
    const auto s = __builtin_amdgcn_permlane16_swap(__builtin_bit_cast(unsigned, v), __builtin_bit_cast(unsigned, v), false, false);
    v = __builtin_bit_cast(float, (unsigned)s[0]) + __builtin_bit_cast(float, (unsigned)s[1]);
    const auto t = __builtin_amdgcn_permlane32_swap(__builtin_bit_cast(unsigned, v), __builtin_bit_cast(unsigned, v), false, false);
    return __builtin_bit_cast(float, (unsigned)t[0]) + __builtin_bit_cast(float, (unsigned)t[1]);
}
DI f32x4 mfma16(bf16x8 a, bf16x8 b, f32x4 c) { return __builtin_amdgcn_mfma_f32_16x16x32_bf16(a, b, c, 0, 0, 0); }
DI bf16x8 lds_frag(const LAS bf16_t* base, int ld, int row0, int k0, int lane) { return *(const LAS bf16x8*)(base + (row0 + (lane & 15)) * ld + k0 + 8 * (lane >> 4)); }

constexpr int NB = 2, NLAT = 8192, LCTX = 256, TT = NLAT + LCTX, RR = NB * TT, DM = 2048;
constexpr int NMOD = 6;
constexpr int HGW = 1024, HGH = 8, EVIN = 6144;
constexpr int S5G = 64, S5P = 64, S5C = 16, S5CS = 16, S5NCH = TT / S5CS  , S5NCTX = LCTX / S5CS  ;
constexpr int DNQK = 2048, DNV = 4096, DNQKV = 8192, ODIN = 12416, ODIN_PAD = 12544, DNHV = 32;
constexpr int NEXP = 16, EFF = 1024, CAPL = 1024, CAPC = 32;
constexpr int NCHUNK = TT / 64;
constexpr float EPS = 1e-6f;
constexpr float W8_GU = 64.0f, W8_DN = 32.0f;

constexpr size_t MiB = 1u << 20;
constexpr size_t WS_CTL = 0, CTL_ZERO_BYTES = 1 * MiB;
constexpr size_t WS_MODV = 1 * MiB;
constexpr size_t WS_LB = 2 * MiB;
constexpr size_t WS_S5A16 = 2 * MiB + 65536;
constexpr size_t WS_CTXW = 8 * MiB;
constexpr size_t WS_S5WY = 12 * MiB;
constexpr size_t WS_S5WX = 28 * MiB;
constexpr int OD8_MODE = 3;
constexpr int ODA_N = OD8_MODE == 1 ? 4352 : (OD8_MODE == 2 ? 2304 : 256), ODB_N = OD8_MODE == 1 ? 8192 : (OD8_MODE == 2 ? 10240 : 12288);
constexpr size_t WS_WODIN = 36 * MiB;
constexpr size_t WS_WODIN8 = 56 * MiB;
constexpr size_t WS_WODOUT = 85 * MiB;
constexpr size_t WS_HA = 101 * MiB;
constexpr size_t WS_AFF = 167 * MiB;
constexpr size_t WS_AFFC = 168 * MiB;
constexpr size_t WS_GATEV = 168 * MiB + 65536;
constexpr size_t WS_IDX = 168 * MiB + 524288;
constexpr size_t WS_SLOT = 169 * MiB;
constexpr size_t WS_VOFF = 171 * MiB;
constexpr size_t WS_W0 = 176 * MiB;
constexpr size_t WS_WEVIN = WS_W0;
constexpr size_t WS_WEVOUT = WS_W0 + 24 * MiB;
constexpr size_t WS_WGU = WS_W0 + 32 * MiB;
constexpr size_t WS_WDN = WS_W0 + 160 * MiB;
constexpr size_t WS_WGU1 = 1123 * MiB;
constexpr size_t WS_WDN1 = 1187 * MiB;
constexpr size_t WS_ACT = 400 * MiB;
constexpr size_t WS_P0 = WS_ACT;
constexpr size_t WS_MIX = WS_ACT;
constexpr size_t WS_OCAT0 = 598 * MiB;
constexpr size_t WS_KVT = 664 * MiB;
constexpr size_t WS_SST = 796 * MiB;
constexpr size_t WS_DEC = 928 * MiB;
constexpr size_t WS_REFX = 1030 * MiB;
constexpr size_t WS_XL = 931 * MiB;
constexpr size_t WS_X0 = 997 * MiB;
constexpr size_t WS_XS = WS_ACT;
constexpr size_t WS_HA8 = 508 * MiB;
constexpr size_t WS_HID = 544 * MiB;
constexpr size_t WS_Y = 616 * MiB;
constexpr size_t WS_TM = 176 * MiB;
constexpr size_t WS_HA8B = WS_TM;
constexpr size_t WS_QKM = 308 * MiB;
constexpr size_t WS_PQ = 440 * MiB;
constexpr size_t WS_ODIR = WS_PQ;
constexpr size_t WS_MIX1 = WS_PQ;
constexpr size_t WS_PZ = 704 * MiB;
constexpr size_t WS_GATES = 836 * MiB;
constexpr size_t WS_G2 = 845 * MiB;
constexpr size_t WS_GC = 854 * MiB;
constexpr size_t WS_QKVC = 859 * MiB;
constexpr size_t WS_OCAT1 = WS_QKVC;
constexpr size_t WS_END = 1219 * MiB;
constexpr int MOE_ROWS = 32 * 1024 + 16 * 256;
constexpr int LDS_BYTES = 147456;
constexpr int LDS_MISC = LDS_BYTES - 16;
namespace pg8 {
#define PG8_LAS __attribute__((address_space(3)))
typedef unsigned short bf16_t;
typedef short bf16x8 __attribute__((ext_vector_type(8)));
typedef float f32x4 __attribute__((ext_vector_type(4)));
typedef unsigned u32x4 __attribute__((ext_vector_type(4)));
typedef int i32x8 __attribute__((ext_vector_type(8)));
constexpr int BM = 256, BK = 64, HALF = 128, HTB = HALF * BK * 2  , STAGE_BYTES = 8 * HTB, NXCD = 8, WGM = 8;

__host__ __device__ __forceinline__ int lds_byte(int r, int c) { const int st = (r >> 4) * 2 + (c >> 5), rr = r & 15, cc = c & 31, ob = rr * 64 + cc * 2; return st * 1024 + (ob ^ (((ob >> 9) & 1) << 5)); }
__host__ __device__ __forceinline__ void stage_rc(int b, int& R, int& C) { const int st = b / 1024, sb = b % 1024, swz = sb ^ (((sb >> 9) & 1) << 5); R = (st >> 1) * 16 + swz / 64; C = (st & 1) * 32 + (swz % 64) / 2; }
__host__ __device__ __forceinline__ int perm32(int rho) { const int n = rho >> 4, i = rho & 15; return 8 * (i >> 2) + 4 * n + (i & 3); }

struct Unit { int pm, pn; };
struct Gemm { const bf16_t* A; const bf16_t* Bt; int M, N, K; };

struct StaticOrder {
    int nM, nN, nwg, G, c;
    __host__ __device__ void init(int M, int N, int G_, int c_) { nM = M / BM; nN = N / BM; nwg = nM * nN; G = G_; c = c_; }
    __host__ __device__ bool next(int i, Unit& u) const { return unit_of((long)i * G + c, u); }
    __host__ __device__ bool unit_of(long L, Unit& u) const {
        if (L >= nwg) return false;
        int wgid = (int)L; { const int q = nwg / NXCD, r = nwg % NXCD, xcd = wgid % NXCD, off = wgid / NXCD; wgid = (xcd < r ? xcd * (q + 1) : r * (q + 1) + (xcd - r) * q) + off; }
        const int nig = WGM * nN, gid = wgid / nig, fm = gid * WGM, gsz = (nM - fm) < WGM ? (nM - fm) : WGM;
        u.pm = fm + ((wgid % nig) % gsz); u.pn = (wgid % nig) / gsz; return true;
    }
    __device__ __forceinline__ void a_ready(const Unit&) const {}
    __device__ __forceinline__ void done(const Unit&) const {}
};

struct HeldOrder : StaticOrder {
    int nheld, r0;
    __host__ __device__ bool next(int i, Unit& u) const {
        if (i < r0) return unit_of((long)i * G + c, u);
        if (c >= G - nheld) return false;
        return unit_of((long)r0 * G + (long)(i - r0) * (G - nheld) + c, u); }
};
__device__ __forceinline__ unsigned cvt_pk_bf16(float lo, float hi) { unsigned r; asm volatile("v_cvt_pk_bf16_f32 %0, %1, %2" : "=v"(r) : "v"(lo), "v"(hi)); return r; }
template <class Epi, class Sched, bool GATHER = false, bool FP8 = false, bool ALIGN_EPI = true, bool SP2 = true>
__device__ __forceinline__ void gemm_phase(PG8_LAS unsigned char* lds, const Gemm g, const Sched& S, const Epi& E) {
    const int tid = threadIdx.x, wid = __builtin_amdgcn_readfirstlane(tid >> 6), lane = tid & 63, wr = wid >> 2, wc = wid & 3, fr = lane & 15, fq = lane >> 4;
    const int K = g.K, nt = K / BK;
    unsigned voffA[2], voffB[2];
#pragma unroll
    for (int i = 0; i < 2; ++i) { int R, C; stage_rc(tid * 16 + i * 8192, R, C); const int Rb = Epi::PERM ? ((R & ~31) + perm32(R & 31)) : R;
        voffA[i] = (unsigned)(R * K + C) * 2u; voffB[i] = (unsigned)(Rb * K + C) * 2u; }
    const size_t kstep = (size_t)(BK * 2);
    const size_t hstep = (size_t)HALF * K * 2;
    const size_t tstep = 2 * hstep;
    const unsigned ldsw = (unsigned)wid * 1024u;
    const int aoff = lds_byte(wr * 64 + fr, fq * 8), boff = lds_byte(wc * 32 + fr, fq * 8);
#define PG8_SA(b, h) (((b) * 2 + (h)) * HTB)
#define PG8_SB(b, h) ((4 + (b) * 2 + (h)) * HTB)
#define PG8_STAGE(bufoff, gbase, voff) do { _Pragma("unroll") for (int _i = 0; _i < 2; ++_i) \
        __builtin_amdgcn_global_load_lds((const unsigned*)((const char*)(gbase) + (voff)[_i]), (PG8_LAS unsigned*)(lds + (bufoff) + ldsw + _i * 8192), 16, 0, 0); } while (0)
#define PG8_LDA(dst, b, h) do { _Pragma("unroll") for (int m = 0; m < 4; ++m) _Pragma("unroll") for (int k = 0; k < 2; ++k) dst[m][k] = *(const PG8_LAS bf16x8*)(lds + PG8_SA(b, h) + aoff + m * 2048 + k * 1024); } while (0)
#define PG8_LDB(dst, b, h) do { _Pragma("unroll") for (int n = 0; n < 2; ++n) _Pragma("unroll") for (int k = 0; k < 2; ++k) dst[n][k] = *(const PG8_LAS bf16x8*)(lds + PG8_SB(b, h) + boff + n * 2048 + k * 1024); } while (0)
#define PG8_MMA(ai, bj, At, Bt) do { __builtin_amdgcn_s_setprio(1); if constexpr (FP8) { _Pragma("unroll") for (int m = 0; m < 4; ++m) _Pragma("unroll") for (int n = 0; n < 2; ++n) { \
            typedef int i32x4_ __attribute__((ext_vector_type(4))); \
            const i32x8 bb_ = __builtin_shufflevector(__builtin_bit_cast(i32x4_, Bt[n][0]), __builtin_bit_cast(i32x4_, Bt[n][1]), 0, 1, 2, 3, 4, 5, 6, 7), aa_ = __builtin_shufflevector(__builtin_bit_cast(i32x4_, At[m][0]), __builtin_bit_cast(i32x4_, At[m][1]), 0, 1, 2, 3, 4, 5, 6, 7); \
            asm volatile("v_mfma_scale_f32_16x16x128_f8f6f4 %0, %1, %2, %0, %3, %3 op_sel_hi:[0,0,0]" : "+v"(acc[ai][bj][m][n]) : "v"(bb_), "v"(aa_), "v"(scl8)); } } \
        else { _Pragma("unroll") for (int m = 0; m < 4; ++m) _Pragma("unroll") for (int n = 0; n < 2; ++n) _Pragma("unroll") for (int k = 0; k < 2; ++k) \
        acc[ai][bj][m][n] = __builtin_amdgcn_mfma_f32_16x16x32_bf16(Bt[n][k], At[m][k], acc[ai][bj][m][n], 0, 0, 0); } __builtin_amdgcn_s_setprio(0); } while (0)
#define PG8_WAIT_V(n) asm volatile("s_waitcnt vmcnt(" #n ")" ::: "memory")
#define PG8_WAIT_L(n) asm volatile("s_waitcnt lgkmcnt(" #n ")" ::: "memory")
#define PG8_BAR __builtin_amdgcn_s_barrier()
#define PG8_SCHED __builtin_amdgcn_sched_barrier(0)
    const int scl8 = 0x7f7f7f7f;
    Unit cur, nxt; int ui = 0;
    if (!S.next(0, cur)) return;
    f32x4 acc[2][2][4][2];
#pragma unroll
    for (int a = 0; a < 2; ++a)
#pragma unroll
        for (int b = 0; b < 2; ++b)
#pragma unroll
            for (int m = 0; m < 4; ++m)
#pragma unroll
                for (int n = 0; n < 2; ++n) acc[a][b][m][n] = (f32x4){0.f, 0.f, 0.f, 0.f};
    bf16x8 At[4][2], B0[2][2], B1[2][2];
    const char* cA = GATHER ? (const char*)g.A : (const char*)g.A + (size_t)cur.pm * tstep; const char* cB = (const char*)g.Bt + (size_t)cur.pn * tstep;
    const size_t hstepA = GATHER ? 0 : hstep;
    unsigned cv0[2], cv1[2], nv0[2], nv1[2];
    if constexpr (GATHER) { const u32x4 vv = S.voff(cur); cv0[0] = vv.x; cv0[1] = vv.y; cv1[0] = vv.z; cv1[1] = vv.w; } else { cv0[0] = cv1[0] = voffA[0]; cv0[1] = cv1[1] = voffA[1]; }
    nv0[0] = cv0[0]; nv0[1] = cv0[1]; nv1[0] = cv1[0]; nv1[1] = cv1[1];
    S.a_ready(cur);
    if constexpr (SP2) {
        PG8_STAGE(PG8_SB(0, 0), cB, voffB); PG8_STAGE(PG8_SB(0, 1), cB + hstep, voffB); PG8_STAGE(PG8_SA(0, 0), cA, cv0); PG8_STAGE(PG8_SA(0, 1), cA + hstepA, cv1);
        if (wr == 1) PG8_BAR;
        PG8_WAIT_V(2); PG8_BAR;
        PG8_STAGE(PG8_SB(1, 0), cB + kstep, voffB); PG8_STAGE(PG8_SA(1, 0), cA + kstep, cv0); PG8_STAGE(PG8_SB(1, 1), cB + hstep + kstep, voffB);
        PG8_WAIT_V(6); PG8_BAR;
    } else {
        PG8_STAGE(PG8_SB(0, 0), cB, voffB); PG8_STAGE(PG8_SA(0, 0), cA, cv0); PG8_STAGE(PG8_SB(0, 1), cB + hstep, voffB); PG8_STAGE(PG8_SA(0, 1), cA + hstepA, cv1);
        if (wr == 1) PG8_BAR;
        PG8_WAIT_V(4); PG8_BAR;
        PG8_STAGE(PG8_SB(1, 0), cB + kstep, voffB); PG8_STAGE(PG8_SA(1, 0), cA + kstep, cv0); PG8_STAGE(PG8_SB(1, 1), cB + hstep + kstep, voffB);
        PG8_WAIT_V(6); PG8_BAR;
    }
    for (;;) {
        const bool has_next = S.next(ui + 1, nxt);
        if constexpr (GATHER) { if (has_next) { const u32x4 vv = S.voff(nxt); nv0[0] = vv.x; nv0[1] = vv.y; nv1[0] = vv.z; nv1[1] = vv.w; } }
        const char* nA = GATHER ? cA : (has_next ? (const char*)g.A + (size_t)nxt.pm * tstep : cA); const char* nB = has_next ? (const char*)g.Bt + (size_t)nxt.pn * tstep : cB;
#pragma unroll 1
        for (int t = 0; t < nt; t += 2) {
            const bool last = (t == nt - 2);
            const char* a1 = cA + (size_t)(t + 1) * kstep;
            const char* a2 = last ? nA : cA + (size_t)(t + 2) * kstep; const char* b2 = last ? nB : cB + (size_t)(t + 2) * kstep;
            const char* a3 = a2 + kstep; const char* b3 = b2 + kstep;
            unsigned sv0[2], sv1[2];
            sv0[0] = last ? nv0[0] : cv0[0]; sv0[1] = last ? nv0[1] : cv0[1]; sv1[0] = last ? nv1[0] : cv1[0]; sv1[1] = last ? nv1[1] : cv1[1];
            if (last && has_next) S.a_ready(nxt);
            if constexpr (SP2) {
            PG8_LDB(B0, 0, 0); PG8_LDB(B1, 0, 1); PG8_SCHED; PG8_LDA(At, 0, 0); PG8_STAGE(PG8_SA(1, 1), a1 + hstepA, cv1);
            PG8_WAIT_V(8); PG8_WAIT_L(0); PG8_BAR; PG8_MMA(0, 0, At, B0); PG8_MMA(0, 1, At, B1); PG8_BAR; PG8_SCHED;
            PG8_LDA(At, 0, 1); PG8_STAGE(PG8_SB(0, 0), b2, voffB); PG8_STAGE(PG8_SB(0, 1), b2 + hstep, voffB); PG8_STAGE(PG8_SA(0, 0), a2, sv0);
            PG8_WAIT_V(8); PG8_WAIT_L(0); PG8_BAR; PG8_MMA(1, 0, At, B0); PG8_MMA(1, 1, At, B1); PG8_BAR; PG8_SCHED;
            PG8_LDB(B0, 1, 0); PG8_LDB(B1, 1, 1); PG8_SCHED; PG8_LDA(At, 1, 0); PG8_STAGE(PG8_SA(0, 1), a2 + hstepA, sv1);
            PG8_WAIT_V(8); PG8_WAIT_L(0); PG8_BAR; PG8_MMA(0, 0, At, B0); PG8_MMA(0, 1, At, B1); PG8_BAR; PG8_SCHED;
            PG8_LDA(At, 1, 1); PG8_STAGE(PG8_SB(1, 0), b3, voffB); PG8_STAGE(PG8_SB(1, 1), b3 + hstep, voffB); PG8_STAGE(PG8_SA(1, 0), a3, sv0);
            PG8_WAIT_V(8); PG8_WAIT_L(0); PG8_BAR; PG8_MMA(1, 0, At, B0); PG8_MMA(1, 1, At, B1); PG8_BAR; PG8_SCHED;
            } else {
            PG8_LDB(B0, 0, 0); PG8_SCHED; PG8_LDA(At, 0, 0); PG8_STAGE(PG8_SA(1, 1), a1 + hstepA, cv1);
            PG8_WAIT_L(8); PG8_BAR; PG8_WAIT_L(0); PG8_MMA(0, 0, At, B0); PG8_BAR; PG8_SCHED;
            PG8_LDB(B1, 0, 1); PG8_STAGE(PG8_SB(0, 0), b2, voffB);
            PG8_BAR; PG8_WAIT_L(0); PG8_MMA(0, 1, At, B1); PG8_BAR;
            PG8_LDA(At, 0, 1); PG8_STAGE(PG8_SA(0, 0), a2, sv0);
            PG8_BAR; PG8_WAIT_L(0); PG8_MMA(1, 0, At, B0); PG8_BAR; PG8_SCHED;
            PG8_STAGE(PG8_SB(0, 1), b2 + hstep, voffB);
            PG8_WAIT_V(6); PG8_BAR; PG8_MMA(1, 1, At, B1); PG8_BAR;
            PG8_LDB(B0, 1, 0); PG8_SCHED; PG8_LDA(At, 1, 0); PG8_STAGE(PG8_SA(0, 1), a2 + hstepA, sv1);
            PG8_WAIT_L(8); PG8_BAR; PG8_WAIT_L(0); PG8_MMA(0, 0, At, B0); PG8_BAR; PG8_SCHED;
            PG8_LDB(B1, 1, 1); PG8_STAGE(PG8_SB(1, 0), b3, voffB);
            PG8_BAR; PG8_WAIT_L(0); PG8_MMA(0, 1, At, B1); PG8_BAR;
            PG8_LDA(At, 1, 1); PG8_STAGE(PG8_SA(1, 0), a3, sv0);
            PG8_BAR; PG8_WAIT_L(0); PG8_MMA(1, 0, At, B0); PG8_BAR; PG8_SCHED;
            PG8_STAGE(PG8_SB(1, 1), b3 + hstep, voffB);
            PG8_WAIT_V(6); PG8_BAR; PG8_MMA(1, 1, At, B1); PG8_BAR;
                    }
        }
        if constexpr (FP8) asm volatile("s_nop 15\n\ts_nop 15\n\ts_nop 7" ::: "memory");
        if constexpr (ALIGN_EPI) { if (wr == 0) PG8_BAR; }
        if constexpr (!Epi::AFTER_DRAIN) { E(acc, cur, wr, wc, fr, fq); S.done(cur); }
        if (!has_next) break;
#pragma unroll
        for (int a = 0; a < 2; ++a)
#pragma unroll
            for (int b = 0; b < 2; ++b)
#pragma unroll
                for (int m = 0; m < 4; ++m)
#pragma unroll
                    for (int n = 0; n < 2; ++n) acc[a][b][m][n] = (f32x4){0.f, 0.f, 0.f, 0.f};
        cur = nxt; cA = nA; cB = nB; ++ui; cv0[0] = nv0[0]; cv0[1] = nv0[1]; cv1[0] = nv1[0]; cv1[1] = nv1[1];
        if constexpr (ALIGN_EPI) { if (wr == 1) PG8_BAR; }
    }
    PG8_WAIT_V(0);
    if constexpr (!ALIGN_EPI) { if (wr == 0) PG8_BAR; }
    PG8_BAR;
    if constexpr (Epi::AFTER_DRAIN) { E.fused(acc, cur, wr, wc, fr, fq, lds, wid, lane); S.done(cur); }
#undef PG8_SA
#undef PG8_SB
#undef PG8_STAGE
#undef PG8_LDA
#undef PG8_LDB
#undef PG8_MMA
#undef PG8_WAIT_V
#undef PG8_WAIT_L
#undef PG8_BAR
#undef PG8_SCHED
}
}

namespace pg8 {
struct EpiBf {
    static constexpr bool PERM = true, AFTER_DRAIN = false;
    bf16_t* O; int ldc; float sc;
    __device__ __forceinline__ void operator()(const f32x4 (&acc)[2][2][4][2], const Unit& u, int wr, int wc, int fr, int fq) const {
        const int row0 = u.pm * BM + wr * 64 + fr, col0 = u.pn * BM + wc * 32 + 8 * fq;
#pragma unroll
        for (int ai = 0; ai < 2; ++ai)
#pragma unroll
            for (int m = 0; m < 4; ++m) { bf16_t* rowp = O + (size_t)(row0 + ai * HALF + m * 16) * ldc + col0;
#pragma unroll
                for (int bj = 0; bj < 2; ++bj) { const f32x4 v0 = acc[ai][bj][m][0] * sc, v1 = acc[ai][bj][m][1] * sc;
                    u32x4 w; w.x = cvt_pk_bf16(v0[0], v0[1]); w.y = cvt_pk_bf16(v0[2], v0[3]); w.z = cvt_pk_bf16(v1[0], v1[1]); w.w = cvt_pk_bf16(v1[2], v1[3]);
                    *(u32x4*)(rowp + bj * HALF) = w; } }
    }
};
struct EpiF32 {
    static constexpr bool PERM = false, AFTER_DRAIN = false;
    float* C; int ldc;
    __device__ __forceinline__ void operator()(const f32x4 (&acc)[2][2][4][2], const Unit& u, int wr, int wc, int fr, int fq) const {
        const int row0 = u.pm * BM + wr * 64 + fr, col0 = u.pn * BM + wc * 32 + 4 * fq;
#pragma unroll
        for (int ai = 0; ai < 2; ++ai)
#pragma unroll
            for (int m = 0; m < 4; ++m) { float* rowp = C + (size_t)(row0 + ai * HALF + m * 16) * ldc + col0;
#pragma unroll
                for (int bj = 0; bj < 2; ++bj)
#pragma unroll
                    for (int n = 0; n < 2; ++n) *(f32x4*)(rowp + bj * HALF + n * 16) = acc[ai][bj][m][n]; }
    }
};
struct EpiOdA {
    static constexpr bool PERM = true, AFTER_DRAIN = false;
    bf16_t* PQ; float* GATES;
    __device__ __forceinline__ void operator()(const f32x4 (&acc)[2][2][4][2], const Unit& u, int wr, int wc, int fr, int fq) const {
        const int row0 = u.pm * BM + wr * 64 + fr;
        if (u.pn < ODA_N / 256 - 1) {
            const int col0 = (OD8_MODE == 2 ? 2048 : 0) + u.pn * BM + wc * 32 + 8 * fq;
#pragma unroll
            for (int ai = 0; ai < 2; ++ai)
#pragma unroll
                for (int m = 0; m < 4; ++m) { bf16_t* rowp = PQ + (size_t)(row0 + ai * HALF + m * 16) * 8192 + col0;
#pragma unroll
                    for (int bj = 0; bj < 2; ++bj) { const f32x4 v0 = acc[ai][bj][m][0], v1 = acc[ai][bj][m][1];
                        u32x4 w; w.x = cvt_pk_bf16(v0[0], v0[1]); w.y = cvt_pk_bf16(v0[2], v0[3]); w.z = cvt_pk_bf16(v1[0], v1[1]); w.w = cvt_pk_bf16(v1[2], v1[3]);
                        *(u32x4*)(rowp + bj * HALF) = w; } }
        } else {
            const int col0 = wc * 32 + 8 * fq;
#pragma unroll
            for (int ai = 0; ai < 2; ++ai)
#pragma unroll
                for (int m = 0; m < 4; ++m) { float* rowp = GATES + (size_t)(row0 + ai * HALF + m * 16) * 128 + col0;
                    *(f32x4*)(rowp) = acc[ai][0][m][0]; *(f32x4*)(rowp + 4) = acc[ai][0][m][1]; }
        }
    }
};
struct EpiOdB {
    static constexpr bool PERM = true, AFTER_DRAIN = false;
    bf16_t* PQ; bf16_t* PZ; float sc;
    __device__ __forceinline__ void operator()(const f32x4 (&acc)[2][2][4][2], const Unit& u, int wr, int wc, int fr, int fq) const {
        const int row0 = u.pm * BM + wr * 64 + fr;
        constexpr int NQK = OD8_MODE == 1 ? 0 : (OD8_MODE == 2 ? 8 : 16);
        bf16_t* base; int ldc, colt;
        if (u.pn < NQK) { base = PQ; ldc = 8192; colt = u.pn * BM; }
        else if (u.pn < NQK + 16) { base = PQ; ldc = 8192; colt = 4096 + (u.pn - NQK) * BM; }
        else { base = PZ; ldc = 4096; colt = (u.pn - NQK - 16) * BM; }
        const int col0 = colt + wc * 32 + 8 * fq;
#pragma unroll
        for (int ai = 0; ai < 2; ++ai)
#pragma unroll
            for (int m = 0; m < 4; ++m) { bf16_t* rowp = base + (size_t)(row0 + ai * HALF + m * 16) * ldc + col0;
#pragma unroll
                for (int bj = 0; bj < 2; ++bj) { const f32x4 v0 = acc[ai][bj][m][0] * sc, v1 = acc[ai][bj][m][1] * sc;
                    u32x4 w; w.x = cvt_pk_bf16(v0[0], v0[1]); w.y = cvt_pk_bf16(v0[2], v0[3]); w.z = cvt_pk_bf16(v1[0], v1[1]); w.w = cvt_pk_bf16(v1[2], v1[3]);
                    *(u32x4*)(rowp + bj * HALF) = w; } }
    }
};
struct EpiSwiGlu {
    static constexpr bool PERM = true, AFTER_DRAIN = false;
    unsigned char* H; float inv;
    __device__ __forceinline__ void operator()(const f32x4 (&acc)[2][2][4][2], const Unit& u, int wr, int wc, int fr, int fq) const {
        const int row0 = u.pm * BM + wr * 64 + fr, col0 = (u.pn & 7) * HALF + wc * 32 + 8 * fq;
#pragma unroll
        for (int ai = 0; ai < 2; ++ai)
#pragma unroll
            for (int m = 0; m < 4; ++m) { unsigned char* rowp = H + (size_t)(row0 + ai * HALF + m * 16) * 1024 + col0;
                float v[8];
#pragma unroll
                for (int n = 0; n < 2; ++n)
#pragma unroll
                    for (int j = 0; j < 4; ++j) { const float gt = acc[ai][0][m][n][j] * inv, up = acc[ai][1][m][n][j] * inv; v[n * 4 + j] = gt * __builtin_amdgcn_rcpf(1.0f + __expf(-gt)) * up; }
                int w0 = 0, w1 = 0; w0 = __builtin_amdgcn_cvt_pk_fp8_f32(v[0], v[1], w0, false); w0 = __builtin_amdgcn_cvt_pk_fp8_f32(v[2], v[3], w0, true);
                w1 = __builtin_amdgcn_cvt_pk_fp8_f32(v[4], v[5], w1, false); w1 = __builtin_amdgcn_cvt_pk_fp8_f32(v[6], v[7], w1, true);
                typedef unsigned u32x2_ __attribute__((ext_vector_type(2))); *(u32x2_*)(rowp) = (u32x2_){(unsigned)w0, (unsigned)w1}; }
    }
};
struct EpiDown {
    static constexpr bool PERM = true, AFTER_DRAIN = false;
    bf16_t* Y; const float* gate; float inv;
    __device__ __forceinline__ void operator()(const f32x4 (&acc)[2][2][4][2], const Unit& u, int wr, int wc, int fr, int fq) const {
        const int row0 = u.pm * BM + wr * 64 + fr, col0 = (u.pn & 7) * BM + wc * 32 + 8 * fq;
#pragma unroll
        for (int ai = 0; ai < 2; ++ai)
#pragma unroll
            for (int m = 0; m < 4; ++m) { const int row = row0 + ai * HALF + m * 16; const float gt = gate[row] * inv; bf16_t* rowp = Y + (size_t)row * 2048 + col0;
#pragma unroll
                for (int bj = 0; bj < 2; ++bj) { const f32x4 v0 = acc[ai][bj][m][0] * gt, v1 = acc[ai][bj][m][1] * gt;
                    u32x4 w; w.x = cvt_pk_bf16(v0[0], v0[1]); w.y = cvt_pk_bf16(v0[2], v0[3]); w.z = cvt_pk_bf16(v1[0], v1[1]); w.w = cvt_pk_bf16(v1[2], v1[3]);
                    *(u32x4*)(rowp + bj * HALF) = w; } }
    }
};
struct MoeOrder {
    int G, c, nctx;
    const unsigned* vtab;
    __device__ __forceinline__ u32x4 voff(const Unit& u) const { return *(const u32x4*)(vtab + ((size_t)u.pm * 512 + threadIdx.x) * 4); }
    __device__ __forceinline__ bool next(int i, Unit& u) const {
        long L = (long)i * G + c;
        if (L < 1024) { const int l = (int)L; const int lp = (G == 256) ? (l / 256) * 256 + (l % 8) * 32 + (l % 256) / 8 : l;
            const int s = lp / 32, w = lp % 32, e = s / 2, b = s % 2; u.pm = (b * 16 + e) * 4 + (w % 4); u.pn = e * 8 + (w / 4); return true; }
        L -= 1024; if (L < nctx) { const int e = (int)L / 8; u.pm = 128 + e; u.pn = e * 8 + (int)L % 8; return true; }
        return false;
    }
    __device__ __forceinline__ void a_ready(const Unit&) const {}
    __device__ __forceinline__ void done(const Unit&) const {}
};
}
#define XB_TMO      128
#define XB_XCNT(j)  (256  + 64 * (j))
#define XB_XSUB(j)  (1280 + 64 * (j))
#define XB_XGEN(j)  (2304 + 64 * (j))
#define XB_TOP      3328
#define XB_TOPGEN   3392
#define XCD_BAR_WORDS 3456
#define XB_SPIN_CAP (1u << 22)

__device__ __forceinline__ unsigned xb_ld(unsigned* p)              { return __hip_atomic_load(p, __ATOMIC_RELAXED, __HIP_MEMORY_SCOPE_AGENT); }
__device__ __forceinline__ unsigned xb_add(unsigned* p, unsigned v) { return __hip_atomic_fetch_add(p, v, __ATOMIC_RELAXED, __HIP_MEMORY_SCOPE_AGENT); }
__device__ __forceinline__ unsigned xb_xcc_id() { return (unsigned)__builtin_amdgcn_s_getreg((3 << 11) | 20) & 0xFu; }
#define XB_SPIN(cond, bar) do { unsigned _sp = 0; while (cond) { __builtin_amdgcn_s_sleep(1); \
    if ((++_sp & 255u) == 0u) { if (xb_ld(&(bar)[XB_TMO])) break; if (_sp > XB_SPIN_CAP) { atomicAdd(&(bar)[XB_TMO], 1u); break; } } } } while (0)

struct XcdBarrier {
    unsigned* bar; unsigned x;
    volatile LAS unsigned* st;
};

__device__ __forceinline__ XcdBarrier xcd_barrier_post(unsigned* bar, volatile LAS unsigned* st) {
    XcdBarrier b; b.bar = bar; b.x = xb_xcc_id(); b.st = st;
    if (threadIdx.x == 0) (void)xb_add(&bar[XB_XCNT(b.x)], 1u);
    return b;
}
__device__ __forceinline__ void xcd_barrier_complete(unsigned* bar, unsigned x, unsigned& nloc, unsigned& nx) {
    const unsigned G = gridDim.x * gridDim.y * gridDim.z;
    unsigned sum, cnt, mine, sp = 0u;
    for (;;) {
        sum = 0u; cnt = 0u; mine = 0u;
#pragma unroll
        for (unsigned j = 0; j < 16; ++j) { const unsigned c = xb_ld(&bar[XB_XCNT(j)]); sum += c; cnt += (c > 0u) ? 1u : 0u; mine = (j == x) ? c : mine; }
        if (sum == G) break;
        __builtin_amdgcn_s_sleep(1);
        if ((++sp & 255u) == 0u) { if (xb_ld(&bar[XB_TMO])) break; if (sp > XB_SPIN_CAP) { atomicAdd(&bar[XB_TMO], 1u); break; } }
    }
    nloc = mine > 0u ? mine : 1u; nx = cnt > 0u ? cnt : 1u;
}

__device__ __forceinline__ void xcd_barrier(const XcdBarrier& b) {
    asm volatile("s_waitcnt vmcnt(0)" ::: "memory");
    __syncthreads();
    if (threadIdx.x == 0) {
        unsigned* bar = b.bar;
        __builtin_amdgcn_s_waitcnt(0);
        unsigned nloc = b.st[0], nx = b.st[1];
        if (nloc == 0u) { xcd_barrier_complete(bar, b.x, nloc, nx); b.st[0] = nloc; b.st[1] = nx; }
        const unsigned old = xb_add(&bar[XB_XSUB(b.x)], 1u);
        const unsigned gen = old / nloc;
        if (old + 1u == (gen + 1u) * nloc) {
            __builtin_amdgcn_fence(__ATOMIC_RELEASE, "agent");
            asm volatile("s_waitcnt vmcnt(0)" ::: "memory");
            const unsigned og = xb_add(&bar[XB_TOP], 1u);
            const unsigned tg = og / nx;
            if (og + 1u == (tg + 1u) * nx) xb_add(&bar[XB_TOPGEN], 1u);
            else XB_SPIN(xb_ld(&bar[XB_TOPGEN]) == tg, bar);
            __builtin_amdgcn_fence(__ATOMIC_ACQUIRE, "agent");
            xb_add(&bar[XB_XGEN(b.x)], 1u);
            asm volatile("s_waitcnt vmcnt(0)" ::: "memory");
        } else {
            XB_SPIN(xb_ld(&bar[XB_XGEN(b.x)]) == gen, bar);
            __builtin_amdgcn_fence(__ATOMIC_ACQUIRE, "agent");
            asm volatile("s_waitcnt vmcnt(0)" ::: "memory");
        }
    }
    __syncthreads();
}

struct Params { const float* in[31]; float* out; unsigned char* ws; int ph_lo, ph_hi; };
enum { I_X = 0, I_C, I_CTX, I_CCTX, I_MODW, I_MODB, I_NORMG, I_EVWIN, I_EVWOUT, I_HGLB, I_HGNG, I_S5ARE, I_S5AIM, I_S5LDT, I_S5BRE, I_S5BIM, I_S5CRE, I_S5CIM, I_S5D, I_S5GLUW, I_S5GLUB,
       I_ODWIN, I_ODCONV, I_ODALOG, I_ODDTB, I_ODNG, I_ODWOUT, I_ROUTER, I_MOEG, I_MOEU, I_MOED };
struct Frame { LAS unsigned char* lds; int tid, lane, wave, G, bid; };
#define WSP(T, off) ((T*)(P.ws + (off)))

struct TrTile { const float* src; bf16_t* dst; int N, K; float s8; };
DI void tr_issue(const TrTile& t, f32x4 (&v)[4], int tid) {
#pragma unroll
    for (int i = 0; i < 4; ++i) { const int idx = tid + 512 * i, kr = idx >> 4, nc = (idx & 15) * 4; v[i] = *(const f32x4*)(t.src + (size_t)kr * t.N + nc); }
}
DI void tr_finish(const TrTile& t, const f32x4 (&v)[4], LAS unsigned char* lds, int buf, int tid) {
    if (t.s8 != 0.f) {
        LAS unsigned char* t8 = lds + buf * 17408;
#pragma unroll
        for (int i = 0; i < 4; ++i) { const int idx = tid + 512 * i, kr = idx >> 4, nc = (idx & 15) * 4; const unsigned w = cvt4_fp8(v[i][0] * t.s8, v[i][1] * t.s8, v[i][2] * t.s8, v[i][3] * t.s8);
            t8[(nc + 0) * 144 + kr] = (unsigned char)(w & 0xffu); t8[(nc + 1) * 144 + kr] = (unsigned char)((w >> 8) & 0xffu); t8[(nc + 2) * 144 + kr] = (unsigned char)((w >> 16) & 0xffu); t8[(nc + 3) * 144 + kr] = (unsigned char)(w >> 24); }
        __syncthreads();
        { const int n = tid >> 3, ch = tid & 7; *(u32x4*)((unsigned char*)t.dst + (size_t)n * t.K + ch * 16) = *(const LAS u32x4*)(t8 + n * 144 + ch * 16); }
        return; }
    LAS bf16_t* tT = (LAS bf16_t*)(lds + buf * 17408);
#pragma unroll
    for (int i = 0; i < 4; ++i) { const int idx = tid + 512 * i, kr = idx >> 4, nc = (idx & 15) * 4;
        const unsigned a = pk2(v[i][0], v[i][1]), b = pk2(v[i][2], v[i][3]);
        tT[(nc + 0) * 136 + kr] = (bf16_t)(a & 0xffffu); tT[(nc + 1) * 136 + kr] = (bf16_t)(a >> 16); tT[(nc + 2) * 136 + kr] = (bf16_t)(b & 0xffffu); tT[(nc + 3) * 136 + kr] = (bf16_t)(b >> 16); }
    __syncthreads();
#pragma unroll
    for (int i = 0; i < 2; ++i) { const int idx = tid + 512 * i, n = idx >> 4, ch = idx & 15;
        const u32x4 w = *(const LAS u32x4*)(tT + n * 136 + ch * 8);
        *(u32x4*)(t.dst + (size_t)n * t.K + ch * 8) = w; }
}
DI TrTile tr_desc(const float* src, int N, int k0, int n0, bf16_t* dst, int K, int drow0) { TrTile t; t.src = src + (size_t)k0 * N + n0; t.dst = dst + (size_t)drow0 * K + k0; t.N = N; t.K = K; t.s8 = 0.f; return t; }
DI TrTile tr_desc8(const float* src, int N, int k0, int n0, unsigned char* dst, int K, int drow0, float s8) { TrTile t; t.src = src + (size_t)k0 * N + n0; t.dst = (bf16_t*)(dst + (size_t)drow0 * K + k0); t.N = N; t.K = K; t.s8 = s8; return t; }
DI TrTile tr_moe_desc(const Params& P, int layer, int idx, bf16_t* WGU, bf16_t* WDN) {
    const int e = idx / 768, rem = idx % 768, which = rem / 256, t = rem % 256;
    if (which < 2) { const float* src = P.in[which ? I_MOEU : I_MOEG] + (size_t)(layer * 16 + e) * 2048 * 1024; const int kt = t / 16, nt = t % 16, n0 = nt * 64;
        return tr_desc8(src, 1024, kt * 128, n0, (unsigned char*)WGU + (size_t)e * 2048 * 2048, 2048, (n0 / 128) * 256 + (n0 % 128) + which * 128, W8_GU); }
    const float* src = P.in[I_MOED] + (size_t)(layer * 16 + e) * 1024 * 2048; const int kt = t / 32, nt = t % 32;
    return tr_desc8(src, 2048, kt * 128, nt * 64, (unsigned char*)WDN + (size_t)e * 2048 * 1024, 1024, nt * 64, W8_DN);
}
DI void t4_issue(const TrTile& t, f32x4 (&v)[4], int tid) { const int kb = tid >> 4, nb = tid & 15;
#pragma unroll
    for (int r = 0; r < 4; ++r) v[r] = *(const f32x4*)(t.src + (size_t)(4 * kb + r) * t.N + 4 * nb); }
DI void t4_lds(const TrTile& t, const f32x4 (&v)[4], LAS unsigned char* img, int tid) { const int kb = tid >> 4, nb = tid & 15;
#pragma unroll
    for (int j = 0; j < 4; ++j) *(LAS unsigned*)(img + (4 * nb + j) * 144 + 4 * kb) = cvt4_fp8(v[0][j] * t.s8, v[1][j] * t.s8, v[2][j] * t.s8, v[3][j] * t.s8); }
DI void t4_store(const TrTile& t, const LAS unsigned char* img, int tid) { const int n = tid >> 3, ch = tid & 7; *(u32x4*)((unsigned char*)t.dst + (size_t)n * t.K + ch * 16) = *(const LAS u32x4*)(img + n * 144 + ch * 16); }
constexpr int L1Q_END = 12288 - NB * HGH * NCHUNK;
DI void l1w_from_queue(const Params& P, const Frame& F, int quota) {
    volatile LAS int* slot = (volatile LAS int*)(F.lds + LDS_MISC - 16); unsigned* ctr = WSP(unsigned, WS_CTL) + 256;
    __syncthreads();
    if (F.tid == 0) *slot = quota > 0 ? (int)__hip_atomic_fetch_add(ctr, (unsigned)quota, __ATOMIC_RELAXED, __HIP_MEMORY_SCOPE_AGENT) : (int)__hip_atomic_load(ctr, __ATOMIC_RELAXED, __HIP_MEMORY_SCOPE_AGENT);
    __syncthreads();
    int t = *slot, step = 1, end = t + quota;
    if (quota < 0) { t += F.bid; step = F.G; end = L1Q_END; }
    if (end > L1Q_END) end = L1Q_END;
    if (t >= end) return;
    TrTile cur = tr_moe_desc(P, 1, t, WSP(bf16_t, WS_WGU1), WSP(bf16_t, WS_WDN1)); f32x4 va[4], vb[4]; tr_issue(cur, va, F.tid); int buf = 0;
    for (;;) { const int tn = t + step; const bool more = tn < end; TrTile nx = cur; if (more) { nx = tr_moe_desc(P, 1, tn, WSP(bf16_t, WS_WGU1), WSP(bf16_t, WS_WDN1)); tr_issue(nx, vb, F.tid); }
        tr_finish(cur, va, F.lds, buf, F.tid); buf ^= 1;
        if (!more) break;
#pragma unroll
        for (int i = 0; i < 4; ++i) va[i] = vb[i];
        cur = nx; t = tn; }
    __syncthreads();
}
constexpr int P0_NMOD = 384, P0_NS5 = 64, P0_T0 = P0_NMOD + P0_NS5 + 1;
constexpr int P0_TEVIN = 16 * 96, P0_TEVOUT = 16 * 32, P0_TODIN = 16 * 194, P0_TODOUT = 32 * 32, P0_TMOE = 12288;
constexpr int P0_NTASK = P0_T0 + P0_TEVIN + P0_TEVOUT + P0_TODIN + P0_TODOUT;
constexpr int P0_LDS_SC = 20480, P0_LDS_RED = 45056;

DI void p0_modgemv(const Params& P, const Frame& F, int task) {
    const int layer = task / 192, cg = task % 192, rg = F.tid >> 4, l16 = F.tid & 15, col = cg * 64 + l16 * 4;
    const LAS float* SC = (const LAS float*)(F.lds + P0_LDS_SC); LAS float* RED = (LAS float*)(F.lds + P0_LDS_RED);
    const float* W = P.in[I_MODW] + (size_t)layer * 2048 * 12288 + col;
    f32x4 a0 = {0, 0, 0, 0}, a1 = a0, a2 = a0;
#pragma unroll 8
    for (int kk = 0; kk < 64; ++kk) { const int k = rg + 32 * kk; const f32x4 w = *(const f32x4*)(W + (size_t)k * 12288);
        a0 += w * SC[k]; a1 += w * SC[2048 + k]; a2 += w * SC[4096 + k]; }
#pragma unroll
    for (int j = 0; j < 4; ++j) { RED[(rg * 3 + 0) * 64 + l16 * 4 + j] = a0[j]; RED[(rg * 3 + 1) * 64 + l16 * 4 + j] = a1[j]; RED[(rg * 3 + 2) * 64 + l16 * 4 + j] = a2[j]; }
    __syncthreads();
    if (F.tid < 192) { const int i = F.tid / 64, cc = F.tid % 64; float s = 0.f;
#pragma unroll 8
        for (int r = 0; r < 32; ++r) s += RED[(r * 3 + i) * 64 + cc];
        WSP(float, WS_MODV)[(size_t)(layer * 3 + i) * 12288 + cg * 64 + cc] = s + P.in[I_MODB][layer * 12288 + cg * 64 + cc]; }
    __syncthreads();
}
DI void p0_s5(const Params& P, const Frame& F, int g) {
    LAS float* BBr = (LAS float*)F.lds; LAS float* BBi = BBr + 2048; LAS float* CMr = BBr + 4096; LAS float* CMi = BBr + 6144;
    LAS float* APr = BBr + 8192; LAS float* APi = APr + 2176;
    LAS float* KT = BBr + 8192 + 4352;
    const int tid = F.tid;
    if (tid < 128) { const int dir = tid >> 6, p = tid & 63; const int gi = (dir * 64 + g) * 64 + p;
        const float ar = P.in[I_S5ARE][gi], ai = P.in[I_S5AIM][gi], dt = __expf(P.in[I_S5LDT][dir * 64 + g]);
        const float mag = ar * dt, ang = ai * dt; float sn, cs; sincosf(ang, &sn, &cs); const float em = expf(mag);
        const float nr = em * cs - 1.0f, ni = em * sn, den = 1.0f / (ar * ar + ai * ai);
        const float cr = (nr * ar + ni * ai) * den, ci = (ni * ar - nr * ai) * den;
        for (int c = 0; c < 16; ++c) { const float br = P.in[I_S5BRE][(size_t)gi * 16 + c], bi = P.in[I_S5BIM][(size_t)gi * 16 + c];
            BBr[(dir * 64 + p) * 16 + c] = cr * br - ci * bi; BBi[(dir * 64 + p) * 16 + c] = cr * bi + ci * br; }
        for (int l = 0; l <= 16; ++l) { float s2, c2; sincosf((float)l * ang, &s2, &c2); const float e2 = expf((float)l * mag); APr[(dir * 17 + l) * 64 + p] = e2 * c2; APi[(dir * 17 + l) * 64 + p] = e2 * s2; }
        float* a16 = WSP(float, WS_S5A16) + (size_t)gi * 2; a16[0] = APr[(dir * 17 + 16) * 64 + p]; a16[1] = APi[(dir * 17 + 16) * 64 + p]; }
    for (int i = tid; i < 2048; i += 512) { const int dir = i >> 10, c = (i >> 6) & 15, p = i & 63; const size_t gi = ((size_t)(dir * 64 + g) * 16 + c) * 64 + p;
        CMr[i] = P.in[I_S5CRE][gi]; CMi[i] = P.in[I_S5CIM][gi]; }
    __syncthreads();
    for (int i = tid; i < 8192; i += 512) { const int dir = i >> 12, l = (i >> 8) & 15, c = (i >> 4) & 15, c2 = i & 15; float acc = 0.f;
        for (int p = 0; p < 64; ++p) { const float Cr = CMr[(dir * 16 + c) * 64 + p], Ci = CMi[(dir * 16 + c) * 64 + p], Pr = APr[(dir * 17 + l) * 64 + p], Pi = APi[(dir * 17 + l) * 64 + p];
            const float tr = Cr * Pr - Ci * Pi, ti = Cr * Pi + Ci * Pr; acc += tr * BBr[(dir * 64 + p) * 16 + c2] - ti * BBi[(dir * 64 + p) * 16 + c2]; }
        KT[i] = acc; }
    __syncthreads();
    bf16_t* WY = WSP(bf16_t, WS_S5WY) + (size_t)g * 256 * 512; bf16_t* WX = WSP(bf16_t, WS_S5WX) + (size_t)g * 256 * 256;
    for (int i = tid; i < 256 * 512; i += 512) { const int row = i >> 9, col = i & 511, j = row >> 4, c = row & 15; float v;
        if (col < 256) { const int ii = col >> 4, c2 = col & 15; v = 0.f;
            if (ii <= j) v += KT[((0 * 16 + (j - ii)) * 16 + c) * 16 + c2];
            if (ii >= j) v += KT[((1 * 16 + (ii - j)) * 16 + c) * 16 + c2];
            if (ii == j && c == c2) v += P.in[I_S5D][g * 16 + c]; }
        else { const int q = col - 256, part = q >> 6, p = q & 63, dir = part >> 1, im = part & 1, l = dir == 0 ? j + 1 : 16 - j;
            const float Cr = CMr[(dir * 16 + c) * 64 + p], Ci = CMi[(dir * 16 + c) * 64 + p], Pr = APr[(dir * 17 + l) * 64 + p], Pi = APi[(dir * 17 + l) * 64 + p];
            v = im ? -(Cr * Pi + Ci * Pr) : (Cr * Pr - Ci * Pi); }
        WY[i] = f2bf(v); }
    for (int i = tid; i < 256 * 256; i += 512) { const int row = i >> 8, col = i & 255, part = row >> 6, p = row & 63, dir = part >> 1, im = part & 1, ii = col >> 4, c2 = col & 15, l = dir == 0 ? 15 - ii : ii;
        const float Pr = APr[(dir * 17 + l) * 64 + p], Pi = APi[(dir * 17 + l) * 64 + p], Br = BBr[(dir * 64 + p) * 16 + c2], Bi = BBi[(dir * 64 + p) * 16 + c2];
        WX[i] = f2bf(im ? (Pr * Bi + Pi * Br) : (Pr * Br - Pi * Bi)); }
    __syncthreads();
}
DI void p0_prologue(const Params& P, const Frame& F, int rep) {
    if (F.bid < P0_NMOD) {
        LAS float* SC = (LAS float*)(F.lds + P0_LDS_SC);
        for (int i = F.tid; i < 6144; i += 512) { const float v = i < 4096 ? P.in[I_C][i] : P.in[I_CCTX][i - 4096]; SC[i] = siluf_(v); }
        __syncthreads();
    }
    int task = F.bid;
    for (; task < P0_T0; task += F.G) {
        if (task < P0_NMOD) p0_modgemv(P, F, task);
        else if (task < P0_NMOD + P0_NS5) p0_s5(P, F, task - P0_NMOD);
        else { for (int i = F.tid; i < 2048; i += 512) { const float a0 = P.in[I_HGLB][i], a1 = P.in[I_HGLB][2048 + i]; WSP(float, WS_LB)[i] = 1.0f / (1.0f + __expf(a1 - a0)); } }
    }
    __syncthreads();
    auto desc = [&](int tk) -> TrTile { int t = tk - P0_T0;
        if (t < P0_TEVIN) return tr_desc(P.in[I_EVWIN], 6144, (t / 96) * 128, (t % 96) * 64, WSP(bf16_t, WS_WEVIN), 2048, (t % 96) * 64); t -= P0_TEVIN;
        if (t < P0_TEVOUT) return tr_desc8(P.in[I_EVWOUT], 2048, (t / 32) * 128, (t % 32) * 64, WSP(unsigned char, WS_WEVOUT), 2048, (t % 32) * 64, W8_GU); t -= P0_TEVOUT;
        if (t < P0_TODIN) { const int k0 = (t / 194) * 128, j = t % 194;
            const bool q8 = OD8_MODE >= 2, k8 = OD8_MODE >= 3;
            int r8 = -1, rb = -1;
            if (j < 32) { if (q8) r8 = j * 64; else rb = j * 64; }
            else if (j < 64) { if (k8) r8 = j * 64; else rb = (q8 ? j - 32 : j) * 64; }
            else if (j < 192) r8 = (j - 64) * 64 + (q8 ? 2048 : 0) + (k8 ? 2048 : 0);
            else rb = ODA_N - 256 + (j - 192) * 64;
            if (r8 >= 0) return tr_desc8(P.in[I_ODWIN], ODIN, k0, j * 64, WSP(unsigned char, WS_WODIN8), 2048, r8, W8_GU);
            return tr_desc(P.in[I_ODWIN], ODIN, k0, j * 64, WSP(bf16_t, WS_WODIN), 2048, rb); }
        t -= P0_TODIN;
        return tr_desc8(P.in[I_ODWOUT], 2048, (t / 32) * 128, (t % 32) * 64, WSP(unsigned char, WS_WODOUT), 4096, (t % 32) * 64, W8_GU); };
    { constexpr int PC = 4, NT = P0_NTASK - P0_T0; unsigned* ctr = WSP(unsigned, WS_CTL) + 320 + rep; volatile LAS int* slot = (volatile LAS int*)(F.lds + LDS_MISC - 16);
      if (F.tid == 0) { slot[0] = (int)__hip_atomic_fetch_add(ctr, (unsigned)PC, __ATOMIC_RELAXED, __HIP_MEMORY_SCOPE_AGENT); slot[1] = (int)__hip_atomic_fetch_add(ctr, (unsigned)PC, __ATOMIC_RELAXED, __HIP_MEMORY_SCOPE_AGENT); }
      __syncthreads();
      int t = slot[0], nbase = slot[1], k = 0, pend = 0; __syncthreads();
      if (t < NT) { TrTile cur = desc(P0_T0 + t); f32x4 va[4], vb[4]; tr_issue(cur, va, F.tid); int buf = 0;
        for (;;) { if (k == 0 && F.tid == 0) pend = (int)__hip_atomic_fetch_add(ctr, (unsigned)PC, __ATOMIC_RELAXED, __HIP_MEMORY_SCOPE_AGENT);
            const bool endc = (k == PC - 1); const int tn = endc ? nbase : t + 1; const bool more = tn < NT; TrTile nx = cur; if (more) { nx = desc(P0_T0 + tn); tr_issue(nx, vb, F.tid); }
            if (endc && F.tid == 0) slot[0] = pend;
            tr_finish(cur, va, F.lds, buf, F.tid); buf ^= 1;
            if (endc) nbase = slot[0];
            if (!more) break;
#pragma unroll
            for (int i = 0; i < 4; ++i) va[i] = vb[i];
            cur = nx; t = tn; k = endc ? 0 : k + 1; } } }
    __syncthreads();
}

DI void row_load(const float* src, int lane, f32x4 (&v)[8]) {
#pragma unroll
    for (int i = 0; i < 8; ++i) v[i] = *(const f32x4*)(src + i * 256 + lane * 4);
}
DI float row_rs(const f32x4 (&v)[8]) { float ss = 0.f;
#pragma unroll
    for (int i = 0; i < 8; ++i) ss += v[i][0] * v[i][0] + v[i][1] * v[i][1] + v[i][2] * v[i][2] + v[i][3] * v[i][3];
    ss = wave_sum(ss); return rsqrtf(ss * (1.0f / 2048.0f) + EPS); }
DI void row_norm_mod(f32x4 (&v)[8], const float* gain, const float* shift, const float* scale, bf16_t* dst, int lane, bool store = true) {
    const float rs = row_rs(v);
#pragma unroll
    for (int i = 0; i < 8; ++i) { const int c = i * 256 + lane * 4; const f32x4 g = *(const f32x4*)(gain + c), sh = *(const f32x4*)(shift + c), sc = *(const f32x4*)(scale + c);
        v[i] = (v[i] * rs * g) * (sc + 1.0f) + sh;
        u32x2 w; w.x = pk2(v[i][0], v[i][1]); w.y = pk2(v[i][2], v[i][3]); if (store) *(u32x2*)(dst + c) = w; }
}
DI void row_norm_mod8(f32x4 (&v)[8], const float* gain, const float* shift, const float* scale, unsigned char* dst, int lane, bool store) {
    const float rs = row_rs(v);
#pragma unroll
    for (int i = 0; i < 8; ++i) { const int c = i * 256 + lane * 4; const f32x4 g = *(const f32x4*)(gain + c), sh = *(const f32x4*)(shift + c), sc = *(const f32x4*)(scale + c);
        v[i] = (v[i] * rs * g) * (sc + 1.0f) + sh;
        if (store) *(unsigned*)(dst + c) = cvt4_fp8(v[i][0], v[i][1], v[i][2], v[i][3]); }
}
DI const float* stream_row_in(const Params& P, int layer_stream, int b, int t) {
    if (layer_stream == 0) return t < LCTX ? P.in[I_CTX] + (size_t)(b * LCTX + t) * DM : P.in[I_X] + (size_t)(b * NLAT + t - LCTX) * DM;
    return t < LCTX ? (const float*)WSP(float, WS_CTXW) + (size_t)(b * LCTX + t) * DM : (const float*)P.out + (size_t)(b * NLAT + t - LCTX) * DM;
}
DI float* stream_row_out(const Params& P, int b, int t) { return t < LCTX ? WSP(float, WS_CTXW) + (size_t)(b * LCTX + t) * DM : P.out + (size_t)(b * NLAT + t - LCTX) * DM; }

DI void p1_hall0(const Params& P, const Frame& F) {
    const float* modv = WSP(float, WS_MODV);
    for (int r = F.bid * 8 + F.wave; r < RR; r += F.G * 8) { const int b = r / TT, t = r % TT, mi = t < LCTX ? 2 : b;
        f32x4 v[8]; row_load(stream_row_in(P, 0, b, t), F.lane, v);
        const float* m = modv + (size_t)(0 * 3 + mi) * 12288;
        row_norm_mod(v, P.in[I_NORMG] + (0 * 4 + 0) * DM, m, m + DM, WSP(bf16_t, WS_HA) + (size_t)r * DM, F.lane); }
}
DI void hg_load8(const bf16_t* p, float (&o)[8]) { const u32x4 w = *(const u32x4*)p; o[0] = bflo(w.x); o[1] = bfhi(w.x); o[2] = bflo(w.y); o[3] = bfhi(w.y); o[4] = bflo(w.z); o[5] = bfhi(w.z); o[6] = bflo(w.w); o[7] = bfhi(w.w); }
DI bf16x8 tr_frag(const LAS bf16_t* base, int ld, int k0, int n0, int lane) { const int g = lane >> 4, qq = (lane & 15) >> 2, pp = lane & 3; const LAS bf16_t* p = base + (k0 + 8 * g + qq) * ld + n0 + 4 * pp;
    const s16x4 a = __builtin_amdgcn_ds_read_tr16_b64_v4i16((LAS s16x4*)p), b = __builtin_amdgcn_ds_read_tr16_b64_v4i16((LAS s16x4*)(p + 4 * ld));
    return (bf16x8){a[0], a[1], a[2], a[3], b[0], b[1], b[2], b[3]}; }
DI void cv8(const u32x4& w, float (&o)[8]) { o[0] = bflo(w.x); o[1] = bfhi(w.x); o[2] = bflo(w.y); o[3] = bfhi(w.y); o[4] = bflo(w.z); o[5] = bfhi(w.z); o[6] = bflo(w.w); o[7] = bfhi(w.w); }
struct HgaPre { u32x4 pf[2][2], pv[2]; f32x4 lb[2][2]; int item; };
DI void hga_request(const Params& P, const Frame& F, int item, HgaPre& pre) {
    const int c = item % NCHUNK, bh = item / NCHUNK, h = bh % HGH, b = bh / HGH, tid = F.tid;
    const bf16_t* P0 = WSP(bf16_t, WS_P0) + (size_t)(b * TT + c * 64) * EVIN + h * 128; const float* LB = WSP(float, WS_LB);
#pragma unroll
    for (int i = 0; i < 2; ++i) { const int idx = tid + 512 * i, tok = idx >> 4, k0 = (idx & 15) * 8; const bf16_t* rp = P0 + (size_t)tok * EVIN + k0;
        pre.pf[0][i] = *(const u32x4*)(rp + 1024); pre.pf[1][i] = *(const u32x4*)(rp + 2048); pre.pv[i] = *(const u32x4*)(rp + 3072); }
    { const int k0 = (tid & 15) * 8;
#pragma unroll
      for (int d = 0; d < 2; ++d) { pre.lb[d][0] = *(const f32x4*)(LB + d * 1024 + h * 128 + k0); pre.lb[d][1] = *(const f32x4*)(LB + d * 1024 + h * 128 + k0 + 4); } }
    pre.item = item;
}
DI void hga_item(const Params& P, const Frame& F, int item, int next_item, HgaPre& pre) {
    const int c = item % NCHUNK, bh = item / NCHUNK, h = bh % HGH, b = bh / HGH, tid = F.tid;
    const bf16_t* P0 = WSP(bf16_t, WS_P0) + (size_t)(b * TT + c * 64) * EVIN + h * 128;
    const float* LB = WSP(float, WS_LB);
    LAS float* LF = (LAS float*)F.lds;
    LAS bf16_t* KL = (LAS bf16_t*)(F.lds + 65536);
    LAS bf16_t* VL = (LAS bf16_t*)(F.lds + 100352);
    LAS float* SEG = (LAS float*)(F.lds + 117760);
    LAS bf16_t* OUT = (LAS bf16_t*)F.lds;
    LAS unsigned char* IMG0 = F.lds + 119808; LAS unsigned char* IMG1 = IMG0 + 9216;
    const TrTile tA = tr_moe_desc(P, 0, 2 * item, WSP(bf16_t, WS_WGU), WSP(bf16_t, WS_WDN)), tB = tr_moe_desc(P, 0, 2 * item + 1, WSP(bf16_t, WS_WGU), WSP(bf16_t, WS_WDN));
    f32x4 wa[4], wb[4];
    if (pre.item != item) hga_request(P, F, item, pre);
#pragma unroll
    for (int i = 0; i < 2; ++i) { const int idx = tid + 512 * i, tok = idx >> 4, k0 = (idx & 15) * 8; float x[8];
#pragma unroll
        for (int dir = 0; dir < 2; ++dir) { cv8(pre.pf[dir][i], x); float kk[8];
#pragma unroll
            for (int j = 0; j < 8; ++j) { const float lb = pre.lb[dir][j >> 2][j & 3], f = lb + (1.0f - lb) * sigmoidf_(x[j]); LF[(dir * 64 + tok) * 128 + k0 + j] = __logf(f); kk[j] = 1.0f - f; }
            *(LAS u32x4*)(KL + (dir * 64 + tok) * 136 + k0) = (u32x4){pk2(kk[0], kk[1]), pk2(kk[2], kk[3]), pk2(kk[4], kk[5]), pk2(kk[6], kk[7])}; }
        *(LAS u32x4*)(VL + tok * 136 + k0) = pre.pv[i]; }
    asm volatile("" ::: "memory");
    if (next_item >= 0) hga_request(P, F, next_item, pre); else pre.item = -1;
    t4_issue(tA, wa, tid); t4_issue(tB, wb, tid);
    __syncthreads();
    const int sdir = tid >> 8, sseg = (tid >> 7) & 1, skd = tid & 127;
    { float tot = 0.f;
#pragma unroll 8
      for (int s = 0; s < 32; ++s) { const int ss = sseg * 32 + s, t = sdir ? 63 - ss : ss; tot += LF[(sdir * 64 + t) * 128 + skd]; }
      SEG[(sdir * 2 + sseg) * 128 + skd] = tot; }
    t4_lds(tA, wa, IMG0, tid);
    __syncthreads();
    t4_store(tA, IMG0, tid);
    { const float s0 = SEG[(sdir * 2 + 0) * 128 + skd], s1 = SEG[(sdir * 2 + 1) * 128 + skd], tot = s0 + s1; float run = sseg ? s0 : 0.f;
#pragma unroll 8
      for (int s = 0; s < 32; ++s) { const int ss = sseg * 32 + s, t = sdir ? 63 - ss : ss; run += LF[(sdir * 64 + t) * 128 + skd];
          const float kk = bf2f(KL[(sdir * 64 + t) * 136 + skd]); KL[(sdir * 64 + t) * 136 + skd] = f2bf(kk * __expf(tot - run));
          if (ss == 31) WSP(float, WS_REFX)[(size_t)((bh * 2 + sdir) * NCHUNK + c) * 128 + skd] = __expf(run); }
      if (sseg == 0) WSP(float, WS_DEC)[(size_t)((bh * 2 + sdir) * NCHUNK + c) * 128 + skd] = __expf(tot); }
    t4_lds(tB, wb, IMG1, tid);
    const TrTile tC = tr_moe_desc(P, 1, L1Q_END + item, WSP(bf16_t, WS_WGU1), WSP(bf16_t, WS_WDN1)); t4_issue(tC, wa, tid);
    __syncthreads();
    t4_store(tB, IMG1, tid);
    {
        const int w = F.wave, lane = F.lane, l15 = lane & 15, q = lane >> 4;
        const bf16x8 a0 = tr_frag(VL, 136, 0, 16 * w, lane), a1 = tr_frag(VL, 136, 32, 16 * w, lane);
#pragma unroll 1
        for (int dir = 0; dir < 2; ++dir) {
#pragma unroll 2
            for (int nt = 0; nt < 8; ++nt) { f32x4 acc = {0, 0, 0, 0};
                acc = mfma16(a0, tr_frag(KL + dir * 64 * 136, 136, 0, 16 * nt, lane), acc); acc = mfma16(a1, tr_frag(KL + dir * 64 * 136, 136, 32, 16 * nt, lane), acc);
#pragma unroll
                for (int r = 0; r < 4; ++r) OUT[(16 * w + 4 * q + r) * 136 + 16 * nt + l15] = f2bf(acc[r]); }
            bf16_t* dst = WSP(bf16_t, WS_KVT) + (size_t)((bh * 2 + dir) * NCHUNK + c) * 16384;
#pragma unroll
            for (int i = 0; i < 4; ++i) { const int idx = lane + 64 * i, row = 16 * w + (idx >> 4), ch = idx & 15;
                *(u32x4*)(dst + row * 128 + ch * 8) = *(const LAS u32x4*)(OUT + row * 136 + ch * 8); }
        }
    }
    t4_lds(tC, wa, IMG0, tid);
    __syncthreads();
    t4_store(tC, IMG0, tid);
}
DI bf16x8 s5_ufrag(const bf16_t* P0, int g, int mt, int ks, int lane) { const int cr = 16 * mt + (lane & 15), q = lane >> 4;
    return *(const bf16x8*)(P0 + (size_t)(cr * 16 + 2 * ks + (q >> 1)) * EVIN + 5120 + g * 16 + 8 * (q & 1)); }
DI void s5xl_group(const Params& P, const Frame& F, int gtask) {
    const int g = gtask >> 2, mt_lo = 17 * (gtask & 3), mt_hi = mt_lo + 17 < 66 ? mt_lo + 17 : 66;
    LAS bf16_t* WXh = (LAS bf16_t*)F.lds;
    const bf16_t* P0 = WSP(bf16_t, WS_P0); const bf16_t* WX = WSP(bf16_t, WS_S5WX) + (size_t)g * 65536; float* XL = WSP(float, WS_XL);
    const int lane = F.lane, l15 = lane & 15, q = lane >> 4;
    for (int half = 0; half < 2; ++half) {
        __syncthreads();
#pragma unroll
        for (int i = 0; i < 8; ++i) { const int idx = F.tid + 512 * i, row = idx >> 5, ch = idx & 31; *(LAS u32x4*)(WXh + row * 264 + ch * 8) = *(const u32x4*)(WX + (size_t)(half * 128 + row) * 256 + ch * 8); }
        __syncthreads();
        for (int mt = mt_lo + F.wave; mt < mt_hi; mt += 8) { bf16x8 a[8];
#pragma unroll
            for (int ks = 0; ks < 8; ++ks) a[ks] = s5_ufrag(P0, g, mt, ks, lane);
#pragma unroll 2
            for (int nt = 0; nt < 8; ++nt) { f32x4 acc = {0, 0, 0, 0};
#pragma unroll
                for (int ks = 0; ks < 8; ++ks) acc = mfma16(a[ks], lds_frag(WXh, 264, 16 * nt, 32 * ks, lane), acc);
#pragma unroll
                for (int r = 0; r < 4; ++r) { const int cr = 16 * mt + 4 * q + r, b = cr / S5NCH, n = cr % S5NCH;
                    XL[((size_t)(b * 64 + g) * S5NCH + n) * 256 + half * 128 + 16 * nt + l15] = acc[r]; } }
        }
    }
    __syncthreads();
}
#define BLK_QUEUE_LOOP(ctr, ntask, body) do { volatile LAS int* slot_ = (volatile LAS int*)(F.lds + LDS_MISC - 16); \
    if (F.tid == 0) *slot_ = (int)__hip_atomic_fetch_add((ctr), 1u, __ATOMIC_RELAXED, __HIP_MEMORY_SCOPE_AGENT); __syncthreads(); \
    for (;;) { const int task = *slot_; if (task >= (ntask)) break; int nxt_ = 0; if (F.tid == 0) nxt_ = (int)__hip_atomic_fetch_add((ctr), 1u, __ATOMIC_RELAXED, __HIP_MEMORY_SCOPE_AGENT); \
        body; if (F.tid == 0) *slot_ = nxt_; __syncthreads(); } } while (0)
#define BLK_QUEUE_LOOP2(ctr, ntask, body) do { volatile LAS int* slot_ = (volatile LAS int*)(F.lds + LDS_MISC - 16); \
    if (F.tid == 0) { slot_[0] = (int)__hip_atomic_fetch_add((ctr), 1u, __ATOMIC_RELAXED, __HIP_MEMORY_SCOPE_AGENT); slot_[1] = (int)__hip_atomic_fetch_add((ctr), 1u, __ATOMIC_RELAXED, __HIP_MEMORY_SCOPE_AGENT); } __syncthreads(); \
    for (;;) { const int task = slot_[0], tnext = slot_[1]; if (task >= (ntask)) break; int nn_ = 0; if (F.tid == 0) nn_ = (int)__hip_atomic_fetch_add((ctr), 1u, __ATOMIC_RELAXED, __HIP_MEMORY_SCOPE_AGENT); \
        body; if (F.tid == 0) { slot_[0] = tnext; slot_[1] = nn_; } __syncthreads(); } } while (0)
DI void e2a(const Params& P, const Frame& F, int rep) {
    constexpr int NT = 256 + NB * HGH * NCHUNK; HgaPre pre; pre.item = -1;
#pragma unroll
    for (int i = 0; i < 2; ++i) { pre.pf[0][i] = pre.pf[1][i] = pre.pv[i] = (u32x4){0u, 0u, 0u, 0u}; pre.lb[0][i] = pre.lb[1][i] = (f32x4){0.f, 0.f, 0.f, 0.f}; }
    BLK_QUEUE_LOOP2(WSP(unsigned, WS_CTL) + 128 + rep, NT, { if (task < 256) s5xl_group(P, F, task); else hga_item(P, F, task - 256, (tnext >= 256 && tnext < NT) ? tnext - 256 : -1, pre); });
}
DI void e2b(const Params& P, const Frame& F) {
    for (int t = F.bid; t < 256; t += F.G) { const int b = t >> 7, g = (t >> 1) & 63, dir = t & 1, p = F.lane, w = F.wave;
        const float* a16 = WSP(float, WS_S5A16) + (size_t)((dir * 64 + g) * 64 + p) * 2; const float ar = a16[0], ai = a16[1];
        const float* XL = WSP(float, WS_XL) + (size_t)(b * 64 + g) * S5NCH * 256 + dir * 128 + p; bf16_t* X0 = WSP(bf16_t, WS_X0) + (size_t)(b * 64 + g) * S5NCH * 256 + dir * 128 + p;
        LAS float* CAR = (LAS float*)F.lds;
        constexpr int SEG = S5NCH / 8;
        float xr = 0.f, xi = 0.f;
#pragma unroll 1
        for (int s0 = w * SEG; s0 < (w + 1) * SEG; s0 += 22) { float lr[22], li[22];
#pragma unroll
            for (int u = 0; u < 22; ++u) { const int sq = s0 + u, nn = dir == 0 ? sq : (sq < S5NCTX ? S5NCTX - 1 - sq : S5NCH + S5NCTX - 1 - sq); lr[u] = XL[(size_t)nn * 256]; li[u] = XL[(size_t)nn * 256 + 64]; }
#pragma unroll
            for (int u = 0; u < 22; ++u) { const float nr = ar * xr - ai * xi + lr[u], ni = ar * xi + ai * xr + li[u]; xr = nr; xi = ni; } }
        CAR[(w * 64 + p) * 2] = xr; CAR[(w * 64 + p) * 2 + 1] = xi;
        float pr = 1.f, pi = 0.f;
#pragma unroll 1
        for (int k = 0; k < SEG; ++k) { const float nr = pr * ar - pi * ai, ni = pr * ai + pi * ar; pr = nr; pi = ni; }
        __syncthreads();
        xr = 0.f; xi = 0.f;
        for (int k = 0; k < w; ++k) { const float er = CAR[(k * 64 + p) * 2], ei = CAR[(k * 64 + p) * 2 + 1]; const float nr = pr * xr - pi * xi + er, ni = pr * xi + pi * xr + ei; xr = nr; xi = ni; }
#pragma unroll 1
        for (int s0 = w * SEG; s0 < (w + 1) * SEG; s0 += 22) { float lr[22], li[22]; int nn[22];
#pragma unroll
            for (int u = 0; u < 22; ++u) { const int sq = s0 + u; nn[u] = dir == 0 ? sq : (sq < S5NCTX ? S5NCTX - 1 - sq : S5NCH + S5NCTX - 1 - sq); lr[u] = XL[(size_t)nn[u] * 256]; li[u] = XL[(size_t)nn[u] * 256 + 64]; }
#pragma unroll
            for (int u = 0; u < 22; ++u) { X0[(size_t)nn[u] * 256] = f2bf(xr); X0[(size_t)nn[u] * 256 + 64] = f2bf(xi);
                const float nr = ar * xr - ai * xi + lr[u], ni = ar * xi + ai * xr + li[u]; xr = nr; xi = ni; } }
        __syncthreads();
    }
    for (int u = F.bid; u < 256; u += F.G) { const int chain = u >> 3, part = u & 7, dir = chain & 1, e = (part * 512 + F.tid) * 4, kd = e & 127;
        const bf16_t* KVT = WSP(bf16_t, WS_KVT) + (size_t)chain * NCHUNK * 16384 + e; bf16_t* SST = WSP(bf16_t, WS_SST) + (size_t)chain * NCHUNK * 16384 + e;
        const float* DEC = WSP(float, WS_DEC) + (size_t)chain * NCHUNK * 128 + kd; const float* RFX = WSP(float, WS_REFX) + (size_t)chain * NCHUNK * 128 + kd;
        f32x4 s = {0, 0, 0, 0};
        for (int n0 = 0; n0 < NCHUNK; n0 += 12) { u32x2 kv[12]; f32x4 d[12], rx[12]; int cc[12];
#pragma unroll
            for (int k = 0; k < 12; ++k) { const int n = n0 + k; cc[k] = dir ? (n < 4 ? 3 - n : NCHUNK + 3 - n) : n; kv[k] = *(const u32x2*)(KVT + (size_t)cc[k] * 16384); d[k] = *(const f32x4*)(DEC + (size_t)cc[k] * 128); rx[k] = *(const f32x4*)(RFX + (size_t)cc[k] * 128); }
#pragma unroll
            for (int k = 0; k < 12; ++k) { u32x2 w; w.x = pk2(s[0] * rx[k][0], s[1] * rx[k][1]); w.y = pk2(s[2] * rx[k][2], s[3] * rx[k][3]); *(u32x2*)(SST + (size_t)cc[k] * 16384) = w;
                s[0] = s[0] * d[k][0] + bflo(kv[k].x); s[1] = s[1] * d[k][1] + bfhi(kv[k].x); s[2] = s[2] * d[k][2] + bflo(kv[k].y); s[3] = s[3] * d[k][3] + bfhi(kv[k].y); } }
    }
}
DI void hgc_item(const Params& P, const Frame& F, int item) {
    const int c = item % NCHUNK, bh = item / NCHUNK, h = bh % HGH, b = bh / HGH, tid = F.tid, lane = F.lane, l15 = lane & 15, q = lane >> 4, w = F.wave;
    const size_t r0 = (size_t)(b * TT + c * 64);
    const bf16_t* P0 = WSP(bf16_t, WS_P0) + r0 * EVIN + h * 128;
    const float* LB = WSP(float, WS_LB);
    LAS float* BF = (LAS float*)F.lds;
    LAS bf16_t* QH = (LAS bf16_t*)(F.lds + 32768);
    LAS bf16_t* KH = (LAS bf16_t*)(F.lds + 50176);
    LAS bf16_t* VL = (LAS bf16_t*)(F.lds + 67584);
    LAS bf16_t* ST = (LAS bf16_t*)(F.lds + 84992);
    LAS bf16_t* ATT = (LAS bf16_t*)(F.lds + 119808);
    LAS float* REFV = (LAS float*)(F.lds + 129024);
    LAS float* SEG = (LAS float*)(F.lds + 129536);
    LAS float* OST = (LAS float*)F.lds;
#pragma unroll
    for (int i = 0; i < 2; ++i) { const int idx = tid + 512 * i, tok = idx >> 4, k0 = (idx & 15) * 8; *(LAS u32x4*)(VL + tok * 136 + k0) = *(const u32x4*)(P0 + (size_t)tok * EVIN + 3072 + k0); }
    const int mt = w >> 1, sseg = tid >> 7, skd = tid & 127;
    u32x4 pq[2], pf[2][2], pg[2];
#pragma unroll
    for (int i = 0; i < 2; ++i) { const int idx = tid + 512 * i, tok = idx >> 4, k0 = (idx & 15) * 8; const bf16_t* rp = P0 + (size_t)tok * EVIN + k0;
        pf[0][i] = *(const u32x4*)(rp + 1024); pf[1][i] = *(const u32x4*)(rp + 2048); pq[i] = *(const u32x4*)rp; }
    { const int t = tid >> 3, v0 = (tid & 7) * 16; pg[0] = *(const u32x4*)(P0 + (size_t)t * EVIN + 4096 + v0); pg[1] = *(const u32x4*)(P0 + (size_t)t * EVIN + 4096 + v0 + 8); }
    f32x4 lbv[2][2], gnv[4];
    { const int k0 = (tid & 15) * 8, v0 = (tid & 7) * 16;
#pragma unroll
      for (int d = 0; d < 2; ++d) { lbv[d][0] = *(const f32x4*)(LB + d * 1024 + h * 128 + k0); lbv[d][1] = *(const f32x4*)(LB + d * 1024 + h * 128 + k0 + 4); }
#pragma unroll
      for (int i = 0; i < 4; ++i) gnv[i] = *(const f32x4*)(P.in[I_HGNG] + v0 + 4 * i); }
    LAS unsigned char* IMG = F.lds + 131584; f32x4 wt[4]; const int tile0 = 4224 + 4 * item; const bool host = tile0 + 3 < 12288;
    TrTile tcur = tr_moe_desc(P, 0, host ? tile0 : 0, WSP(bf16_t, WS_WGU), WSP(bf16_t, WS_WDN)); if (host) t4_issue(tcur, wt, tid);
    f32x4 oacc[4]; for (int i = 0; i < 4; ++i) oacc[i] = (f32x4){0, 0, 0, 0};
#pragma unroll
    for (int dir = 0; dir < 2; ++dir) {
#pragma unroll
        for (int i = 0; i < 2; ++i) { const int idx = tid + 512 * i, tok = idx >> 4, k0 = (idx & 15) * 8; float x[8], kk[8]; cv8(pf[dir][i], x);
#pragma unroll
            for (int j = 0; j < 8; ++j) { const float lb = lbv[dir][j >> 2][j & 3], f = lb + (1.0f - lb) * sigmoidf_(x[j]); BF[tok * 128 + k0 + j] = __logf(f); kk[j] = 1.0f - f; }
            *(LAS u32x4*)(KH + tok * 136 + k0) = (u32x4){pk2(kk[0], kk[1]), pk2(kk[2], kk[3]), pk2(kk[4], kk[5]), pk2(kk[6], kk[7])}; }
        u32x4 stv[4];
        { asm volatile("" ::: "memory"); const bf16_t* SS = WSP(bf16_t, WS_SST) + (size_t)((bh * 2 + dir) * NCHUNK + c) * 16384;
#pragma unroll
          for (int i = 0; i < 4; ++i) { const int idx = tid + 512 * i; stv[i] = *(const u32x4*)(SS + (idx >> 4) * 128 + (idx & 15) * 8); } }
        __syncthreads();
        { float tot = 0.f;
#pragma unroll
          for (int s = 0; s < 16; ++s) { const int ss = sseg * 16 + s, t = dir ? 63 - ss : ss; tot += BF[t * 128 + skd]; }
          SEG[sseg * 128 + skd] = tot; }
        if (host) t4_lds(tcur, wt, IMG, tid);
        __syncthreads();
        if (host) t4_store(tcur, IMG, tid);
        { float run = 0.f;
#pragma unroll
          for (int k = 0; k < 3; ++k) run += (k < sseg) ? SEG[k * 128 + skd] : 0.f;
#pragma unroll
          for (int s = 0; s < 16; ++s) { const int ss = sseg * 16 + s, t = dir ? 63 - ss : ss; run += BF[t * 128 + skd]; BF[t * 128 + skd] = run; if (ss == 31) REFV[skd] = run; } }
#pragma unroll
        for (int i = 0; i < 4; ++i) { const int idx = tid + 512 * i; *(LAS u32x4*)(ST + (idx >> 4) * 136 + (idx & 15) * 8) = stv[i]; }
        if (host) { asm volatile("" ::: "memory"); tcur = tr_moe_desc(P, 0, tile0 + 2 * dir + 1, WSP(bf16_t, WS_WGU), WSP(bf16_t, WS_WDN)); t4_issue(tcur, wt, tid); }
        __syncthreads();
#pragma unroll
        for (int i = 0; i < 2; ++i) { const int idx = tid + 512 * i, tok = idx >> 4, k0 = (idx & 15) * 8; float xq[8], xk[8];
            cv8(pq[i], xq); { const u32x4 kw = *(const LAS u32x4*)(KH + tok * 136 + k0); xk[0] = bflo(kw.x); xk[1] = bfhi(kw.x); xk[2] = bflo(kw.y); xk[3] = bfhi(kw.y); xk[4] = bflo(kw.z); xk[5] = bfhi(kw.z); xk[6] = bflo(kw.w); xk[7] = bfhi(kw.w); }
            unsigned qw[4], kw2[4];
#pragma unroll
            for (int j = 0; j < 8; j += 2) { const float d0 = BF[tok * 128 + k0 + j] - REFV[k0 + j], d1 = BF[tok * 128 + k0 + j + 1] - REFV[k0 + j + 1];
                qw[j >> 1] = pk2(xq[j] * __expf(d0), xq[j + 1] * __expf(d1)); kw2[j >> 1] = pk2(xk[j] * __expf(-d0), xk[j + 1] * __expf(-d1)); }
            *(LAS u32x4*)(QH + tok * 136 + k0) = (u32x4){qw[0], qw[1], qw[2], qw[3]}; *(LAS u32x4*)(KH + tok * 136 + k0) = (u32x4){kw2[0], kw2[1], kw2[2], kw2[3]}; }
        __syncthreads();
#pragma unroll
        for (int tt = 0; tt < 2; ++tt) { const int nt = 2 * (w & 1) + tt; f32x4 acc = {0, 0, 0, 0};
#pragma unroll
            for (int ks = 0; ks < 4; ++ks) acc = mfma16(lds_frag(QH, 136, 16 * mt, 32 * ks, lane), lds_frag(KH, 136, 16 * nt, 32 * ks, lane), acc);
#pragma unroll
            for (int r = 0; r < 4; ++r) { const int t = 16 * mt + 4 * q + r, s = 16 * nt + l15; const bool keep = dir ? (s >= t) : (s <= t); ATT[t * 72 + s] = f2bf(keep ? acc[r] : 0.f); } }
        if (host) t4_lds(tcur, wt, IMG, tid);
        __syncthreads();
        if (host) { t4_store(tcur, IMG, tid); if (dir == 0) { tcur = tr_moe_desc(P, 0, tile0 + 2, WSP(bf16_t, WS_WGU), WSP(bf16_t, WS_WDN)); t4_issue(tcur, wt, tid); } }
#pragma unroll
        for (int tt = 0; tt < 4; ++tt) { const int nt = 4 * (w & 1) + tt;
#pragma unroll
            for (int ks = 0; ks < 2; ++ks) oacc[tt] = mfma16(lds_frag(ATT, 72, 16 * mt, 32 * ks, lane), tr_frag(VL, 136, 32 * ks, 16 * nt, lane), oacc[tt]);
#pragma unroll
            for (int ks = 0; ks < 4; ++ks) oacc[tt] = mfma16(lds_frag(QH, 136, 16 * mt, 32 * ks, lane), lds_frag(ST, 136, 16 * nt, 32 * ks, lane), oacc[tt]); }
        __syncthreads();
    }
#pragma unroll
    for (int tt = 0; tt < 4; ++tt) { const int nt = 4 * (w & 1) + tt;
#pragma unroll
        for (int r = 0; r < 4; ++r) OST[(16 * mt + 4 * q + r) * 132 + 16 * nt + l15] = oacc[tt][r]; }
    __syncthreads();
    {   const int t = tid >> 3, v0 = (tid & 7) * 16; float o[16]; float ss = 0.f;
#pragma unroll
        for (int j = 0; j < 16; ++j) { o[j] = OST[t * 132 + v0 + j]; ss += o[j] * o[j]; }
        ss = row8_sum(ss);
        const float rs = rsqrtf(ss * (1.0f / 128.0f) + EPS);
        float gza[8], gzb[8]; cv8(pg[0], gza); cv8(pg[1], gzb);
        float ov[16];
#pragma unroll
        for (int j = 0; j < 16; ++j) { const float gn = gnv[j >> 2][j & 3]; const float z = j < 8 ? gza[j & 7] : gzb[j & 7]; ov[j] = o[j] * rs * gn * siluf_(z); }
        unsigned char* dst = WSP(unsigned char, WS_OCAT0) + (r0 + t) * DM + h * 128 + v0;
        *(u32x4*)dst = (u32x4){cvt4_fp8(ov[0], ov[1], ov[2], ov[3]), cvt4_fp8(ov[4], ov[5], ov[6], ov[7]), cvt4_fp8(ov[8], ov[9], ov[10], ov[11]), cvt4_fp8(ov[12], ov[13], ov[14], ov[15])}; }
    __syncthreads();
}
DI void s5y_group(const Params& P, const Frame& F, int gtask) {
    const int g = gtask >> 2, mt_lo = 17 * (gtask & 3), mt_hi = mt_lo + 17 < 66 ? mt_lo + 17 : 66;
    LAS bf16_t* WYq = (LAS bf16_t*)F.lds;
    LAS float* YT = (LAS float*)(F.lds + 66560) + F.wave * 272;
    const bf16_t* P0 = WSP(bf16_t, WS_P0); const bf16_t* WY = WSP(bf16_t, WS_S5WY) + (size_t)g * 256 * 512; const bf16_t* X0 = WSP(bf16_t, WS_X0);
    const int lane = F.lane, l15 = lane & 15, q = lane >> 4;
    float gw[16];
#pragma unroll
    for (int c = 0; c < 16; ++c) gw[c] = P.in[I_S5GLUW][(g * 16 + c) * 16 + l15];
    const float gb = P.in[I_S5GLUB][g * 16 + l15];
    for (int nq = 0; nq < 4; ++nq) {
        __syncthreads();
#pragma unroll
        for (int i = 0; i < 8; ++i) { const int idx = F.tid + 512 * i, row = idx >> 6, ch = idx & 63; *(LAS u32x4*)(WYq + row * 520 + ch * 8) = *(const u32x4*)(WY + (size_t)(nq * 64 + row) * 512 + ch * 8); }
        __syncthreads();
        for (int mt = mt_lo + F.wave; mt < mt_hi; mt += 8) { bf16x8 a[16];
#pragma unroll
            for (int ks = 0; ks < 8; ++ks) a[ks] = s5_ufrag(P0, g, mt, ks, lane);
            { const int cr = 16 * mt + l15, b = cr / S5NCH, n = cr % S5NCH; const bf16_t* xp = X0 + ((size_t)(b * 64 + g) * S5NCH + n) * 256 + 8 * q;
#pragma unroll
              for (int ks = 0; ks < 8; ++ks) a[8 + ks] = *(const bf16x8*)(xp + 32 * ks); }
#pragma unroll 1
            for (int nt = 0; nt < 4; ++nt) { f32x4 acc = {0, 0, 0, 0};
#pragma unroll
                for (int ks = 0; ks < 16; ++ks) acc = mfma16(a[ks], lds_frag(WYq, 520, 16 * nt, 32 * ks, lane), acc);
                float y[4];
#pragma unroll
                for (int r = 0; r < 4; ++r) { const float x = acc[r], u = 0.7978845608f * (x + 0.044715f * x * x * x); y[r] = 0.5f * x * (2.0f - 2.0f * rcpf_(1.0f + __expf(2.0f * u))); YT[(4 * q + r) * 17 + l15] = y[r]; }
                const int j = 4 * nq + nt;
#pragma unroll
                for (int r = 0; r < 4; ++r) { float z = gb;
#pragma unroll
                    for (int c = 0; c < 16; ++c) z += YT[(4 * q + r) * 17 + c] * gw[c];
                    const int cr = 16 * mt + 4 * q + r;
                    float outv = y[r] * sigmoidf_(z);
#ifdef MK_DBG_NO_S5
                    outv = 0.f;
#endif
                    WSP(unsigned char, WS_OCAT0)[(size_t)(cr * 16 + j) * DM + 1024 + g * 16 + l15] = (unsigned char)(cvt4_fp8(outv, 0.f, 0.f, 0.f) & 0xffu); }
            }
        }
    }
    __syncthreads();
}
DI void e2c(const Params& P, const Frame& F, int rep) {
    BLK_QUEUE_LOOP(WSP(unsigned, WS_CTL) + 192 + rep, 256 + NB * HGH * NCHUNK, { if (task < 256) s5y_group(P, F, task); else hgc_item(P, F, task - 256); });
}
DI void row_post_mixer(const Params& P, const Frame& F, int layer) {
    LAS float* RWT = (LAS float*)F.lds;
    { const float* rw = P.in[I_ROUTER] + (size_t)layer * DM * NEXP; f32x4 rv[16];
#pragma unroll
      for (int j = 0; j < 16; ++j) rv[j] = *(const f32x4*)(rw + (size_t)(F.tid + 512 * j) * 4);
#pragma unroll
      for (int j = 0; j < 16; ++j) { const int i4 = F.tid + 512 * j, k = i4 >> 2, e0 = (i4 & 3) * 4;
#pragma unroll
          for (int jj = 0; jj < 4; ++jj) RWT[(e0 + jj) * DM + k] = rv[j][jj]; } }
    __syncthreads();
    const float* modv = WSP(float, WS_MODV); const float* ng = P.in[I_NORMG] + (size_t)layer * 4 * DM;
    const int nrows = layer == 0 ? RR : NB * NLAT, lane = F.lane, stride = F.G * 8;
    for (int rr0 = F.bid * 8 + F.wave; rr0 < nrows; rr0 += 2 * stride) {
        int b[2], t[2]; bool ok[2]; f32x4 v[2][8], x[2][8]; const float* m[2]; float* xo[2];
#pragma unroll
        for (int u = 0; u < 2; ++u) { int rr = rr0 + u * stride; ok[u] = rr < nrows; if (!ok[u]) rr = rr0;
            const bf16_t* mix;
            if (layer == 0) { b[u] = rr / TT; t[u] = rr % TT; mix = WSP(bf16_t, WS_MIX) + (size_t)rr * DM; } else { b[u] = rr / NLAT; t[u] = LCTX + rr % NLAT; mix = WSP(bf16_t, WS_MIX1) + (size_t)rr * DM; }
            const int mi = t[u] < LCTX ? 2 : b[u]; m[u] = modv + (size_t)(layer * 3 + mi) * 12288; xo[u] = stream_row_out(P, b[u], t[u]);
#pragma unroll
            for (int i = 0; i < 8; ++i) { const u32x2 w2 = *(const u32x2*)(mix + i * 256 + lane * 4); v[u][i] = (f32x4){bflo(w2.x), bfhi(w2.x), bflo(w2.y), bfhi(w2.y)}; }
            row_load(stream_row_in(P, layer, b[u], t[u]), lane, x[u]); }
#pragma unroll
        for (int u = 0; u < 2; ++u) { const float rs = row_rs(v[u]);
#pragma unroll
            for (int i = 0; i < 8; ++i) { const int c = i * 256 + lane * 4; const f32x4 g = *(const f32x4*)(ng + 1 * DM + c), m2 = *(const f32x4*)(m[u] + 2 * DM + c);
#ifndef MK_DBG_NOUPD
                x[u][i] = x[u][i] + m2 * (v[u][i] * rs * g);
#endif
                if (ok[u]) *(f32x4*)(xo[u] + c) = x[u][i]; }
            row_norm_mod8(x[u], ng + 2 * DM, m[u] + 3 * DM, m[u] + 4 * DM, WSP(unsigned char, WS_HA8) + (size_t)(b[u] * TT + t[u]) * DM, lane, ok[u]); }
        float pa[2][16];
#pragma unroll
        for (int e = 0; e < 16; ++e) { f32x2 s0 = {0.f, 0.f}, s1 = {0.f, 0.f};
#pragma unroll
            for (int i = 0; i < 8; ++i) { const f32x4 w = *(const LAS f32x4*)(RWT + e * DM + i * 256 + lane * 4); const f32x2 wl = {w[0], w[1]}, wh = {w[2], w[3]};
                s0 += wl * (f32x2){x[0][i][0], x[0][i][1]}; s0 += wh * (f32x2){x[0][i][2], x[0][i][3]}; s1 += wl * (f32x2){x[1][i][0], x[1][i][1]}; s1 += wh * (f32x2){x[1][i][2], x[1][i][3]}; }
            pa[0][e] = s0[0] + s0[1]; pa[1][e] = s1[0] + s1[1]; asm volatile("" ::: "memory"); }
        float mine[2];
#pragma unroll
        for (int u = 0; u < 2; ++u) {
#pragma unroll
            for (int j = 0; j < 8; ++j) { const bool hi = lane & 1; const float keep = hi ? pa[u][2 * j + 1] : pa[u][2 * j], send = hi ? pa[u][2 * j] : pa[u][2 * j + 1]; pa[u][j] = keep + xor1f(send); }
#pragma unroll
            for (int j = 0; j < 4; ++j) { const bool hi = lane & 2; const float keep = hi ? pa[u][2 * j + 1] : pa[u][2 * j], send = hi ? pa[u][2 * j] : pa[u][2 * j + 1]; pa[u][j] = keep + xor2f(send); }
#pragma unroll
            for (int j = 0; j < 2; ++j) { const bool hi = lane & 4; const float keep = hi ? pa[u][2 * j + 1] : pa[u][2 * j], send = hi ? pa[u][2 * j] : pa[u][2 * j + 1]; pa[u][j] = keep + __shfl_xor(send, 4); }
            { const bool hi = lane & 8; const float keep = hi ? pa[u][1] : pa[u][0], send = hi ? pa[u][0] : pa[u][1]; float v = keep + __shfl_xor(send, 8); v += __shfl_xor(v, 16); v += __shfl_xor(v, 32); mine[u] = v; } }
#pragma unroll
        for (int u = 0; u < 2; ++u) { float mx = mine[u];
            mx = row16_max(mx);
            const float ex = __expf(mine[u] - mx); float den = ex;
            den = row16_sum(den);
            if (lane < 16 && ok[u]) { const float a = ex * rcpf_(den);
                if (t[u] < LCTX) WSP(float, WS_AFFC)[(size_t)(b[u] * 16 + lane) * LCTX + t[u]] = a; else WSP(float, WS_AFF)[(size_t)(b[u] * 16 + lane) * NLAT + (t[u] - LCTX)] = a; } }
    }
}
DI void topk_task(const Params& P, const Frame& F, const float* vals, int n, int K, int srow0  , int e, int stack0  ) {
    LAS unsigned* keys = (LAS unsigned*)F.lds;
    LAS unsigned* hist = (LAS unsigned*)(F.lds + 32768);
    LAS unsigned* wsum = (LAS unsigned*)(F.lds + 32768 + 1024);
    LAS unsigned* sel = (LAS unsigned*)(F.lds + 32768 + 1024 + 64);
    LAS int* srcl = (LAS int*)(F.lds + 36864);
    const int tid = F.tid;
    for (int i = tid; i < n; i += 512) keys[i] = __float_as_uint(vals[i]);
    if (tid == 0) { sel[0] = 0u; sel[1] = (unsigned)K; }
    unsigned mask = 0u;
#pragma unroll 1
    for (int shift = 24; shift >= 0; shift -= 8) {
        if (tid < 256) hist[tid] = 0u;
        __syncthreads();
        const unsigned prefix = sel[0];
        for (int i = tid; i < n; i += 512) { const unsigned k = keys[i]; if ((k & mask) == prefix) (void)__hip_atomic_fetch_add(&hist[(k >> shift) & 255u], 1u, __ATOMIC_RELAXED, __HIP_MEMORY_SCOPE_WORKGROUP); }
        __syncthreads();
        if (F.wave == 0) {
            const unsigned kk = sel[1]; const int l = F.lane; unsigned c[4];
#pragma unroll
            for (int j = 0; j < 4; ++j) c[j] = hist[255 - 4 * l - j];
            const unsigned mysum = (c[0] + c[1]) + (c[2] + c[3]); unsigned incl = mysum;
#pragma unroll
            for (int o = 1; o < 64; o <<= 1) { const unsigned v = __shfl_up(incl, o); if (l >= o) incl += v; }
            const unsigned long long bal = __ballot(incl >= kk); const int first = bal ? __builtin_ctzll(bal) : 63;
            if (l == first) { unsigned cum = incl - mysum; int j = 0;
#pragma unroll
                for (; j < 3; ++j) { if (cum + c[j] >= kk) break; cum += c[j]; }
                sel[0] = prefix | ((unsigned)(255 - 4 * l - j) << shift); sel[1] = kk - cum; } }
        mask |= 255u << shift;
        __syncthreads();
    }
    const unsigned thr = sel[0], need_eq = sel[1], total_gt = (unsigned)K - need_eq;
    const int per = (n + 511) / 512, i0 = tid * per;
    unsigned cnt = 0u;
    for (int j = 0; j < per; ++j) { const int i = i0 + j; if (i < n) { const unsigned k = keys[i]; cnt += (k > thr ? 1u : 0u) + (k == thr ? 65536u : 0u); } }
    unsigned inc = cnt;
#pragma unroll
    for (int o = 1; o < 64; o <<= 1) { const unsigned v = __shfl_up(inc, o); if (F.lane >= o) inc += v; }
    if (F.lane == 63) wsum[F.wave] = inc;
    __syncthreads();
    unsigned base = 0u;
    for (int w = 0; w < F.wave; ++w) base += wsum[w];
    unsigned run = base + inc - cnt;
    unsigned rgt = run & 0xffffu, req = run >> 16;
    float* gatev = WSP(float, WS_GATEV); int* idxo = WSP(int, WS_IDX); int* slot = WSP(int, WS_SLOT);
    for (int j = 0; j < per; ++j) { const int i = i0 + j; if (i < n) { const unsigned k = keys[i]; int s = -1;
        if (k > thr) { s = (int)rgt; ++rgt; } else if (k == thr) { if (req < need_eq) s = (int)(total_gt + req); ++req; }
        slot[(size_t)(srow0 + i) * 16 + e] = s;
        if (s >= 0) { gatev[stack0 + s] = __uint_as_float(k); idxo[stack0 + s] = srow0 + i; srcl[s] = srow0 + i; } } }
    __syncthreads();
    {
        unsigned* vt = WSP(unsigned, WS_VOFF); const int tile0 = stack0 >> 8, row00 = stack0 & 255, ntile = (K + 255) >> 8;
        for (int tl = 0; tl < ntile; ++tl)
#pragma unroll
            for (int hi = 0; hi < 4; ++hi) { int R, C; pg8::stage_rc(tid * 16 + (hi & 1) * 8192, R, C); const int row = tl * 256 + (hi >> 1) * 128 + R - row00;
                const bool mine = row >= 0 && row < K, dummy = (K < 256) && row00 == 0 && (row >= 64);
                if (mine || dummy) vt[((size_t)(tile0 + tl) * 512 + tid) * 4 + hi] = (unsigned)((mine ? srcl[row] : 0) * (DM / 2) + C) * 2u; }
    }
    __syncthreads();
}
DI void moe_topk(const Params& P, const Frame& F, int layer) {
    const int ntask = layer == 0 ? 64 : 32;
    for (int task = F.bid; task < ntask; task += F.G) {
        if (task < 32) { const int b = task >> 4, e = task & 15; topk_task(P, F, WSP(float, WS_AFF) + (size_t)task * NLAT, NLAT, CAPL, b * TT + LCTX, e, task * 1024); }
        else { const int t2 = task - 32, b = t2 >> 4, e = t2 & 15; topk_task(P, F, WSP(float, WS_AFFC) + (size_t)t2 * LCTX, LCTX, CAPC, b * TT, e, 32768 + e * 256 + b * 32); }
    }
}
DI void moe_gather(const Params& P, const Frame& F, int layer) {
    const int nrows = 32768 + (layer == 0 ? 1024 : 0); const int* idx = WSP(int, WS_IDX); const bf16_t* HA = WSP(bf16_t, WS_HA); bf16_t* XS = WSP(bf16_t, WS_XS);
    for (int r = F.bid * 8 + F.wave; r < nrows; r += F.G * 8) { int st = r; if (r >= 32768) { const int qq = r - 32768; st = 32768 + (qq >> 6) * 256 + (qq & 63); }
        const int srow = idx[st]; const u32x4* s = (const u32x4*)(HA + (size_t)srow * DM); u32x4* d = (u32x4*)(XS + (size_t)st * DM);
#pragma unroll
        for (int i = 0; i < 4; ++i) d[i * 64 + F.lane] = s[i * 64 + F.lane]; }
}
DI void moe_combine(const Params& P, const Frame& F, int layer) {
    const float* modv = WSP(float, WS_MODV); const float* ng = P.in[I_NORMG] + (size_t)layer * 4 * DM; const int* slot = WSP(int, WS_SLOT); const bf16_t* Y = WSP(bf16_t, WS_Y);
    const int nrows = layer == 0 ? RR : NB * NLAT, lane = F.lane, stride = F.G * 8;
    for (int rr0 = F.bid * 8 + F.wave; rr0 < nrows; rr0 += 2 * stride) {
        int b[2], t[2], r[2]; bool ok[2]; const float* m[2]; f32x4 acc[2][8], x[2][8];
#pragma unroll
        for (int u = 0; u < 2; ++u) { int rr = rr0 + u * stride; ok[u] = rr < nrows; if (!ok[u]) rr = rr0;
            if (layer == 0) { b[u] = rr / TT; t[u] = rr % TT; } else { b[u] = rr / NLAT; t[u] = LCTX + rr % NLAT; }
            r[u] = b[u] * TT + t[u]; const int mi = t[u] < LCTX ? 2 : b[u]; m[u] = modv + (size_t)(layer * 3 + mi) * 12288;
            row_load(stream_row_in(P, 1, b[u], t[u]), lane, x[u]);
#pragma unroll
            for (int i = 0; i < 8; ++i) acc[u][i] = (f32x4){0, 0, 0, 0}; }
        int sl[2][16];
#pragma unroll
        for (int u = 0; u < 2; ++u)
#pragma unroll
            for (int e = 0; e < 16; ++e) sl[u][e] = __builtin_amdgcn_readfirstlane(slot[(size_t)r[u] * 16 + e]);
#pragma unroll
        for (int e = 0; e < 16; ++e)
#pragma unroll
            for (int u = 0; u < 2; ++u) { const int s = sl[u][e];
                if (s >= 0) { const size_t yrow = t[u] >= LCTX ? (size_t)(b[u] * 16 + e) * 1024 + s : (size_t)32768 + e * 256 + b[u] * 32 + s; const bf16_t* yp = Y + yrow * DM + lane * 4;
#pragma unroll
                    for (int i = 0; i < 8; ++i) { const u32x2 w = *(const u32x2*)(yp + i * 256); acc[u][i][0] += bflo(w.x); acc[u][i][1] += bfhi(w.x); acc[u][i][2] += bflo(w.y); acc[u][i][3] += bfhi(w.y); } } }
#pragma unroll
        for (int u = 0; u < 2; ++u) { const float rs = row_rs(acc[u]); float* xo = stream_row_out(P, b[u], t[u]);
#pragma unroll
            for (int i = 0; i < 8; ++i) { const int c = i * 256 + lane * 4; const f32x4 g = *(const f32x4*)(ng + 3 * DM + c), m5 = *(const f32x4*)(m[u] + 5 * DM + c);
                x[u][i] = x[u][i] + m5 * (acc[u][i] * rs * g); if (ok[u]) *(f32x4*)(xo + c) = x[u][i]; }
            if (layer == 0) { const int mi = t[u] < LCTX ? 2 : b[u]; const float* m1 = modv + (size_t)(1 * 3 + mi) * 12288; row_norm_mod(x[u], P.in[I_NORMG] + (size_t)(1 * 4 + 0) * DM, m1, m1 + DM, WSP(bf16_t, WS_HA) + (size_t)r[u] * DM, lane, ok[u]);
                if (ok[u]) { unsigned char* d8 = WSP(unsigned char, WS_HA8B) + (size_t)r[u] * DM;
#pragma unroll
                    for (int i = 0; i < 8; ++i) *(unsigned*)(d8 + i * 256 + lane * 4) = cvt4_fp8(x[u][i][0], x[u][i][1], x[u][i][2], x[u][i][3]); } } }
    }
}
DI void cv_unpack(const u32x4& w, float (&o)[8]) { o[0] = bflo(w.x); o[1] = bfhi(w.x); o[2] = bflo(w.y); o[3] = bfhi(w.y); o[4] = bflo(w.z); o[5] = bfhi(w.z); o[6] = bflo(w.w); o[7] = bfhi(w.w); }
DI void dn_conv_walk(const Params& P, int b, int isctx, int gy, int cg, int xs, int lane) {
    const bf16_t* PQ = WSP(bf16_t, WS_PQ); bf16_t* QC = WSP(bf16_t, WS_QKVC); const float* CW = P.in[I_ODCONV];
    const int ch0 = (cg * 64 + lane) * 8, nx = isctx ? LCTX : 64;
    const size_t rowbase = (size_t)b * TT + (isctx ? 0 : LCTX + gy * 64);
    const bool up = !isctx && gy > 0, dn = !isctx && gy < 127;
    float wgt[9][8];
#pragma unroll
    for (int k = 0; k < 9; ++k) { const f32x4 w0 = *(const f32x4*)(CW + (size_t)k * DNQKV + ch0), w1 = *(const f32x4*)(CW + (size_t)k * DNQKV + ch0 + 4);
#pragma unroll
        for (int j = 0; j < 4; ++j) { wgt[k][j] = w0[j]; wgt[k][4 + j] = w1[j]; } }
#pragma unroll
    for (int kx = 0; kx < 3; ++kx)
#pragma unroll
        for (int j = 0; j < 8; ++j) { if (!up) wgt[kx][j] = 0.f; if (!dn) wgt[6 + kx][j] = 0.f; }
    const u32x4 zero = {0u, 0u, 0u, 0u};
    u32x4 raw[3][3];
    float fc[3][3][8];
#define CV_LOAD(dst, x) do { const int xc = (x) < 0 ? 0 : ((x) >= nx ? nx - 1 : (x)); const bf16_t* pp = PQ + (rowbase + xc) * DNQKV + ch0; \
        dst[0] = *(const u32x4*)(pp - (up ? (size_t)64 * DNQKV : 0)); dst[1] = *(const u32x4*)pp; dst[2] = *(const u32x4*)(pp + (dn ? (size_t)64 * DNQKV : 0)); } while (0)
#define CV_CONV(slot, x) do { cv_unpack(raw[slot][0], fc[slot][0]); cv_unpack(raw[slot][1], fc[slot][1]); cv_unpack(raw[slot][2], fc[slot][2]); \
        if (!((x) >= 0 && (x) < nx)) { _Pragma("unroll") for (int ky_ = 0; ky_ < 3; ++ky_) _Pragma("unroll") for (int e_ = 0; e_ < 8; ++e_) fc[slot][ky_][e_] = 0.f; } } while (0)
    CV_LOAD(raw[0], xs - 1); CV_LOAD(raw[1], xs); CV_LOAD(raw[2], xs + 1);
    CV_CONV(0, xs - 1); CV_CONV(1, xs); CV_CONV(2, xs + 1);
    CV_LOAD(raw[0], xs + 2); CV_LOAD(raw[1], xs + 3); CV_LOAD(raw[2], xs + 4);
#pragma unroll 1
    for (int x0 = xs; x0 < xs + 32; x0 += 3) {
#pragma unroll
        for (int j = 0; j < 3; ++j) { const int x = x0 + j;
            float acc[8];
#pragma unroll
            for (int e = 0; e < 8; e += 2) { f32x2 a2 = (f32x2){fc[j][0][e], fc[j][0][e + 1]} * (f32x2){wgt[0][e], wgt[0][e + 1]};
#pragma unroll
                for (int ky = 0; ky < 3; ++ky)
#pragma unroll
                    for (int kx = 0; kx < 3; ++kx) { if (ky == 0 && kx == 0) continue; const int sl = (j + kx) % 3;
                        a2 = __builtin_elementwise_fma((f32x2){fc[sl][ky][e], fc[sl][ky][e + 1]}, (f32x2){wgt[ky * 3 + kx][e], wgt[ky * 3 + kx][e + 1]}, a2); }
                acc[e] = a2[0]; acc[e + 1] = a2[1]; }
            CV_CONV(j, x + 2);
            CV_LOAD(raw[j], x + 5);
            float ss = 0.f;
#pragma unroll
            for (int e = 0; e < 8; ++e) { acc[e] = siluf_(acc[e]); ss += acc[e] * acc[e]; }
            if (cg < 8) { ss = row16_sum(ss); const float rs = rsqrtf(ss + EPS);
#pragma unroll
                for (int e = 0; e < 8; ++e) acc[e] *= rs; }
            if (x < xs + 32) { bf16_t* orow = QC + (rowbase + x) * DNQKV;
                if (cg < 8) {
                    const int cc = (ch0 & 31) >> 3; bf16_t* dst = orow + (ch0 & ~31) + 16 * (cc & 1) + 4 * (cc >> 1);
                    *(u32x2*)dst = (u32x2){pk2(acc[0], acc[1]), pk2(acc[2], acc[3])}; *(u32x2*)(dst + 8) = (u32x2){pk2(acc[4], acc[5]), pk2(acc[6], acc[7])}; }
                else *(u32x4*)(orow + ch0) = (u32x4){pk2(acc[0], acc[1]), pk2(acc[2], acc[3]), pk2(acc[4], acc[5]), pk2(acc[6], acc[7])}; }
        }
    }
#undef CV_CONV
#undef CV_LOAD
}
DI void dn_conv(const Params& P, const Frame& F, int rep) {
    const float* GA = WSP(float, WS_GATES); float* G2 = WSP(float, WS_G2); const int lane = F.lane;
    unsigned* ctr = WSP(unsigned, WS_CTL) + 64 + rep;
    for (;;) { unsigned t = 0; if (lane == 0) t = __hip_atomic_fetch_add(ctr, 1u, __ATOMIC_RELAXED, __HIP_MEMORY_SCOPE_AGENT); t = __builtin_amdgcn_readfirstlane(t);
        if (t >= 256u + 8192u) break;
        if (t < 256u) dn_conv_walk(P, (int)t >> 7, 1, 0, ((int)t >> 3) & 15, ((int)t & 7) * 32, lane);
        else { const int u = (int)t - 256; dn_conv_walk(P, u >> 12, 0, (u >> 5) & 127, (u >> 1) & 15, (u & 1) * 32, lane); } }
    for (int r = F.bid * 8 + F.wave; r < RR; r += F.G * 8) {
#pragma unroll
        for (int hh = 0; hh < 2; ++hh) { const int j = lane + 64 * hh; const float x = GA[(size_t)r * 128 + j]; float o;
            if (j < 64) o = sigmoidf_(x);
            else { const int dh = j - 64; const float y = x + P.in[I_ODDTB][dh]; const float sp = y > 20.f ? y : log1pf(__expf(y)); o = -__expf(P.in[I_ODALOG][dh]) * sp; }
            G2[(size_t)r * 128 + j] = o; }
    }
}
DI int dn_perm(int j) { return (j & ~31) + 8 * ((j & 15) >> 2) + 4 * ((j >> 4) & 1) + (j & 3); }
DI int dn_seq_to_chunk(int dir, int n) { return dir ? (n < 4 ? 3 - n : NCHUNK + 3 - n) : n; }
DI bf16x8 pp_pack(const f32x4& a, const f32x4& b) { return __builtin_bit_cast(bf16x8, (u32x4){pk2(a[0], a[1]), pk2(a[2], a[3]), pk2(b[0], b[1]), pk2(b[2], b[3])}); }
DI void dn_prep_variant(const Params& P, int vid, int lane) {
    const int chain = vid / NCHUNK, seq = vid % NCHUNK, dir = chain & 1, hv = (chain >> 1) & 31, b = chain >> 6, hqk = hv >> 1, c = dn_seq_to_chunk(dir, seq), l15 = lane & 15, q = lane >> 4;
    const size_t r0 = (size_t)b * TT + c * 64;
    const bf16_t* QC = WSP(bf16_t, WS_QKVC); const float* G2 = WSP(float, WS_G2);
    float gcs, bes;
    { const size_t rw = r0 + (dir ? 63 - lane : lane); const float g = G2[rw * 128 + 64 + dir * 32 + hv]; bes = G2[rw * 128 + dir * 32 + hv]; float inc = g;
#pragma unroll
      for (int o = 1; o < 64; o <<= 1) { const float v = __shfl_up(inc, o); if (lane >= o) inc += v; }
      gcs = inc; WSP(float, WS_GC)[(size_t)vid * 64 + lane] = inc; }
    float gcc[4], bec[4];
#pragma unroll
    for (int t = 0; t < 4; ++t) { gcc[t] = __shfl(gcs, 16 * t + l15); bec[t] = __shfl(bes, 16 * t + l15); }
    bf16x8 kf[4][4];
    {   bf16x8 qf[4][4];
#pragma unroll
        for (int t = 0; t < 4; ++t) { const int sr = 16 * t + l15; const unsigned ro = (((unsigned)r0 + (unsigned)(dir ? 63 - sr : sr)) * (unsigned)DNQKV + (unsigned)(hqk * 128 + 8 * q)) * 2u;
#pragma unroll
            for (int ks = 0; ks < 4; ++ks) { kf[t][ks] = *(const bf16x8*)((const char*)QC + ro + (unsigned)(DNQK + 32 * ks) * 2u); qf[t][ks] = *(const bf16x8*)((const char*)QC + ro + (unsigned)(32 * ks) * 2u); } }
        bf16_t* QM = WSP(bf16_t, WS_QKM) + (size_t)vid * 4096;
#pragma unroll
        for (int jt = 0; jt < 4; ++jt) { float gcrj[4];
#pragma unroll
            for (int r = 0; r < 4; ++r) gcrj[r] = __shfl(gcs, 16 * jt + 4 * q + r);
#pragma unroll
            for (int it = 0; it < 4; ++it) { f32x4 acc = {0, 0, 0, 0};
                if (it >= jt) {
#pragma unroll
                    for (int ks = 0; ks < 4; ++ks) acc = mfma16(kf[jt][ks], qf[it][ks], acc); }
                float o[4];
#pragma unroll
                for (int r = 0; r < 4; ++r) { const int j = 16 * jt + 4 * q + r, i = 16 * it + l15; o[r] = (j <= i) ? 0.08838834764831845f * acc[r] * __expf(fminf(gcc[it] - gcrj[r], 0.f)) : 0.f; }
                *(u32x2*)(QM + (16 * it + l15) * 64 + 32 * (jt >> 1) + 8 * q + 4 * (jt & 1)) = (u32x2){pk2(o[0], o[1]), pk2(o[2], o[3])}; } }
    }
    f32x4 X[4][4], XT[4][4]; bf16x8 Mf[4][2];
#pragma unroll
    for (int rt = 0; rt < 4; ++rt) { float gcra[4], bera[4];
#pragma unroll
        for (int r = 0; r < 4; ++r) { gcra[r] = __shfl(gcs, 16 * rt + 4 * q + r); bera[r] = __shfl(bes, 16 * rt + 4 * q + r); }
#pragma unroll
        for (int ct = 0; ct < 4; ++ct) { f32x4 kk = {0, 0, 0, 0};
#pragma unroll
            for (int ks = 0; ks < 4; ++ks) kk = mfma16(kf[rt][ks], kf[ct][ks], kk);
#pragma unroll
            for (int r = 0; r < 4; ++r) { const int a = 16 * rt + 4 * q + r, bb = 16 * ct + l15;
                X[rt][ct][r] = (bb < a) ? -(bera[r] * kk[r] * __expf(fminf(gcra[r] - gcc[ct], 0.f))) : (a == bb ? 1.f : 0.f);
                XT[rt][ct][r] = (a < bb) ? -(bec[ct] * kk[r] * __expf(fminf(gcc[ct] - gcra[r], 0.f))) : (a == bb ? 1.f : 0.f); } } }
#pragma unroll
    for (int ib = 0; ib < 4; ++ib)
#pragma unroll
        for (int ks = 0; ks < 2; ++ks) { f32x4 m0, m1;
#pragma unroll
            for (int r = 0; r < 4; ++r) { m0[r] = ((16 * (2 * ks) + 4 * q + r) == (16 * ib + l15) ? 2.f : 0.f) - XT[2 * ks][ib][r]; m1[r] = ((16 * (2 * ks + 1) + 4 * q + r) == (16 * ib + l15) ? 2.f : 0.f) - XT[2 * ks + 1][ib][r]; }
            Mf[ib][ks] = pp_pack(m0, m1); }
#pragma unroll 1
    for (int it = 0; it < 5; ++it) {
        bf16x8 Xp[4][2], Xf[4][2], Qp[4][2];
#pragma unroll
        for (int t = 0; t < 4; ++t)
#pragma unroll
            for (int ks = 0; ks < 2; ++ks) { Xp[t][ks] = pp_pack(X[2 * ks][t], X[2 * ks + 1][t]); Xf[t][ks] = pp_pack(XT[2 * ks][t], XT[2 * ks + 1][t]); }
#pragma unroll
        for (int nt = 0; nt < 4; ++nt) { f32x4 qa[4];
#pragma unroll
            for (int ib = 0; ib < 4; ++ib) { f32x4 acc = {0, 0, 0, 0}; if (nt <= ib) { if (nt <= 1) acc = mfma16(Mf[ib][0], Xp[nt][0], acc); if (ib >= 2) acc = mfma16(Mf[ib][1], Xp[nt][1], acc); }
#pragma unroll
                for (int r = 0; r < 4; ++r) qa[ib][r] = ((16 * ib + 4 * q + r) == (16 * nt + l15) ? 2.f : 0.f) - acc[r]; }
            Qp[nt][0] = pp_pack(qa[0], qa[1]); Qp[nt][1] = pp_pack(qa[2], qa[3]); }
#pragma unroll
        for (int ib = 0; ib < 4; ++ib)
#pragma unroll
            for (int nt = 0; nt < 4; ++nt) { f32x4 a1 = {0, 0, 0, 0}, a2 = {0, 0, 0, 0};
                if (nt <= ib) {
                    if (nt <= 1) { a1 = mfma16(Xf[ib][0], Qp[nt][0], a1); a2 = mfma16(Qp[nt][0], Xf[ib][0], a2); }
                    if (ib >= 2) { a1 = mfma16(Xf[ib][1], Qp[nt][1], a1); a2 = mfma16(Qp[nt][1], Xf[ib][1], a2); } }
                X[ib][nt] = a1; XT[nt][ib] = a2; }
    }
    bf16_t* TM = WSP(bf16_t, WS_TM) + (size_t)vid * 4096;
#pragma unroll
    for (int nt = 0; nt < 4; ++nt)
#pragma unroll
        for (int ib = 0; ib < 4; ++ib) *(u32x2*)(TM + (16 * ib + l15) * 64 + 32 * (nt >> 1) + 8 * q + 4 * (nt & 1)) = (u32x2){pk2(XT[nt][ib][0], XT[nt][ib][1]), pk2(XT[nt][ib][2], XT[nt][ib][3])};
}
DI void dn_prep(const Params& P, const Frame& F) { for (int vid = F.wave * F.G + F.bid; vid < NB * 32 * 2 * NCHUNK; vid += F.G * 8) dn_prep_variant(P, vid, F.lane); }


constexpr int RC_K = 0, RC_Q = 17408, RC_V = 34816, RC_T = 44032, RC_QK = 53248, RC_SC = 62464, RC_STAGE = 63488;
struct RcG { u32x4 k[4], q[4], v[2], t[2], qk[2]; float be, gc, gcl; };
DI int rc_row(int b, int dir, int n, int s) { const int c = dn_seq_to_chunk(dir, n); return b * TT + c * 64 + (dir ? 63 - s : s); }
DI void rc_load(const Params& P, RcG& g, int b, int hv, int dir, int vhalf, int chain, int n, int ht) {
    const bf16_t* QC = WSP(bf16_t, WS_QKVC); const int hqk = hv >> 1;
#pragma unroll
    for (int i = 0; i < 4; ++i) { const int idx = ht + 256 * i, s = idx >> 4, ch = (idx & 15) * 8; const size_t r = rc_row(b, dir, n, s);
        g.k[i] = *(const u32x4*)(QC + r * DNQKV + DNQK + hqk * 128 + ch); g.q[i] = *(const u32x4*)(QC + r * DNQKV + hqk * 128 + ch); }
#pragma unroll
    for (int i = 0; i < 2; ++i) { const int idx = ht + 256 * i, s = idx >> 3, ch = (idx & 7) * 8; const size_t r = rc_row(b, dir, n, s);
        g.v[i] = *(const u32x4*)(QC + r * DNQKV + 2 * DNQK + hv * 128 + vhalf * 64 + ch); }
    const bf16_t* TM = WSP(bf16_t, WS_TM) + ((size_t)chain * NCHUNK + n) * 4096; const bf16_t* QM = WSP(bf16_t, WS_QKM) + ((size_t)chain * NCHUNK + n) * 4096;
#pragma unroll
    for (int i = 0; i < 2; ++i) { const int idx = ht + 256 * i; g.t[i] = *(const u32x4*)(TM + idx * 8); g.qk[i] = *(const u32x4*)(QM + idx * 8); }
#ifdef MK_PROBE_RCBW
    { u32x4 dk[4];
#pragma unroll
      for (int i = 0; i < 4; ++i) { const int idx = ht + 256 * i, s = idx >> 4, ch = (idx & 15) * 8; const size_t r = rc_row(b, dir, n, s); dk[i] = *(const u32x4*)(QC + r * DNQKV + 2 * DNQK + ((hv + 7) & 31) * 128 + ch); }
      asm volatile("" :: "v"(dk[0]), "v"(dk[1]), "v"(dk[2]), "v"(dk[3])); }
#endif
    { const int s = ht & 63; const float* gc = WSP(float, WS_GC) + ((size_t)chain * NCHUNK + n) * 64;
      g.be = WSP(float, WS_G2)[(size_t)rc_row(b, dir, n, s) * 128 + dir * 32 + hv]; g.gc = gc[s]; g.gcl = gc[63]; }
}
DI void rc_store(const RcG& g, LAS unsigned char* st, int ht) {
    LAS bf16_t* KL = (LAS bf16_t*)(st + RC_K); LAS bf16_t* QL = (LAS bf16_t*)(st + RC_Q); LAS bf16_t* VL = (LAS bf16_t*)(st + RC_V); LAS bf16_t* TL = (LAS bf16_t*)(st + RC_T); LAS bf16_t* QKL = (LAS bf16_t*)(st + RC_QK); LAS float* SC = (LAS float*)(st + RC_SC);
#pragma unroll
    for (int i = 0; i < 4; ++i) { const int idx = ht + 256 * i, s = idx >> 4, ch = (idx & 15) * 8; *(LAS u32x4*)(KL + s * 136 + ch) = g.k[i]; *(LAS u32x4*)(QL + s * 136 + ch) = g.q[i]; }
#pragma unroll
    for (int i = 0; i < 2; ++i) { const int idx = ht + 256 * i, s = idx >> 3, ch = (idx & 7) * 8; *(LAS u32x4*)(VL + s * 72 + ch) = g.v[i]; *(LAS u32x4*)(TL + s * 72 + ch) = g.t[i]; *(LAS u32x4*)(QKL + s * 72 + ch) = g.qk[i]; }
    if (ht < 64) { SC[ht] = g.be; SC[64 + ht] = __expf(g.gc); SC[128 + ht] = __expf(g.gcl - g.gc); if (ht == 0) SC[192] = __expf(g.gcl); }
#ifdef MK_PROBE_RCST2
    asm volatile("" ::: "memory");
#pragma unroll
    for (int i = 0; i < 4; ++i) { const int idx = ht + 256 * i, s = idx >> 4, ch = (idx & 15) * 8; *(LAS u32x4*)(KL + s * 136 + ch) = g.k[i]; *(LAS u32x4*)(QL + s * 136 + ch) = g.q[i]; }
#pragma unroll
    for (int i = 0; i < 2; ++i) { const int idx = ht + 256 * i, s = idx >> 3, ch = (idx & 7) * 8; *(LAS u32x4*)(VL + s * 72 + ch) = g.v[i]; *(LAS u32x4*)(TL + s * 72 + ch) = g.t[i]; *(LAS u32x4*)(QKL + s * 72 + ch) = g.qk[i]; }
#endif
}
DI bf16x8 rc_afrag(const LAS bf16_t* base, int ld, int row0, int k0, int lane) { return *(const LAS bf16x8*)(base + (row0 + (lane & 15)) * ld + k0 + 8 * (lane >> 4)); }
DI bf16x8 rc_afrag_tr(const LAS bf16_t* base, int ld, int mt, int k0, int lane) { const int g = lane >> 4, qq = (lane & 15) >> 2, pp = lane & 3; const LAS bf16_t* p = base + (k0 + 4 * g + qq) * ld + 32 * (mt >> 1) + 8 * pp + 4 * (mt & 1);
    const s16x4 a = __builtin_amdgcn_ds_read_tr16_b64_v4i16((LAS s16x4*)p), b = __builtin_amdgcn_ds_read_tr16_b64_v4i16((LAS s16x4*)(p + 16 * ld));
#ifdef MK_PROBE_TR2
    { const s16x4 a2 = __builtin_amdgcn_ds_read_tr16_b64_v4i16((LAS s16x4*)(p + 8)), b2 = __builtin_amdgcn_ds_read_tr16_b64_v4i16((LAS s16x4*)(p + 16 * ld + 8));
      asm volatile("" :: "v"(a2), "v"(b2)); }
#endif
    return (bf16x8){a[0], a[1], a[2], a[3], b[0], b[1], b[2], b[3]}; }
DI bf16x8 rc_pack(const f32x4& a, const f32x4& b) { return __builtin_bit_cast(bf16x8, (u32x4){pk2(a[0], a[1]), pk2(a[2], a[3]), pk2(b[0], b[1]), pk2(b[2], b[3])}); }
#define RC_BAR() asm volatile("s_waitcnt lgkmcnt(0)\n\ts_barrier" ::: "memory")
DI void dn_recur_unit(const Params& P, const Frame& F, int unit) {
    const int vhalf = unit & 1, chain = unit >> 1, dir = chain & 1, hv = (chain >> 1) & 31, b = chain >> 6, lane = F.lane, l15 = lane & 15, q = lane >> 4, w = F.wave;
    LAS unsigned char* lds = F.lds;
    __syncthreads();
    if (w >= 4) {
        const int ht = F.tid - 256; RcG g0, g1;
        rc_load(P, g0, b, hv, dir, vhalf, chain, 0, ht); rc_store(g0, lds, ht);
        rc_load(P, g0, b, hv, dir, vhalf, chain, 1, ht); rc_load(P, g1, b, hv, dir, vhalf, chain, 2, ht);
        RC_BAR();
#pragma unroll 1
        for (int n = 0; n < NCHUNK; n += 2) {
            rc_store(g0, lds + RC_STAGE, ht);
            rc_load(P, g0, b, hv, dir, vhalf, chain, n + 3 < NCHUNK ? n + 3 : NCHUNK - 1, ht);
            RC_BAR();
            rc_store(g1, lds, ht);
            rc_load(P, g1, b, hv, dir, vhalf, chain, n + 4 < NCHUNK ? n + 4 : NCHUNK - 1, ht);
            RC_BAR();
        }
    } else {
        __builtin_amdgcn_s_setprio(3);
        f32x4 S[8];
#pragma unroll
        for (int i = 0; i < 8; ++i) S[i] = (f32x4){0, 0, 0, 0};
        char* ODu = (char*)(WSP(bf16_t, WS_ODIR) + (size_t)dir * RR * DNV + hv * 128 + vhalf * 64 + 16 * w);
        RC_BAR();
#pragma unroll 1
        for (int n = 0; n < NCHUNK; ++n) {
            int lane = F.lane; asm volatile("" : "+v"(lane)); const int l15 = lane & 15, q = lane >> 4;
            const LAS unsigned char* st = lds + (n & 1) * RC_STAGE;
            const LAS bf16_t* KL = (const LAS bf16_t*)(st + RC_K); const LAS bf16_t* QL = (const LAS bf16_t*)(st + RC_Q); const LAS bf16_t* VL = (const LAS bf16_t*)(st + RC_V);
            const LAS bf16_t* TL = (const LAS bf16_t*)(st + RC_T); const LAS bf16_t* QKL = (const LAS bf16_t*)(st + RC_QK); const LAS float* SC = (const LAS float*)(st + RC_SC);
            f32x4 ks_[4], qs_[4];
#define RC_SCHED() __builtin_amdgcn_sched_barrier(0)
            bf16x8 fa[8], fb[8];
#pragma unroll
            for (int m = 0; m < 4; ++m) { fa[m] = rc_afrag(KL, 136, 16 * m, 0, lane); fa[4 + m] = rc_afrag(QL, 136, 16 * m, 0, lane); }
            RC_SCHED();
#pragma unroll
            for (int kk = 0; kk < 4; ++kk) {
                if (kk < 3) {
#pragma unroll
                    for (int m = 0; m < 4; ++m) { fb[m] = rc_afrag(KL, 136, 16 * m, 32 * (kk + 1), lane); fb[4 + m] = rc_afrag(QL, 136, 16 * m, 32 * (kk + 1), lane); } }
                else {
#pragma unroll
                    for (int m = 0; m < 4; ++m) { fb[m] = rc_afrag(TL, 72, 16 * m, 0, lane); if (m >= 2) fb[4 + m] = rc_afrag(TL, 72, 16 * m, 32, lane); } }
                const bf16x8 sb = rc_pack(S[2 * kk], S[2 * kk + 1]);
                RC_SCHED();
#pragma unroll
                for (int m = 0; m < 4; ++m) { ks_[m] = mfma16(fa[m], sb, kk == 0 ? (f32x4){0, 0, 0, 0} : ks_[m]); qs_[m] = mfma16(fa[4 + m], sb, kk == 0 ? (f32x4){0, 0, 0, 0} : qs_[m]); }
                RC_SCHED();
#pragma unroll
                for (int m = 0; m < 8; ++m) fa[m] = fb[m];
            }
            f32x4 rr_[4];
            {   const int gq = lane >> 4, qq = (lane & 15) >> 2, pp = lane & 3;
#pragma unroll
                for (int m = 0; m < 4; ++m) { fb[m] = rc_afrag(QKL, 72, 16 * m, 0, lane); if (m >= 2) fb[4 + m] = rc_afrag(QKL, 72, 16 * m, 32, lane); }
#pragma unroll
                for (int m = 0; m < 4; ++m) { const s16x4 vv = __builtin_amdgcn_ds_read_tr16_b64_v4i16((LAS s16x4*)(VL + (16 * m + 4 * gq + qq) * 72 + 16 * w + 4 * pp));
                    const f32x4 be = *(const LAS f32x4*)(SC + 16 * m + 4 * q), eg = *(const LAS f32x4*)(SC + 64 + 16 * m + 4 * q);
#pragma unroll
                    for (int e = 0; e < 4; ++e) rr_[m][e] = be[e] * (bf2f((unsigned short)vv[e]) - eg[e] * ks_[m][e]);
                    qs_[m] = qs_[m] * eg * 0.08838834764831845f; }
            }
            f32x4 vn[4];
            { const bf16x8 rb0 = rc_pack(rr_[0], rr_[1]), rb1 = rc_pack(rr_[2], rr_[3]);
              RC_SCHED();
#pragma unroll
              for (int m = 0; m < 4; ++m) { vn[m] = mfma16(fa[m], rb0, (f32x4){0, 0, 0, 0}); if (m >= 2) vn[m] = mfma16(fa[4 + m], rb1, vn[m]); }
              RC_SCHED(); }
#pragma unroll
            for (int mt = 0; mt < 4; ++mt) { fa[mt] = rc_afrag_tr(KL, 136, mt, 0, lane); fa[4 + mt] = rc_afrag_tr(KL, 136, mt, 32, lane); }
            { const bf16x8 vb0 = rc_pack(vn[0], vn[1]), vb1 = rc_pack(vn[2], vn[3]);
              RC_SCHED();
#pragma unroll
              for (int m = 0; m < 4; ++m) { qs_[m] = mfma16(fb[m], vb0, qs_[m]); if (m >= 2) qs_[m] = mfma16(fb[4 + m], vb1, qs_[m]); }
              RC_SCHED(); }
#pragma unroll
            for (int mt = 0; mt < 4; ++mt) { fb[mt] = rc_afrag_tr(KL, 136, 4 + mt, 0, lane); fb[4 + mt] = rc_afrag_tr(KL, 136, 4 + mt, 32, lane); }
#pragma unroll
            for (int m = 0; m < 4; ++m) vn[m] = vn[m] * *(const LAS f32x4*)(SC + 128 + 16 * m + 4 * q);
            const float gl = SC[192];
            const bf16x8 nb0 = rc_pack(vn[0], vn[1]), nb1 = rc_pack(vn[2], vn[3]);
#pragma unroll
            for (int mt = 0; mt < 8; ++mt) S[mt] = S[mt] * gl;
            RC_SCHED();
#pragma unroll
            for (int mt = 0; mt < 4; ++mt) { S[mt] = mfma16(fa[mt], nb0, S[mt]); S[mt] = mfma16(fa[4 + mt], nb1, S[mt]); }
            RC_SCHED();
            { const int cch = dn_seq_to_chunk(dir, n); char* obase = ODu + ((size_t)b * TT + cch * 64) * (DNV * 2);
#pragma unroll
              for (int m = 0; m < 4; ++m)
#pragma unroll
                  for (int e = 0; e < 4; ++e) { const int s = 16 * m + 4 * q + e; *(bf16_t*)(obase + (unsigned)((dir ? 63 - s : s) * (DNV * 2) + l15 * 2)) = f2bf(qs_[m][e]); } }
            RC_SCHED();
#pragma unroll
            for (int mt = 0; mt < 4; ++mt) { S[4 + mt] = mfma16(fb[mt], nb0, S[4 + mt]); S[4 + mt] = mfma16(fb[4 + mt], nb1, S[4 + mt]); }
            RC_BAR();
        }
        __builtin_amdgcn_s_setprio(0);
    }
}
DI void dn_recur(const Params& P, const Frame& F) {
    for (int i = F.bid; i < 256; i += F.G) { int u = i;
        if (F.G == 256) { const int x = i & 7, j = i >> 3, grp = (j >> 2) * 8 + x, mem = j & 3, dir = grp & 1, bq = grp >> 1;
            const int hv = 2 * (bq & 15) + (mem >> 1), b = bq >> 4; u = (((b * 32 + hv) * 2 + dir) << 1) | (mem & 1); }
        dn_recur_unit(P, F, u); }
}
DI void dn_post(const Params& P, const Frame& F) {
    const bf16_t* OD = WSP(bf16_t, WS_ODIR); const bf16_t* PZ = WSP(bf16_t, WS_PZ); unsigned char* OC = WSP(unsigned char, WS_OCAT1); const int lane = F.lane;
    const int w0 = F.bid * 8 + F.wave, stride = F.G * 8, ntrip = w0 < NB * NLAT ? ((NB * NLAT - 1 - w0) / stride + 1) * 8 : 0;
    const f32x4 g0 = *(const f32x4*)(P.in[I_ODNG] + ((lane * 8) & 127)), g1 = *(const f32x4*)(P.in[I_ODNG] + ((lane * 8) & 127) + 4);
    u32x4 xa0, xc0, xz0, xa1, xc1, xz1, xa2, xc2, xz2;
#define DP_LOAD(t_, A_, C_, Z_) do { const int rr_ = w0 + ((t_) >> 3) * stride, b_ = rr_ / NLAT, tok_ = rr_ % NLAT; const size_t e_ = ((size_t)b_ * TT + LCTX + tok_) * DNV + (((t_) & 7) * 64 + lane) * 8; \
        A_ = *(const u32x4*)(OD + e_); C_ = *(const u32x4*)(OD + (size_t)RR * DNV + e_); Z_ = *(const u32x4*)(PZ + e_); } while (0)
    if (ntrip > 0) {
        int i0 = 0, i1 = 1 < ntrip ? 1 : ntrip - 1, i2 = 0;
        DP_LOAD(i0, xa0, xc0, xz0); DP_LOAD(i1, xa1, xc1, xz1);
#define DP_STEP(I_, A_, C_, Z_, NI_, NA_, NC_, NZ_, nidx_) do { NI_ = (nidx_) < ntrip ? (nidx_) : ntrip - 1; __builtin_amdgcn_sched_barrier(0); DP_LOAD(NI_, NA_, NC_, NZ_); __builtin_amdgcn_sched_barrier(0); \
        float a[8], c2[8], z[8]; cv8(A_, a); cv8(C_, c2); cv8(Z_, z); float ss = 0.f; \
        _Pragma("unroll") for (int j = 0; j < 8; ++j) { a[j] += c2[j]; ss += a[j] * a[j]; } \
        ss = row16_sum(ss); const float rs = rsqrtf(ss * (1.0f / 128.0f) + EPS); \
        _Pragma("unroll") for (int j = 0; j < 8; ++j) a[j] = a[j] * rs * (j < 4 ? g0[j & 3] : g1[j & 3]) * siluf_(z[j]); \
        const int rr = w0 + ((I_) >> 3) * stride; \
        *(u32x2*)(OC + (size_t)rr * DNV + (((I_) & 7) * 64 + lane) * 8) = (u32x2){cvt4_fp8(a[0], a[1], a[2], a[3]), cvt4_fp8(a[4], a[5], a[6], a[7])}; } while (0)
#pragma unroll 1
        for (int t = 0; t < ntrip; t += 3) {
            DP_STEP(i0, xa0, xc0, xz0, i2, xa2, xc2, xz2, t + 2);
            DP_STEP(i1, xa1, xc1, xz1, i0, xa0, xc0, xz0, t + 3);
            DP_STEP(i2, xa2, xc2, xz2, i1, xa1, xc1, xz1, t + 4);
        }
#undef DP_STEP
    }
#undef DP_LOAD
    l1w_from_queue(P, F, -1);
}
#ifndef MK_FUSED
#define MK_FUSED 1
#endif
#ifndef MK_LAST_PHASE
#define MK_LAST_PHASE 22
#endif
enum { PH_PRO = 0, PH_H0, PH_EVIN, PH_E2A, PH_E2B, PH_E2C, PH_EVOUT, PH_ROW0, PH_TOPK0, PH_GU0, PH_DN0, PH_COMB0, PH_ODIN, PH_CONV, PH_PREP, PH_REC, PH_POST, PH_ODOUT, PH_ROW1, PH_TOPK1, PH_GU1, PH_DN1, PH_COMB1, NPH_ALL };
constexpr int NPH = MK_LAST_PHASE + 1;

__global__ void __launch_bounds__(512, 2) fwd_kernel(Params P) {
    extern __shared__ __attribute__((aligned(16))) unsigned char shm[];
    Frame F; F.lds = (LAS unsigned char*)shm; F.tid = threadIdx.x; F.lane = F.tid & 63; F.wave = __builtin_amdgcn_readfirstlane(F.tid >> 6); F.G = gridDim.x; F.bid = blockIdx.x;
    volatile LAS unsigned* xbw = (volatile LAS unsigned*)(F.lds + LDS_MISC);
    if (F.tid < 4) xbw[F.tid] = 0u;
    __syncthreads();
    XcdBarrier bar; bar.bar = WSP(unsigned, WS_CTL) + 1024; bar.x = 0; bar.st = xbw;
    if (MK_FUSED) bar = xcd_barrier_post(WSP(unsigned, WS_CTL) + 1024, xbw);
    const int lo = P.ph_lo, hi = P.ph_hi;
#ifndef MK_ONLY
#define MK_ONLY -1
#endif
#define IN(k) ((MK_ONLY < 0 || (k) == MK_ONLY) && lo <= (k) && (k) < hi)
#ifndef MK_REPMASK
#define MK_REPMASK 0u
#endif
#ifndef MK_REPN
#define MK_REPN 2
#endif
#define NREP(k) (((MK_REPMASK >> (k)) & 1u) ? 1 + MK_REPN : 1)
#define SEAM(k) do { if (MK_FUSED && (IN((k) + 1) || rep + 1 < NREP(k))) xcd_barrier(bar); } while (0)
    if (IN(PH_PRO)) _Pragma("unroll") for (int rep = 0; rep < NREP(PH_PRO); ++rep) { p0_prologue(P, F, rep); SEAM(PH_PRO); }
    if (IN(PH_H0)) _Pragma("unroll") for (int rep = 0; rep < NREP(PH_H0); ++rep) { p1_hall0(P, F); SEAM(PH_H0); }
    if (IN(PH_EVIN)) _Pragma("unroll") for (int rep = 0; rep < NREP(PH_EVIN); ++rep) { pg8::Gemm g{WSP(bf16_t, WS_HA), WSP(bf16_t, WS_WEVIN), RR, EVIN, DM}; pg8::StaticOrder S; S.init(RR, EVIN, F.G, F.bid);
        pg8::EpiBf E{WSP(bf16_t, WS_P0), EVIN, 1.0f}; pg8::gemm_phase<pg8::EpiBf, pg8::StaticOrder>(F.lds, g, S, E); if ((int)F.bid >= (RR / 256 * (EVIN / 256)) % F.G) l1w_from_queue(P, F, 14); SEAM(PH_EVIN); }
    if (IN(PH_E2A)) _Pragma("unroll") for (int rep = 0; rep < NREP(PH_E2A); ++rep) { e2a(P, F, rep); SEAM(PH_E2A); }
    if (IN(PH_E2B)) _Pragma("unroll") for (int rep = 0; rep < NREP(PH_E2B); ++rep) { e2b(P, F); SEAM(PH_E2B); }
    if (IN(PH_E2C)) _Pragma("unroll") for (int rep = 0; rep < NREP(PH_E2C); ++rep) { e2c(P, F, rep); SEAM(PH_E2C); }
    if (IN(PH_EVOUT)) _Pragma("unroll") for (int rep = 0; rep < NREP(PH_EVOUT); ++rep) { pg8::Gemm g{WSP(bf16_t, WS_OCAT0), WSP(bf16_t, WS_WEVOUT), RR, DM, DM / 2}; pg8::StaticOrder S; S.init(RR, DM, F.G, F.bid);
        pg8::EpiBf E{WSP(bf16_t, WS_MIX), DM, 1.0f / W8_GU}; pg8::gemm_phase<pg8::EpiBf, pg8::StaticOrder, false, true>(F.lds, g, S, E); if ((int)F.bid >= (RR / 256 * (DM / 256)) % F.G) l1w_from_queue(P, F, 14); SEAM(PH_EVOUT); }
    if (IN(PH_ROW0)) _Pragma("unroll") for (int rep = 0; rep < NREP(PH_ROW0); ++rep) { row_post_mixer(P, F, 0); SEAM(PH_ROW0); }
    if (IN(PH_TOPK0)) _Pragma("unroll") for (int rep = 0; rep < NREP(PH_TOPK0); ++rep) { moe_topk(P, F, 0); SEAM(PH_TOPK0); }
    if (IN(PH_GU0)) _Pragma("unroll") for (int rep = 0; rep < NREP(PH_GU0); ++rep) { pg8::Gemm g{WSP(bf16_t, WS_HA8), WSP(bf16_t, WS_WGU), MOE_ROWS, 0, DM / 2}; pg8::MoeOrder S{F.G, F.bid, 128, WSP(unsigned, WS_VOFF)};
        pg8::EpiSwiGlu E{WSP(unsigned char, WS_HID), 1.0f / W8_GU}; pg8::gemm_phase<pg8::EpiSwiGlu, pg8::MoeOrder, true, true>(F.lds, g, S, E); if ((int)F.bid >= (1024 + 128) % F.G) l1w_from_queue(P, F, 7); SEAM(PH_GU0); }
    if (IN(PH_DN0)) _Pragma("unroll") for (int rep = 0; rep < NREP(PH_DN0); ++rep) { pg8::Gemm g{WSP(bf16_t, WS_HID), WSP(bf16_t, WS_WDN), MOE_ROWS, 0, EFF / 2}; pg8::MoeOrder S{F.G, F.bid, 128, nullptr};
        pg8::EpiDown E{WSP(bf16_t, WS_Y), WSP(float, WS_GATEV), 1.0f / W8_DN}; pg8::gemm_phase<pg8::EpiDown, pg8::MoeOrder, false, true>(F.lds, g, S, E); if ((int)F.bid >= (1024 + 128) % F.G) l1w_from_queue(P, F, 3); SEAM(PH_DN0); }
    if (IN(PH_COMB0)) _Pragma("unroll") for (int rep = 0; rep < NREP(PH_COMB0); ++rep) { moe_combine(P, F, 0); SEAM(PH_COMB0); }
    if (IN(PH_ODIN)) _Pragma("unroll") for (int rep = 0; rep < NREP(PH_ODIN); ++rep) {
        { pg8::Gemm g{WSP(bf16_t, WS_HA), WSP(bf16_t, WS_WODIN), RR, ODA_N, DM}; pg8::StaticOrder S; S.init(RR, ODA_N, F.G, F.bid);
          pg8::EpiOdA E{WSP(bf16_t, WS_PQ), WSP(float, WS_GATES)}; pg8::gemm_phase<pg8::EpiOdA, pg8::StaticOrder>(F.lds, g, S, E); }
        { pg8::Gemm g{WSP(bf16_t, WS_HA8B), WSP(bf16_t, WS_WODIN8), RR, ODB_N, DM / 2}; pg8::HeldOrder S; S.init(RR, ODB_N, F.G, F.G - 1 - F.bid);
          const int nbf = RR / 256 * (ODA_N / 256); S.nheld = (OD8_MODE == 3 && nbf < F.G) ? nbf : 0; S.r0 = S.nheld ? 11 : (1 << 20);
          pg8::EpiOdB E{WSP(bf16_t, WS_PQ), WSP(bf16_t, WS_PZ), 1.0f / W8_GU}; pg8::gemm_phase<pg8::EpiOdB, pg8::HeldOrder, false, true>(F.lds, g, S, E); }
        if (OD8_MODE == 3 ? ((int)F.bid >= 66 && (int)F.bid < 94) : (int)(F.G - 1 - F.bid) >= (RR / 256 * (ODB_N / 256)) % F.G) l1w_from_queue(P, F, 14); SEAM(PH_ODIN); }
    if (IN(PH_CONV)) _Pragma("unroll") for (int rep = 0; rep < NREP(PH_CONV); ++rep) { dn_conv(P, F, rep); SEAM(PH_CONV); }
    if (IN(PH_PREP)) _Pragma("unroll") for (int rep = 0; rep < NREP(PH_PREP); ++rep) { dn_prep(P, F); SEAM(PH_PREP); }
    if (IN(PH_REC)) _Pragma("unroll") for (int rep = 0; rep < NREP(PH_REC); ++rep) { dn_recur(P, F); SEAM(PH_REC); }
    if (IN(PH_POST)) _Pragma("unroll") for (int rep = 0; rep < NREP(PH_POST); ++rep) { dn_post(P, F); SEAM(PH_POST); }
    if (IN(PH_ODOUT)) _Pragma("unroll") for (int rep = 0; rep < NREP(PH_ODOUT); ++rep) { pg8::Gemm g{WSP(bf16_t, WS_OCAT1), WSP(bf16_t, WS_WODOUT), NB * NLAT, DM, DNV / 2}; pg8::StaticOrder S; S.init(NB * NLAT, DM, F.G, F.bid);
        pg8::EpiBf E{WSP(bf16_t, WS_MIX1), DM, 1.0f / W8_GU}; pg8::gemm_phase<pg8::EpiBf, pg8::StaticOrder, false, true>(F.lds, g, S, E); SEAM(PH_ODOUT); }
    if (IN(PH_ROW1)) _Pragma("unroll") for (int rep = 0; rep < NREP(PH_ROW1); ++rep) { row_post_mixer(P, F, 1); SEAM(PH_ROW1); }
    if (IN(PH_TOPK1)) _Pragma("unroll") for (int rep = 0; rep < NREP(PH_TOPK1); ++rep) { moe_topk(P, F, 1); SEAM(PH_TOPK1); }
    if (IN(PH_GU1)) _Pragma("unroll") for (int rep = 0; rep < NREP(PH_GU1); ++rep) { pg8::Gemm g{WSP(bf16_t, WS_HA8), WSP(bf16_t, WS_WGU1), MOE_ROWS, 0, DM / 2}; pg8::MoeOrder S{F.G, F.bid, 0, WSP(unsigned, WS_VOFF)};
        pg8::EpiSwiGlu E{WSP(unsigned char, WS_HID), 1.0f / W8_GU}; pg8::gemm_phase<pg8::EpiSwiGlu, pg8::MoeOrder, true, true>(F.lds, g, S, E); SEAM(PH_GU1); }
    if (IN(PH_DN1)) _Pragma("unroll") for (int rep = 0; rep < NREP(PH_DN1); ++rep) { pg8::Gemm g{WSP(bf16_t, WS_HID), WSP(bf16_t, WS_WDN1), MOE_ROWS, 0, EFF / 2}; pg8::MoeOrder S{F.G, F.bid, 0, nullptr};
        pg8::EpiDown E{WSP(bf16_t, WS_Y), WSP(float, WS_GATEV), 1.0f / W8_DN}; pg8::gemm_phase<pg8::EpiDown, pg8::MoeOrder, false, true>(F.lds, g, S, E); SEAM(PH_DN1); }
    if (IN(PH_COMB1)) _Pragma("unroll") for (int rep = 0; rep < NREP(PH_COMB1); ++rep) { moe_combine(P, F, 1); SEAM(PH_COMB1); }
#undef IN
#undef SEAM
}

extern "C" void kernel_launch(void* const* d_in, const int* in_sizes, int n_in, void* d_out, int out_size, void* d_ws, size_t ws_size, hipStream_t stream) {
    static int grid = 0;
    if (grid == 0) {
        if (n_in != 31 || out_size != NB * NLAT * DM || ws_size < WS_END) { fprintf(stderr, "kernel_launch: unexpected shapes (n_in %d, out %d, ws %zu < %zu); nothing launched\n", n_in, out_size, ws_size, (size_t)WS_END); grid = -1; return; }
        int dev = 0, cus = 0, per_cu = 0;
        if (hipGetDevice(&dev) != hipSuccess || hipDeviceGetAttribute(&cus, hipDeviceAttributeMultiprocessorCount, dev) != hipSuccess) { grid = -1; return; }
        if (hipFuncSetAttribute((const void*)fwd_kernel, hipFuncAttributeMaxDynamicSharedMemorySize, LDS_BYTES) != hipSuccess) { fprintf(stderr, "kernel_launch: hipFuncSetAttribute failed\n"); grid = -1; return; }
        if (hipOccupancyMaxActiveBlocksPerMultiprocessor(&per_cu, (const void*)fwd_kernel, 512, LDS_BYTES) != hipSuccess || per_cu < 1) { fprintf(stderr, "kernel_launch: occupancy query reports %d\n", per_cu); (void)hipGetLastError(); grid = -1; return; }
        grid = cus;
    }
    if (grid < 0) return;
    if (hipMemsetAsync((char*)d_ws + WS_CTL, 0, CTL_ZERO_BYTES, stream) != hipSuccess) return;
    Params p{};
    for (int i = 0; i < 31; ++i) p.in[i] = (const float*)d_in[i];
    p.out = (float*)d_out; p.ws = (unsigned char*)d_ws;
#if MK_FUSED
    p.ph_lo = 0; p.ph_hi = NPH;
    hipLaunchKernelGGL(fwd_kernel, dim3(grid), dim3(512), LDS_BYTES, stream, p);
#else
    for (int k = 0; k < NPH; ++k) { p.ph_lo = k; p.ph_hi = k + 1; hipLaunchKernelGGL(fwd_kernel, dim3(grid), dim3(512), LDS_BYTES, stream, p); }
#endif
}
```

```cpp
#include <hip/hip_runtime.h>
#include <cstdio>
#include <cstdint>
#define DI __device__ __forceinline__
#define LAS __attribute__((address_space(3)))
typedef unsigned short bf16_t;
typedef short bf16x8 __attribute__((ext_vector_type(8)));
typedef float f32x4 __attribute__((ext_vector_type(4)));
typedef float f32x2 __attribute__((ext_vector_type(2)));
typedef unsigned u32x4 __attribute__((ext_vector_type(4)));
typedef unsigned u32x2 __attribute__((ext_vector_type(2)));
typedef __bf16 bfx2 __attribute__((ext_vector_type(2)));
typedef short s16x4 __attribute__((ext_vector_type(4)));

DI unsigned pk2(float lo, float hi) { f32x2 v = {lo, hi}; bfx2 b = __builtin_convertvector(v, bfx2); return __builtin_bit_cast(unsigned, b); }
DI bf16_t f2bf(float f) { return (bf16_t)(pk2(f, 0.f) & 0xffffu); }
DI unsigned cvt4_fp8(float a, float b, float c, float d) { int w = 0; w = __builtin_amdgcn_cvt_pk_fp8_f32(a, b, w, false); w = __builtin_amdgcn_cvt_pk_fp8_f32(c, d, w, true); return (unsigned)w; }
DI float bf2f(unsigned h) { return __uint_as_float(h << 16); }
DI float bflo(unsigned w) { return __uint_as_float(w << 16); }
DI float bfhi(unsigned w) { return __uint_as_float(w & 0xffff0000u); }
DI float rcpf_(float x) { return __builtin_amdgcn_rcpf(x); }
DI float sigmoidf_(float x) { return rcpf_(1.0f + __expf(-x)); }
DI float siluf_(float x) { return x * rcpf_(1.0f + __expf(-x)); }
template <int CTRL> DI float dppf(float x) { return __builtin_bit_cast(float, __builtin_amdgcn_mov_dpp(__builtin_bit_cast(int, x), CTRL, 0xf, 0xf, true)); }
DI float xor1f(float x) { return dppf<0xB1>(x); }
DI float xor2f(float x) { return dppf<0x4E>(x); }
DI float row8_sum(float x) { x += dppf<0xB1>(x); x += dppf<0x4E>(x); x += dppf<0x141>(x); return x; }
DI float row16_sum(float x) { x = row8_sum(x); x += dppf<0x128>(x); return x; }
DI float row16_max(float x) { x = fmaxf(x, dppf<0xB1>(x)); x = fmaxf(x, dppf<0x4E>(x)); x = fmaxf(x, dppf<0x141>(x)); x = fmaxf(x, dppf<0x128>(x)); return x; }
DI float wave_sum(float v) {
    v = row16_sum(v);
    const auto s = __builtin_amdgcn_permlane16_swap(__builtin_bit_cast(unsigned, v), __builtin_bit_cast(unsigned, v), false, false);
    v = __builtin_bit_cast(float, (unsigned)s[0]) + __builtin_bit_cast(float, (unsigned)s[1]);
    const auto t = __builtin_amdgcn_permlane32_swap(__builtin_bit_cast(unsigned, v), __builtin_bit_cast(unsigned, v), false, false);
    return __builtin_bit_cast(float, (unsigned)t[0]) + __builtin_bit_cast(float, (unsigned)t[1]);
}
DI f32x4 mfma16(bf16x8 a, bf16x8 b, f32x4 c) { return __builtin_amdgcn_mfma_f32_16x16x32_bf16(a, b, c, 0, 0, 0); }
DI bf16x8 lds_frag(const LAS bf16_t* base, int ld, int row0, int k0, int lane) { return *(const LAS bf16x8*)(base + (row0 + (lane & 15)) * ld + k0 + 8 * (lane >> 4)); }

constexpr int NB = 2, NLAT = 8192, LCTX = 256, TT = NLAT + LCTX, RR = NB * TT, DM = 2048;
constexpr int NMOD = 6;
constexpr int HGW = 1024, HGH = 8, EVIN = 6144;
constexpr int S5G = 64, S5P = 64, S5C = 16, S5CS = 16, S5NCH = TT / S5CS  , S5NCTX = LCTX / S5CS  ;
constexpr int DNQK = 2048, DNV = 4096, DNQKV = 8192, ODIN = 12416, ODIN_PAD = 12544, DNHV = 32;
constexpr int NEXP = 16, EFF = 1024, CAPL = 1024, CAPC = 32;
constexpr int NCHUNK = TT / 64;
constexpr float EPS = 1e-6f;
constexpr float W8_GU = 64.0f, W8_DN = 32.0f;

constexpr size_t MiB = 1u << 20;
constexpr size_t WS_CTL = 0, CTL_ZERO_BYTES = 1 * MiB;
constexpr size_t WS_MODV = 1 * MiB;
constexpr size_t WS_LB = 2 * MiB;
constexpr size_t WS_S5A16 = 2 * MiB + 65536;
constexpr size_t WS_CTXW = 8 * MiB;
constexpr size_t WS_S5WY = 12 * MiB;
constexpr size_t WS_S5WX = 28 * MiB;
constexpr int OD8_MODE = 3;
constexpr int ODA_N = OD8_MODE == 1 ? 4352 : (OD8_MODE == 2 ? 2304 : 256), ODB_N = OD8_MODE == 1 ? 8192 : (OD8_MODE == 2 ? 10240 : 12288);
constexpr size_t WS_WODIN = 36 * MiB;
constexpr size_t WS_WODIN8 = 56 * MiB;
constexpr size_t WS_WODOUT = 85 * MiB;
constexpr size_t WS_HA = 101 * MiB;
constexpr size_t WS_AFF = 167 * MiB;
constexpr size_t WS_AFFC = 168 * MiB;
constexpr size_t WS_GATEV = 168 * MiB + 65536;
constexpr size_t WS_IDX = 168 * MiB + 524288;
constexpr size_t WS_SLOT = 169 * MiB;
constexpr size_t WS_VOFF = 171 * MiB;
constexpr size_t WS_W0 = 176 * MiB;
constexpr size_t WS_WEVIN = WS_W0;
constexpr size_t WS_WEVOUT = WS_W0 + 24 * MiB;
constexpr size_t WS_WGU = WS_W0 + 32 * MiB;
constexpr size_t WS_WDN = WS_W0 + 160 * MiB;
constexpr size_t WS_WGU1 = 1123 * MiB;
constexpr size_t WS_WDN1 = 1187 * MiB;
constexpr size_t WS_ACT = 400 * MiB;
constexpr size_t WS_P0 = WS_ACT;
constexpr size_t WS_MIX = WS_ACT;
constexpr size_t WS_OCAT0 = 598 * MiB;
constexpr size_t WS_KVT = 664 * MiB;
constexpr size_t WS_SST = 796 * MiB;
constexpr size_t WS_DEC = 928 * MiB;
constexpr size_t WS_REFX = 1030 * MiB;
constexpr size_t WS_XL = 931 * MiB;
constexpr size_t WS_X0 = 997 * MiB;
constexpr size_t WS_XS = WS_ACT;
constexpr size_t WS_HA8 = 508 * MiB;
constexpr size_t WS_HID = 544 * MiB;
constexpr size_t WS_Y = 616 * MiB;
constexpr size_t WS_TM = 176 * MiB;
constexpr size_t WS_HA8B = WS_TM;
constexpr size_t WS_QKM = 308 * MiB;
constexpr size_t WS_PQ = 440 * MiB;
constexpr size_t WS_ODIR = WS_PQ;
constexpr size_t WS_MIX1 = WS_PQ;
constexpr size_t WS_PZ = 704 * MiB;
constexpr size_t WS_GATES = 836 * MiB;
constexpr size_t WS_G2 = 845 * MiB;
constexpr size_t WS_GC = 854 * MiB;
constexpr size_t WS_QKVC = 859 * MiB;
constexpr size_t WS_OCAT1 = WS_QKVC;
constexpr size_t WS_END = 1219 * MiB;
constexpr int MOE_ROWS = 32 * 1024 + 16 * 256;
constexpr int LDS_BYTES = 147456;
constexpr int LDS_MISC = LDS_BYTES - 16;
namespace pg8 {
#define PG8_LAS __attribute__((address_space(3)))
typedef unsigned short bf16_t;
typedef short bf16x8 __attribute__((ext_vector_type(8)));
typedef float f32x4 __attribute__((ext_vector_type(4)));
typedef unsigned u32x4 __attribute__((ext_vector_type(4)));
typedef int i32x8 __attribute__((ext_vector_type(8)));
constexpr int BM = 256, BK = 64, HALF = 128, HTB = HALF * BK * 2  , STAGE_BYTES = 8 * HTB, NXCD = 8, WGM = 8;

__host__ __device__ __forceinline__ int lds_byte(int r, int c) { const int st = (r >> 4) * 2 + (c >> 5), rr = r & 15, cc = c & 31, ob = rr * 64 + cc * 2; return st * 1024 + (ob ^ (((ob >> 9) & 1) << 5)); }
__host__ __device__ __forceinline__ void stage_rc(int b, int& R, int& C) { const int st = b / 1024, sb = b % 1024, swz = sb ^ (((sb >> 9) & 1) << 5); R = (st >> 1) * 16 + swz / 64; C = (st & 1) * 32 + (swz % 64) / 2; }
__host__ __device__ __forceinline__ int perm32(int rho) { const int n = rho >> 4, i = rho & 15; return 8 * (i >> 2) + 4 * n + (i & 3); }

struct Unit { int pm, pn; };
struct Gemm { const bf16_t* A; const bf16_t* Bt; int M, N, K; };

struct StaticOrder {
    int nM, nN, nwg, G, c;
    __host__ __device__ void init(int M, int N, int G_, int c_) { nM = M / BM; nN = N / BM; nwg = nM * nN; G = G_; c = c_; }
    __host__ __device__ bool next(int i, Unit& u) const { return unit_of((long)i * G + c, u); }
    __host__ __device__ bool unit_of(long L, Unit& u) const {
        if (L >= nwg) return false;
        int wgid = (int)L; { const int q = nwg / NXCD, r = nwg % NXCD, xcd = wgid % NXCD, off = wgid / NXCD; wgid = (xcd < r ? xcd * (q + 1) : r * (q + 1) + (xcd - r) * q) + off; }
        const int nig = WGM * nN, gid = wgid / nig, fm = gid * WGM, gsz = (nM - fm) < WGM ? (nM - fm) : WGM;
        u.pm = fm + ((wgid % nig) % gsz); u.pn = (wgid % nig) / gsz; return true;
    }
    __device__ __forceinline__ void a_ready(const Unit&) const {}
    __device__ __forceinline__ void done(const Unit&) const {}
};

struct HeldOrder : StaticOrder {
    int nheld, r0;
    __host__ __device__ bool next(int i, Unit& u) const {
        if (i < r0) return unit_of((long)i * G + c, u);
        if (c >= G - nheld) return false;
        return unit_of((long)r0 * G + (long)(i - r0) * (G - nheld) + c, u); }
};
__device__ __forceinline__ unsigned cvt_pk_bf16(float lo, float hi) { unsigned r; asm volatile("v_cvt_pk_bf16_f32 %0, %1, %2" : "=v"(r) : "v"(lo), "v"(hi)); return r; }
template <class Epi, class Sched, bool GATHER = false, bool FP8 = false, bool ALIGN_EPI = true, bool SP2 = true>
__device__ __forceinline__ void gemm_phase(PG8_LAS unsigned char* lds, const Gemm g, const Sched& S, const Epi& E) {
    const int tid = threadIdx.x, wid = __builtin_amdgcn_readfirstlane(tid >> 6), lane = tid & 63, wr = wid >> 2, wc = wid & 3, fr = lane & 15, fq = lane >> 4;
    const int K = g.K, nt = K / BK;
    unsigned voffA[2], voffB[2];
#pragma unroll
    for (int i = 0; i < 2; ++i) { int R, C; stage_rc(tid * 16 + i * 8192, R, C); const int Rb = Epi::PERM ? ((R & ~31) + perm32(R & 31)) : R;
        voffA[i] = (unsigned)(R * K + C) * 2u; voffB[i] = (unsigned)(Rb * K + C) * 2u; }
    const size_t kstep = (size_t)(BK * 2);
    const size_t hstep = (size_t)HALF * K * 2;
    const size_t tstep = 2 * hstep;
    const unsigned ldsw = (unsigned)wid * 1024u;
    const int aoff = lds_byte(wr * 64 + fr, fq * 8), boff = lds_byte(wc * 32 + fr, fq * 8);
#define PG8_SA(b, h) (((b) * 2 + (h)) * HTB)
#define PG8_SB(b, h) ((4 + (b) * 2 + (h)) * HTB)
#define PG8_STAGE(bufoff, gbase, voff) do { _Pragma("unroll") for (int _i = 0; _i < 2; ++_i) \
        __builtin_amdgcn_global_load_lds((const unsigned*)((const char*)(gbase) + (voff)[_i]), (PG8_LAS unsigned*)(lds + (bufoff) + ldsw + _i * 8192), 16, 0, 0); } while (0)
#define PG8_LDA(dst, b, h) do { _Pragma("unroll") for (int m = 0; m < 4; ++m) _Pragma("unroll") for (int k = 0; k < 2; ++k) dst[m][k] = *(const PG8_LAS bf16x8*)(lds + PG8_SA(b, h) + aoff + m * 2048 + k * 1024); } while (0)
#define PG8_LDB(dst, b, h) do { _Pragma("unroll") for (int n = 0; n < 2; ++n) _Pragma("unroll") for (int k = 0; k < 2; ++k) dst[n][k] = *(const PG8_LAS bf16x8*)(lds + PG8_SB(b, h) + boff + n * 2048 + k * 1024); } while (0)
#define PG8_MMA(ai, bj, At, Bt) do { __builtin_amdgcn_s_setprio(1); if constexpr (FP8) { _Pragma("unroll") for (int m = 0; m < 4; ++m) _Pragma("unroll") for (int n = 0; n < 2; ++n) { \
            typedef int i32x4_ __attribute__((ext_vector_type(4))); \
            const i32x8 bb_ = __builtin_shufflevector(__builtin_bit_cast(i32x4_, Bt[n][0]), __builtin_bit_cast(i32x4_, Bt[n][1]), 0, 1, 2, 3, 4, 5, 6, 7), aa_ = __builtin_shufflevector(__builtin_bit_cast(i32x4_, At[m][0]), __builtin_bit_cast(i32x4_, At[m][1]), 0, 1, 2, 3, 4, 5, 6, 7); \
            asm volatile("v_mfma_scale_f32_16x16x128_f8f6f4 %0, %1, %2, %0, %3, %3 op_sel_hi:[0,0,0]" : "+v"(acc[ai][bj][m][n]) : "v"(bb_), "v"(aa_), "v"(scl8)); } } \
        else { _Pragma("unroll") for (int m = 0; m < 4; ++m) _Pragma("unroll") for (int n = 0; n < 2; ++n) _Pragma("unroll") for (int k = 0; k < 2; ++k) \
        acc[ai][bj][m][n] = __builtin_amdgcn_mfma_f32_16x16x32_bf16(Bt[n][k], At[m][k], acc[ai][bj][m][n], 0, 0, 0); } __builtin_amdgcn_s_setprio(0); } while (0)
#define PG8_WAIT_V(n) asm volatile("s_waitcnt vmcnt(" #n ")" ::: "memory")
#define PG8_WAIT_L(n) asm volatile("s_waitcnt lgkmcnt(" #n ")" ::: "memory")
#define PG8_BAR __builtin_amdgcn_s_barrier()
#define PG8_SCHED __builtin_amdgcn_sched_barrier(0)
    const int scl8 = 0x7f7f7f7f;
    Unit cur, nxt; int ui = 0;
    if (!S.next(0, cur)) return;
    f32x4 acc[2][2][4][2];
#pragma unroll
    for (int a = 0; a < 2; ++a)
#pragma unroll
        for (int b = 0; b < 2; ++b)
#pragma unroll
            for (int m = 0; m < 4; ++m)
#pragma unroll
                for (int n = 0; n < 2; ++n) acc[a][b][m][n] = (f32x4){0.f, 0.f, 0.f, 0.f};
    bf16x8 At[4][2], B0[2][2], B1[2][2];
    const char* cA = GATHER ? (const char*)g.A : (const char*)g.A + (size_t)cur.pm * tstep; const char* cB = (const char*)g.Bt + (size_t)cur.pn * tstep;
    const size_t hstepA = GATHER ? 0 : hstep;
    unsigned cv0[2], cv1[2], nv0[2], nv1[2];
    if constexpr (GATHER) { const u32x4 vv = S.voff(cur); cv0[0] = vv.x; cv0[1] = vv.y; cv1[0] = vv.z; cv1[1] = vv.w; } else { cv0[0] = cv1[0] = voffA[0]; cv0[1] = cv1[1] = voffA[1]; }
    nv0[0] = cv0[0]; nv0[1] = cv0[1]; nv1[0] = cv1[0]; nv1[1] = cv1[1];
    S.a_ready(cur);
    if constexpr (SP2) {
        PG8_STAGE(PG8_SB(0, 0), cB, voffB); PG8_STAGE(PG8_SB(0, 1), cB + hstep, voffB); PG8_STAGE(PG8_SA(0, 0), cA, cv0); PG8_STAGE(PG8_SA(0, 1), cA + hstepA, cv1);
        if (wr == 1) PG8_BAR;
        PG8_WAIT_V(2); PG8_BAR;
        PG8_STAGE(PG8_SB(1, 0), cB + kstep, voffB); PG8_STAGE(PG8_SA(1, 0), cA + kstep, cv0); PG8_STAGE(PG8_SB(1, 1), cB + hstep + kstep, voffB);
        PG8_WAIT_V(6); PG8_BAR;
    } else {
        PG8_STAGE(PG8_SB(0, 0), cB, voffB); PG8_STAGE(PG8_SA(0, 0), cA, cv0); PG8_STAGE(PG8_SB(0, 1), cB + hstep, voffB); PG8_STAGE(PG8_SA(0, 1), cA + hstepA, cv1);
        if (wr == 1) PG8_BAR;
        PG8_WAIT_V(4); PG8_BAR;
        PG8_STAGE(PG8_SB(1, 0), cB + kstep, voffB); PG8_STAGE(PG8_SA(1, 0), cA + kstep, cv0); PG8_STAGE(PG8_SB(1, 1), cB + hstep + kstep, voffB);
        PG8_WAIT_V(6); PG8_BAR;
    }
    for (;;) {
        const bool has_next = S.next(ui + 1, nxt);
        if constexpr (GATHER) { if (has_next) { const u32x4 vv = S.voff(nxt); nv0[0] = vv.x; nv0[1] = vv.y; nv1[0] = vv.z; nv1[1] = vv.w; } }
        const char* nA = GATHER ? cA : (has_next ? (const char*)g.A + (size_t)nxt.pm * tstep : cA); const char* nB = has_next ? (const char*)g.Bt + (size_t)nxt.pn * tstep : cB;
#pragma unroll 1
        for (int t = 0; t < nt; t += 2) {
            const bool last = (t == nt - 2);
            const char* a1 = cA + (size_t)(t + 1) * kstep;
            const char* a2 = last ? nA : cA + (size_t)(t + 2) * kstep; const char* b2 = last ? nB : cB + (size_t)(t + 2) * kstep;
            const char* a3 = a2 + kstep; const char* b3 = b2 + kstep;
            unsigned sv0[2], sv1[2];
            sv0[0] = last ? nv0[0] : cv0[0]; sv0[1] = last ? nv0[1] : cv0[1]; sv1[0] = last ? nv1[0] : cv1[0]; sv1[1] = last ? nv1[1] : cv1[1];
            if (last && has_next) S.a_ready(nxt);
            if constexpr (SP2) {
            PG8_LDB(B0, 0, 0); PG8_LDB(B1, 0, 1); PG8_SCHED; PG8_LDA(At, 0, 0); PG8_STAGE(PG8_SA(1, 1), a1 + hstepA, cv1);
            PG8_WAIT_V(8); PG8_WAIT_L(0); PG8_BAR; PG8_MMA(0, 0, At, B0); PG8_MMA(0, 1, At, B1); PG8_BAR; PG8_SCHED;
            PG8_LDA(At, 0, 1); PG8_STAGE(PG8_SB(0, 0), b2, voffB); PG8_STAGE(PG8_SB(0, 1), b2 + hstep, voffB); PG8_STAGE(PG8_SA(0, 0), a2, sv0);
            PG8_WAIT_V(8); PG8_WAIT_L(0); PG8_BAR; PG8_MMA(1, 0, At, B0); PG8_MMA(1, 1, At, B1); PG8_BAR; PG8_SCHED;
            PG8_LDB(B0, 1, 0); PG8_LDB(B1, 1, 1); PG8_SCHED; PG8_LDA(At, 1, 0); PG8_STAGE(PG8_SA(0, 1), a2 + hstepA, sv1);
            PG8_WAIT_V(8); PG8_WAIT_L(0); PG8_BAR; PG8_MMA(0, 0, At, B0); PG8_MMA(0, 1, At, B1); PG8_BAR; PG8_SCHED;
            PG8_LDA(At, 1, 1); PG8_STAGE(PG8_SB(1, 0), b3, voffB); PG8_STAGE(PG8_SB(1, 1), b3 + hstep, voffB); PG8_STAGE(PG8_SA(1, 0), a3, sv0);
            PG8_WAIT_V(8); PG8_WAIT_L(0); PG8_BAR; PG8_MMA(1, 0, At, B0); PG8_MMA(1, 1, At, B1); PG8_BAR; PG8_SCHED;
            } else {
            PG8_LDB(B0, 0, 0); PG8_SCHED; PG8_LDA(At, 0, 0); PG8_STAGE(PG8_SA(1, 1), a1 + hstepA, cv1);
            PG8_WAIT_L(8); PG8_BAR; PG8_WAIT_L(0); PG8_MMA(0, 0, At, B0); PG8_BAR; PG8_SCHED;
            PG8_LDB(B1, 0, 1); PG8_STAGE(PG8_SB(0, 0), b2, voffB);
            PG8_BAR; PG8_WAIT_L(0); PG8_MMA(0, 1, At, B1); PG8_BAR;
            PG8_LDA(At, 0, 1); PG8_STAGE(PG8_SA(0, 0), a2, sv0);
            PG8_BAR; PG8_WAIT_L(0); PG8_MMA(1, 0, At, B0); PG8_BAR; PG8_SCHED;
            PG8_STAGE(PG8_SB(0, 1), b2 + hstep, voffB);
            PG8_WAIT_V(6); PG8_BAR; PG8_MMA(1, 1, At, B1); PG8_BAR;
            PG8_LDB(B0, 1, 0); PG8_SCHED; PG8_LDA(At, 1, 0); PG8_STAGE(PG8_SA(0, 1), a2 + hstepA, sv1);
            PG8_WAIT_L(8); PG8_BAR; PG8_WAIT_L(0); PG8_MMA(0, 0, At, B0); PG8_BAR; PG8_SCHED;
            PG8_LDB(B1, 1, 1); PG8_STAGE(PG8_SB(1, 0), b3, voffB);
            PG8_BAR; PG8_WAIT_L(0); PG8_MMA(0, 1, At, B1); PG8_BAR;
            PG8_LDA(At, 1, 1); PG8_STAGE(PG8_SA(1, 0), a3, sv0);
            PG8_BAR; PG8_WAIT_L(0); PG8_MMA(1, 0, At, B0); PG8_BAR; PG8_SCHED;
            PG8_STAGE(PG8_SB(1, 1), b3 + hstep, voffB);
            PG8_WAIT_V(6); PG8_BAR; PG8_MMA(1, 1, At, B1); PG8_BAR;
                    }
        }
        if constexpr (FP8) asm volatile("s_nop 15\n\ts_nop 15\n\ts_nop 7" ::: "memory");
        if constexpr (ALIGN_EPI) { if (wr == 0) PG8_BAR; }
        if constexpr (!Epi::AFTER_DRAIN) { E(acc, cur, wr, wc, fr, fq); S.done(cur); }
        if (!has_next) break;
#pragma unroll
        for (int a = 0; a < 2; ++a)
#pragma unroll
            for (int b = 0; b < 2; ++b)
#pragma unroll
                for (int m = 0; m < 4; ++m)
#pragma unroll
                    for (int n = 0; n < 2; ++n) acc[a][b][m][n] = (f32x4){0.f, 0.f, 0.f, 0.f};
        cur = nxt; cA = nA; cB = nB; ++ui; cv0[0] = nv0[0]; cv0[1] = nv0[1]; cv1[0] = nv1[0]; cv1[1] = nv1[1];
        if constexpr (ALIGN_EPI) { if (wr == 1) PG8_BAR; }
    }
    PG8_WAIT_V(0);
    if constexpr (!ALIGN_EPI) { if (wr == 0) PG8_BAR; }
    PG8_BAR;
    if constexpr (Epi::AFTER_DRAIN) { E.fused(acc, cur, wr, wc, fr, fq, lds, wid, lane); S.done(cur); }
#undef PG8_SA
#undef PG8_SB
#undef PG8_STAGE
#undef PG8_LDA
#undef PG8_LDB
#undef PG8_MMA
#undef PG8_WAIT_V
#undef PG8_WAIT_L
#undef PG8_BAR
#undef PG8_SCHED
}
}

namespace pg8 {
struct EpiBf {
    static constexpr bool PERM = true, AFTER_DRAIN = false;
    bf16_t* O; int ldc; float sc;
    __device__ __forceinline__ void operator()(const f32x4 (&acc)[2][2][4][2], const Unit& u, int wr, int wc, int fr, int fq) const {
        const int row0 = u.pm * BM + wr * 64 + fr, col0 = u.pn * BM + wc * 32 + 8 * fq;
#pragma unroll
        for (int ai = 0; ai < 2; ++ai)
#pragma unroll
            for (int m = 0; m < 4; ++m) { bf16_t* rowp = O + (size_t)(row0 + ai * HALF + m * 16) * ldc + col0;
#pragma unroll
                for (int bj = 0; bj < 2; ++bj) { const f32x4 v0 = acc[ai][bj][m][0] * sc, v1 = acc[ai][bj][m][1] * sc;
                    u32x4 w; w.x = cvt_pk_bf16(v0[0], v0[1]); w.y = cvt_pk_bf16(v0[2], v0[3]); w.z = cvt_pk_bf16(v1[0], v1[1]); w.w = cvt_pk_bf16(v1[2], v1[3]);
                    *(u32x4*)(rowp + bj * HALF) = w; } }
    }
};
struct EpiF32 {
    static constexpr bool PERM = false, AFTER_DRAIN = false;
    float* C; int ldc;
    __device__ __forceinline__ void operator()(const f32x4 (&acc)[2][2][4][2], const Unit& u, int wr, int wc, int fr, int fq) const {
        const int row0 = u.pm * BM + wr * 64 + fr, col0 = u.pn * BM + wc * 32 + 4 * fq;
#pragma unroll
        for (int ai = 0; ai < 2; ++ai)
#pragma unroll
            for (int m = 0; m < 4; ++m) { float* rowp = C + (size_t)(row0 + ai * HALF + m * 16) * ldc + col0;
#pragma unroll
                for (int bj = 0; bj < 2; ++bj)
#pragma unroll
                    for (int n = 0; n < 2; ++n) *(f32x4*)(rowp + bj * HALF + n * 16) = acc[ai][bj][m][n]; }
    }
};
struct EpiOdA {
    static constexpr bool PERM = true, AFTER_DRAIN = false;
    bf16_t* PQ; float* GATES;
    __device__ __forceinline__ void operator()(const f32x4 (&acc)[2][2][4][2], const Unit& u, int wr, int wc, int fr, int fq) const {
        const int row0 = u.pm * BM + wr * 64 + fr;
        if (u.pn < ODA_N / 256 - 1) {
            const int col0 = (OD8_MODE == 2 ? 2048 : 0) + u.pn * BM + wc * 32 + 8 * fq;
#pragma unroll
            for (int ai = 0; ai < 2; ++ai)
#pragma unroll
                for (int m = 0; m < 4; ++m) { bf16_t* rowp = PQ + (size_t)(row0 + ai * HALF + m * 16) * 8192 + col0;
#pragma unroll
                    for (int bj = 0; bj < 2; ++bj) { const f32x4 v0 = acc[ai][bj][m][0], v1 = acc[ai][bj][m][1];
                        u32x4 w; w.x = cvt_pk_bf16(v0[0], v0[1]); w.y = cvt_pk_bf16(v0[2], v0[3]); w.z = cvt_pk_bf16(v1[0], v1[1]); w.w = cvt_pk_bf16(v1[2], v1[3]);
                        *(u32x4*)(rowp + bj * HALF) = w; } }
        } else {
            const int col0 = wc * 32 + 8 * fq;
#pragma unroll
            for (int ai = 0; ai < 2; ++ai)
#pragma unroll
                for (int m = 0; m < 4; ++m) { float* rowp = GATES + (size_t)(row0 + ai * HALF + m * 16) * 128 + col0;
                    *(f32x4*)(rowp) = acc[ai][0][m][0]; *(f32x4*)(rowp + 4) = acc[ai][0][m][1]; }
        }
    }
};
struct EpiOdB {
    static constexpr bool PERM = true, AFTER_DRAIN = false;
    bf16_t* PQ; bf16_t* PZ; float sc;
    __device__ __forceinline__ void operator()(const f32x4 (&acc)[2][2][4][2], const Unit& u, int wr, int wc, int fr, int fq) const {
        const int row0 = u.pm * BM + wr * 64 + fr;
        constexpr int NQK = OD8_MODE == 1 ? 0 : (OD8_MODE == 2 ? 8 : 16);
        bf16_t* base; int ldc, colt;
        if (u.pn < NQK) { base = PQ; ldc = 8192; colt = u.pn * BM; }
        else if (u.pn < NQK + 16) { base = PQ; ldc = 8192; colt = 4096 + (u.pn - NQK) * BM; }
        else { base = PZ; ldc = 4096; colt = (u.pn - NQK - 16) * BM; }
        const int col0 = colt + wc * 32 + 8 * fq;
#pragma unroll
        for (int ai = 0; ai < 2; ++ai)
#pragma unroll
            for (int m = 0; m < 4; ++m) { bf16_t* rowp = base + (size_t)(row0 + ai * HALF + m * 16) * ldc + col0;
#pragma unroll
                for (int bj = 0; bj < 2; ++bj) { const f32x4 v0 = acc[ai][bj][m][0] * sc, v1 = acc[ai][bj][m][1] * sc;
                    u32x4 w; w.x = cvt_pk_bf16(v0[0], v0[1]); w.y = cvt_pk_bf16(v0[2], v0[3]); w.z = cvt_pk_bf16(v1[0], v1[1]); w.w = cvt_pk_bf16(v1[2], v1[3]);
                    *(u32x4*)(rowp + bj * HALF) = w; } }
    }
};
struct EpiSwiGlu {
    static constexpr bool PERM = true, AFTER_DRAIN = false;
    unsigned char* H; float inv;
    __device__ __forceinline__ void operator()(const f32x4 (&acc)[2][2][4][2], const Unit& u, int wr, int wc, int fr, int fq) const {
        const int row0 = u.pm * BM + wr * 64 + fr, col0 = (u.pn & 7) * HALF + wc * 32 + 8 * fq;
#pragma unroll
        for (int ai = 0; ai < 2; ++ai)
#pragma unroll
            for (int m = 0; m < 4; ++m) { unsigned char* rowp = H + (size_t)(row0 + ai * HALF + m * 16) * 1024 + col0;
                float v[8];
#pragma unroll
                for (int n = 0; n < 2; ++n)
#pragma unroll
                    for (int j = 0; j < 4; ++j) { const float gt = acc[ai][0][m][n][j] * inv, up = acc[ai][1][m][n][j] * inv; v[n * 4 + j] = gt * __builtin_amdgcn_rcpf(1.0f + __expf(-gt)) * up; }
                int w0 = 0, w1 = 0; w0 = __builtin_amdgcn_cvt_pk_fp8_f32(v[0], v[1], w0, false); w0 = __builtin_amdgcn_cvt_pk_fp8_f32(v[2], v[3], w0, true);
                w1 = __builtin_amdgcn_cvt_pk_fp8_f32(v[4], v[5], w1, false); w1 = __builtin_amdgcn_cvt_pk_fp8_f32(v[6], v[7], w1, true);
                typedef unsigned u32x2_ __attribute__((ext_vector_type(2))); *(u32x2_*)(rowp) = (u32x2_){(unsigned)w0, (unsigned)w1}; }
    }
};
struct EpiDown {
    static constexpr bool PERM = true, AFTER_DRAIN = false;
    bf16_t* Y; const float* gate; float inv;
    __device__ __forceinline__ void operator()(const f32x4 (&acc)[2][2][4][2], const Unit& u, int wr, int wc, int fr, int fq) const {
        const int row0 = u.pm * BM + wr * 64 + fr, col0 = (u.pn & 7) * BM + wc * 32 + 8 * fq;
#pragma unroll
        for (int ai = 0; ai < 2; ++ai)
#pragma unroll
            for (int m = 0; m < 4; ++m) { const int row = row0 + ai * HALF + m * 16; const float gt = gate[row] * inv; bf16_t* rowp = Y + (size_t)row * 2048 + col0;
#pragma unroll
                for (int bj = 0; bj < 2; ++bj) { const f32x4 v0 = acc[ai][bj][m][0] * gt, v1 = acc[ai][bj][m][1] * gt;
                    u32x4 w; w.x = cvt_pk_bf16(v0[0], v0[1]); w.y = cvt_pk_bf16(v0[2], v0[3]); w.z = cvt_pk_bf16(v1[0], v1[1]); w.w = cvt_pk_bf16(v1[2], v1[3]);
                    *(u32x4*)(rowp + bj * HALF) = w; } }
    }
};
struct MoeOrder {
    int G, c, nctx;
    const unsigned* vtab;
    __device__ __forceinline__ u32x4 voff(const Unit& u) const { return *(const u32x4*)(vtab + ((size_t)u.pm * 512 + threadIdx.x) * 4); }
    __device__ __forceinline__ bool next(int i, Unit& u) const {
        long L = (long)i * G + c;
        if (L < 1024) { const int l = (int)L; const int lp = (G == 256) ? (l / 256) * 256 + (l % 8) * 32 + (l % 256) / 8 : l;
            const int s = lp / 32, w = lp % 32, e = s / 2, b = s % 2; u.pm = (b * 16 + e) * 4 + (w % 4); u.pn = e * 8 + (w / 4); return true; }
        L -= 1024; if (L < nctx) { const int e = (int)L / 8; u.pm = 128 + e; u.pn = e * 8 + (int)L % 8; return true; }
        return false;
    }
    __device__ __forceinline__ void a_ready(const Unit&) const {}
    __device__ __forceinline__ void done(const Unit&) const {}
};
}
#define XB_TMO      128
#define XB_XCNT(j)  (256  + 64 * (j))
#define XB_XSUB(j)  (1280 + 64 * (j))
#define XB_XGEN(j)  (2304 + 64 * (j))
#define XB_TOP      3328
#define XB_TOPGEN   3392
#define XCD_BAR_WORDS 3456
#define XB_SPIN_CAP (1u << 22)

__device__ __forceinline__ unsigned xb_ld(unsigned* p)              { return __hip_atomic_load(p, __ATOMIC_RELAXED, __HIP_MEMORY_SCOPE_AGENT); }
__device__ __forceinline__ unsigned xb_add(unsigned* p, unsigned v) { return __hip_atomic_fetch_add(p, v, __ATOMIC_RELAXED, __HIP_MEMORY_SCOPE_AGENT); }
__device__ __forceinline__ unsigned xb_xcc_id() { return (unsigned)__builtin_amdgcn_s_getreg((3 << 11) | 20) & 0xFu; }
#define XB_SPIN(cond, bar) do { unsigned _sp = 0; while (cond) { __builtin_amdgcn_s_sleep(1); \
    if ((++_sp & 255u) == 0u) { if (xb_ld(&(bar)[XB_TMO])) break; if (_sp > XB_SPIN_CAP) { atomicAdd(&(bar)[XB_TMO], 1u); break; } } } } while (0)

struct XcdBarrier {
    unsigned* bar; unsigned x;
    volatile LAS unsigned* st;
};

__device__ __forceinline__ XcdBarrier xcd_barrier_post(unsigned* bar, volatile LAS unsigned* st) {
    XcdBarrier b; b.bar = bar; b.x = xb_xcc_id(); b.st = st;
    if (threadIdx.x == 0) (void)xb_add(&bar[XB_XCNT(b.x)], 1u);
    return b;
}
__device__ __forceinline__ void xcd_barrier_complete(unsigned* bar, unsigned x, unsigned& nloc, unsigned& nx) {
    const unsigned G = gridDim.x * gridDim.y * gridDim.z;
    unsigned sum, cnt, mine, sp = 0u;
    for (;;) {
        sum = 0u; cnt = 0u; mine = 0u;
#pragma unroll
        for (unsigned j = 0; j < 16; ++j) { const unsigned c = xb_ld(&bar[XB_XCNT(j)]); sum += c; cnt += (c > 0u) ? 1u : 0u; mine = (j == x) ? c : mine; }
        if (sum == G) break;
        __builtin_amdgcn_s_sleep(1);
        if ((++sp & 255u) == 0u) { if (xb_ld(&bar[XB_TMO])) break; if (sp > XB_SPIN_CAP) { atomicAdd(&bar[XB_TMO], 1u); break; } }
    }
    nloc = mine > 0u ? mine : 1u; nx = cnt > 0u ? cnt : 1u;
}

__device__ __forceinline__ void xcd_barrier(const XcdBarrier& b) {
    asm volatile("s_waitcnt vmcnt(0)" ::: "memory");
    __syncthreads();
    if (threadIdx.x == 0) {
        unsigned* bar = b.bar;
        __builtin_amdgcn_s_waitcnt(0);
        unsigned nloc = b.st[0], nx = b.st[1];
        if (nloc == 0u) { xcd_barrier_complete(bar, b.x, nloc, nx); b.st[0] = nloc; b.st[1] = nx; }
        const unsigned old = xb_add(&bar[XB_XSUB(b.x)], 1u);
        const unsigned gen = old / nloc;
        if (old + 1u == (gen + 1u) * nloc) {
            __builtin_amdgcn_fence(__ATOMIC_RELEASE, "agent");
            asm volatile("s_waitcnt vmcnt(0)" ::: "memory");
            const unsigned og = xb_add(&bar[XB_TOP], 1u);
            const unsigned tg = og / nx;
            if (og + 1u == (tg + 1u) * nx) xb_add(&bar[XB_TOPGEN], 1u);
            else XB_SPIN(xb_ld(&bar[XB_TOPGEN]) == tg, bar);
            __builtin_amdgcn_fence(__ATOMIC_ACQUIRE, "agent");
            xb_add(&bar[XB_XGEN(b.x)], 1u);
            asm volatile("s_waitcnt vmcnt(0)" ::: "memory");
        } else {
            XB_SPIN(xb_ld(&bar[XB_XGEN(b.x)]) == gen, bar);
            __builtin_amdgcn_fence(__ATOMIC_ACQUIRE, "agent");
            asm volatile("s_waitcnt vmcnt(0)" ::: "memory");
        }
    }
    __syncthreads();
}

struct Params { const float* in[31]; float* out; unsigned char* ws; int ph_lo, ph_hi; };
enum { I_X = 0, I_C, I_CTX, I_CCTX, I_MODW, I_MODB, I_NORMG, I_EVWIN, I_EVWOUT, I_HGLB, I_HGNG, I_S5ARE, I_S5AIM, I_S5LDT, I_S5BRE, I_S5BIM, I_S5CRE, I_S5CIM, I_S5D, I_S5GLUW, I_S5GLUB,
       I_ODWIN, I_ODCONV, I_ODALOG, I_ODDTB, I_ODNG, I_ODWOUT, I_ROUTER, I_MOEG, I_MOEU, I_MOED };
struct Frame { LAS unsigned char* lds; int tid, lane, wave, G, bid; };
#define WSP(T, off) ((T*)(P.ws + (off)))

struct TrTile { const float* src; bf16_t* dst; int N, K; float s8; };
DI void tr_issue(const TrTile& t, f32x4 (&v)[4], int tid) {
#pragma unroll
    for (int i = 0; i < 4; ++i) { const int idx = tid + 512 * i, kr = idx >> 4, nc = (idx & 15) * 4; v[i] = *(const f32x4*)(t.src + (size_t)kr * t.N + nc); }
}
DI void tr_finish(const TrTile& t, const f32x4 (&v)[4], LAS unsigned char* lds, int buf, int tid) {
    if (t.s8 != 0.f) {
        LAS unsigned char* t8 = lds + buf * 17408;
#pragma unroll
        for (int i = 0; i < 4; ++i) { const int idx = tid + 512 * i, kr = idx >> 4, nc = (idx & 15) * 4; const unsigned w = cvt4_fp8(v[i][0] * t.s8, v[i][1] * t.s8, v[i][2] * t.s8, v[i][3] * t.s8);
            t8[(nc + 0) * 144 + kr] = (unsigned char)(w & 0xffu); t8[(nc + 1) * 144 + kr] = (unsigned char)((w >> 8) & 0xffu); t8[(nc + 2) * 144 + kr] = (unsigned char)((w >> 16) & 0xffu); t8[(nc + 3) * 144 + kr] = (unsigned char)(w >> 24); }
        __syncthreads();
        { const int n = tid >> 3, ch = tid & 7; *(u32x4*)((unsigned char*)t.dst + (size_t)n * t.K + ch * 16) = *(const LAS u32x4*)(t8 + n * 144 + ch * 16); }
        return; }
    LAS bf16_t* tT = (LAS bf16_t*)(lds + buf * 17408);
#pragma unroll
    for (int i = 0; i < 4; ++i) { const int idx = tid + 512 * i, kr = idx >> 4, nc = (idx & 15) * 4;
        const unsigned a = pk2(v[i][0], v[i][1]), b = pk2(v[i][2], v[i][3]);
        tT[(nc + 0) * 136 + kr] = (bf16_t)(a & 0xffffu); tT[(nc + 1) * 136 + kr] = (bf16_t)(a >> 16); tT[(nc + 2) * 136 + kr] = (bf16_t)(b & 0xffffu); tT[(nc + 3) * 136 + kr] = (bf16_t)(b >> 16); }
    __syncthreads();
#pragma unroll
    for (int i = 0; i < 2; ++i) { const int idx = tid + 512 * i, n = idx >> 4, ch = idx & 15;
        const u32x4 w = *(const LAS u32x4*)(tT + n * 136 + ch * 8);
        *(u32x4*)(t.dst + (size_t)n * t.K + ch * 8) = w; }
}
DI TrTile tr_desc(const float* src, int N, int k0, int n0, bf16_t* dst, int K, int drow0) { TrTile t; t.src = src + (size_t)k0 * N + n0; t.dst = dst + (size_t)drow0 * K + k0; t.N = N; t.K = K; t.s8 = 0.f; return t; }
DI TrTile tr_desc8(const float* src, int N, int k0, int n0, unsigned char* dst, int K, int drow0, float s8) { TrTile t; t.src = src + (size_t)k0 * N + n0; t.dst = (bf16_t*)(dst + (size_t)drow0 * K + k0); t.N = N; t.K = K; t.s8 = s8; return t; }
DI TrTile tr_moe_desc(const Params& P, int layer, int idx, bf16_t* WGU, bf16_t* WDN) {
    const int e = idx / 768, rem = idx % 768, which = rem / 256, t = rem % 256;
    if (which < 2) { const float* src = P.in[which ? I_MOEU : I_MOEG] + (size_t)(layer * 16 + e) * 2048 * 1024; const int kt = t / 16, nt = t % 16, n0 = nt * 64;
        return tr_desc8(src, 1024, kt * 128, n0, (unsigned char*)WGU + (size_t)e * 2048 * 2048, 2048, (n0 / 128) * 256 + (n0 % 128) + which * 128, W8_GU); }
    const float* src = P.in[I_MOED] + (size_t)(layer * 16 + e) * 1024 * 2048; const int kt = t / 32, nt = t % 32;
    return tr_desc8(src, 2048, kt * 128, nt * 64, (unsigned char*)WDN + (size_t)e * 2048 * 1024, 1024, nt * 64, W8_DN);
}
DI void t4_issue(const TrTile& t, f32x4 (&v)[4], int tid) { const int kb = tid >> 4, nb = tid & 15;
#pragma unroll
    for (int r = 0; r < 4; ++r) v[r] = *(const f32x4*)(t.src + (size_t)(4 * kb + r) * t.N + 4 * nb); }
DI void t4_lds(const TrTile& t, const f32x4 (&v)[4], LAS unsigned char* img, int tid) { const int kb = tid >> 4, nb = tid & 15;
#pragma unroll
    for (int j = 0; j < 4; ++j) *(LAS unsigned*)(img + (4 * nb + j) * 144 + 4 * kb) = cvt4_fp8(v[0][j] * t.s8, v[1][j] * t.s8, v[2][j] * t.s8, v[3][j] * t.s8); }
DI void t4_store(const TrTile& t, const LAS unsigned char* img, int tid) { const int n = tid >> 3, ch = tid & 7; *(u32x4*)((unsigned char*)t.dst + (size_t)n * t.K + ch * 16) = *(const LAS u32x4*)(img + n * 144 + ch * 16); }
constexpr int L1Q_END = 12288 - NB * HGH * NCHUNK;
DI void l1w_from_queue(const Params& P, const Frame& F, int quota) {
    volatile LAS int* slot = (volatile LAS int*)(F.lds + LDS_MISC - 16); unsigned* ctr = WSP(unsigned, WS_CTL) + 256;
    __syncthreads();
    if (F.tid == 0) *slot = quota > 0 ? (int)__hip_atomic_fetch_add(ctr, (unsigned)quota, __ATOMIC_RELAXED, __HIP_MEMORY_SCOPE_AGENT) : (int)__hip_atomic_load(ctr, __ATOMIC_RELAXED, __HIP_MEMORY_SCOPE_AGENT);
    __syncthreads();
    int t = *slot, step = 1, end = t + quota;
    if (quota < 0) { t += F.bid; step = F.G; end = L1Q_END; }
    if (end > L1Q_END) end = L1Q_END;
    if (t >= end) return;
    TrTile cur = tr_moe_desc(P, 1, t, WSP(bf16_t, WS_WGU1), WSP(bf16_t, WS_WDN1)); f32x4 va[4], vb[4]; tr_issue(cur, va, F.tid); int buf = 0;
    for (;;) { const int tn = t + step; const bool more = tn < end; TrTile nx = cur; if (more) { nx = tr_moe_desc(P, 1, tn, WSP(bf16_t, WS_WGU1), WSP(bf16_t, WS_WDN1)); tr_issue(nx, vb, F.tid); }
        tr_finish(cur, va, F.lds, buf, F.tid); buf ^= 1;
        if (!more) break;
#pragma unroll
        for (int i = 0; i < 4; ++i) va[i] = vb[i];
        cur = nx; t = tn; }
    __syncthreads();
}
constexpr int P0_NMOD = 384, P0_NS5 = 64, P0_T0 = P0_NMOD + P0_NS5 + 1;
constexpr int P0_TEVIN = 16 * 96, P0_TEVOUT = 16 * 32, P0_TODIN = 16 * 194, P0_TODOUT = 32 * 32, P0_TMOE = 12288;
constexpr int P0_NTASK = P0_T0 + P0_TEVIN + P0_TEVOUT + P0_TODIN + P0_TODOUT;
constexpr int P0_LDS_SC = 20480, P0_LDS_RED = 45056;

DI void p0_modgemv(const Params& P, const Frame& F, int task) {
    const int layer = task / 192, cg = task % 192, rg = F.tid >> 4, l16 = F.tid & 15, col = cg * 64 + l16 * 4;
    const LAS float* SC = (const LAS float*)(F.lds + P0_LDS_SC); LAS float* RED = (LAS float*)(F.lds + P0_LDS_RED);
    const float* W = P.in[I_MODW] + (size_t)layer * 2048 * 12288 + col;
    f32x4 a0 = {0, 0, 0, 0}, a1 = a0, a2 = a0;
#pragma unroll 8
    for (int kk = 0; kk < 64; ++kk) { const int k = rg + 32 * kk; const f32x4 w = *(const f32x4*)(W + (size_t)k * 12288);
        a0 += w * SC[k]; a1 += w * SC[2048 + k]; a2 += w * SC[4096 + k]; }
#pragma unroll
    for (int j = 0; j < 4; ++j) { RED[(rg * 3 + 0) * 64 + l16 * 4 + j] = a0[j]; RED[(rg * 3 + 1) * 64 + l16 * 4 + j] = a1[j]; RED[(rg * 3 + 2) * 64 + l16 * 4 + j] = a2[j]; }
    __syncthreads();
    if (F.tid < 192) { const int i = F.tid / 64, cc = F.tid % 64; float s = 0.f;
#pragma unroll 8
        for (int r = 0; r < 32; ++r) s += RED[(r * 3 + i) * 64 + cc];
        WSP(float, WS_MODV)[(size_t)(layer * 3 + i) * 12288 + cg * 64 + cc] = s + P.in[I_MODB][layer * 12288 + cg * 64 + cc]; }
    __syncthreads();
}
DI void p0_s5(const Params& P, const Frame& F, int g) {
    LAS float* BBr = (LAS float*)F.lds; LAS float* BBi = BBr + 2048; LAS float* CMr = BBr + 4096; LAS float* CMi = BBr + 6144;
    LAS float* APr = BBr + 8192; LAS float* APi = APr + 2176;
    LAS float* KT = BBr + 8192 + 4352;
    const int tid = F.tid;
    if (tid < 128) { const int dir = tid >> 6, p = tid & 63; const int gi = (dir * 64 + g) * 64 + p;
        const float ar = P.in[I_S5ARE][gi], ai = P.in[I_S5AIM][gi], dt = __expf(P.in[I_S5LDT][dir * 64 + g]);
        const float mag = ar * dt, ang = ai * dt; float sn, cs; sincosf(ang, &sn, &cs); const float em = expf(mag);
        const float nr = em * cs - 1.0f, ni = em * sn, den = 1.0f / (ar * ar + ai * ai);
        const float cr = (nr * ar + ni * ai) * den, ci = (ni * ar - nr * ai) * den;
        for (int c = 0; c < 16; ++c) { const float br = P.in[I_S5BRE][(size_t)gi * 16 + c], bi = P.in[I_S5BIM][(size_t)gi * 16 + c];
            BBr[(dir * 64 + p) * 16 + c] = cr * br - ci * bi; BBi[(dir * 64 + p) * 16 + c] = cr * bi + ci * br; }
        for (int l = 0; l <= 16; ++l) { float s2, c2; sincosf((float)l * ang, &s2, &c2); const float e2 = expf((float)l * mag); APr[(dir * 17 + l) * 64 + p] = e2 * c2; APi[(dir * 17 + l) * 64 + p] = e2 * s2; }
        float* a16 = WSP(float, WS_S5A16) + (size_t)gi * 2; a16[0] = APr[(dir * 17 + 16) * 64 + p]; a16[1] = APi[(dir * 17 + 16) * 64 + p]; }
    for (int i = tid; i < 2048; i += 512) { const int dir = i >> 10, c = (i >> 6) & 15, p = i & 63; const size_t gi = ((size_t)(dir * 64 + g) * 16 + c) * 64 + p;
        CMr[i] = P.in[I_S5CRE][gi]; CMi[i] = P.in[I_S5CIM][gi]; }
    __syncthreads();
    for (int i = tid; i < 8192; i += 512) { const int dir = i >> 12, l = (i >> 8) & 15, c = (i >> 4) & 15, c2 = i & 15; float acc = 0.f;
        for (int p = 0; p < 64; ++p) { const float Cr = CMr[(dir * 16 + c) * 64 + p], Ci = CMi[(dir * 16 + c) * 64 + p], Pr = APr[(dir * 17 + l) * 64 + p], Pi = APi[(dir * 17 + l) * 64 + p];
            const float tr = Cr * Pr - Ci * Pi, ti = Cr * Pi + Ci * Pr; acc += tr * BBr[(dir * 64 + p) * 16 + c2] - ti * BBi[(dir * 64 + p) * 16 + c2]; }
        KT[i] = acc; }
    __syncthreads();
    bf16_t* WY = WSP(bf16_t, WS_S5WY) + (size_t)g * 256 * 512; bf16_t* WX = WSP(bf16_t, WS_S5WX) + (size_t)g * 256 * 256;
    for (int i = tid; i < 256 * 512; i += 512) { const int row = i >> 9, col = i & 511, j = row >> 4, c = row & 15; float v;
        if (col < 256) { const int ii = col >> 4, c2 = col & 15; v = 0.f;
            if (ii <= j) v += KT[((0 * 16 + (j - ii)) * 16 + c) * 16 + c2];
            if (ii >= j) v += KT[((1 * 16 + (ii - j)) * 16 + c) * 16 + c2];
            if (ii == j && c == c2) v += P.in[I_S5D][g * 16 + c]; }
        else { const int q = col - 256, part = q >> 6, p = q & 63, dir = part >> 1, im = part & 1, l = dir == 0 ? j + 1 : 16 - j;
            const float Cr = CMr[(dir * 16 + c) * 64 + p], Ci = CMi[(dir * 16 + c) * 64 + p], Pr = APr[(dir * 17 + l) * 64 + p], Pi = APi[(dir * 17 + l) * 64 + p];
            v = im ? -(Cr * Pi + Ci * Pr) : (Cr * Pr - Ci * Pi); }
        WY[i] = f2bf(v); }
    for (int i = tid; i < 256 * 256; i += 512) { const int row = i >> 8, col = i & 255, part = row >> 6, p = row & 63, dir = part >> 1, im = part & 1, ii = col >> 4, c2 = col & 15, l = dir == 0 ? 15 - ii : ii;
        const float Pr = APr[(dir * 17 + l) * 64 + p], Pi = APi[(dir * 17 + l) * 64 + p], Br = BBr[(dir * 64 + p) * 16 + c2], Bi = BBi[(dir * 64 + p) * 16 + c2];
        WX[i] = f2bf(im ? (Pr * Bi + Pi * Br) : (Pr * Br - Pi * Bi)); }
    __syncthreads();
}
DI void p0_prologue(const Params& P, const Frame& F, int rep) {
    if (F.bid < P0_NMOD) {
        LAS float* SC = (LAS float*)(F.lds + P0_LDS_SC);
        for (int i = F.tid; i < 6144; i += 512) { const float v = i < 4096 ? P.in[I_C][i] : P.in[I_CCTX][i - 4096]; SC[i] = siluf_(v); }
        __syncthreads();
    }
    int task = F.bid;
    for (; task < P0_T0; task += F.G) {
        if (task < P0_NMOD) p0_modgemv(P, F, task);
        else if (task < P0_NMOD + P0_NS5) p0_s5(P, F, task - P0_NMOD);
        else { for (int i = F.tid; i < 2048; i += 512) { const float a0 = P.in[I_HGLB][i], a1 = P.in[I_HGLB][2048 + i]; WSP(float, WS_LB)[i] = 1.0f / (1.0f + __expf(a1 - a0)); } }
    }
    __syncthreads();
    auto desc = [&](int tk) -> TrTile { int t = tk - P0_T0;
        if (t < P0_TEVIN) return tr_desc(P.in[I_EVWIN], 6144, (t / 96) * 128, (t % 96) * 64, WSP(bf16_t, WS_WEVIN), 2048, (t % 96) * 64); t -= P0_TEVIN;
        if (t < P0_TEVOUT) return tr_desc8(P.in[I_EVWOUT], 2048, (t / 32) * 128, (t % 32) * 64, WSP(unsigned char, WS_WEVOUT), 2048, (t % 32) * 64, W8_GU); t -= P0_TEVOUT;
        if (t < P0_TODIN) { const int k0 = (t / 194) * 128, j = t % 194;
            const bool q8 = OD8_MODE >= 2, k8 = OD8_MODE >= 3;
            int r8 = -1, rb = -1;
            if (j < 32) { if (q8) r8 = j * 64; else rb = j * 64; }
            else if (j < 64) { if (k8) r8 = j * 64; else rb = (q8 ? j - 32 : j) * 64; }
            else if (j < 192) r8 = (j - 64) * 64 + (q8 ? 2048 : 0) + (k8 ? 2048 : 0);
            else rb = ODA_N - 256 + (j - 192) * 64;
            if (r8 >= 0) return tr_desc8(P.in[I_ODWIN], ODIN, k0, j * 64, WSP(unsigned char, WS_WODIN8), 2048, r8, W8_GU);
            return tr_desc(P.in[I_ODWIN], ODIN, k0, j * 64, WSP(bf16_t, WS_WODIN), 2048, rb); }
        t -= P0_TODIN;
        return tr_desc8(P.in[I_ODWOUT], 2048, (t / 32) * 128, (t % 32) * 64, WSP(unsigned char, WS_WODOUT), 4096, (t % 32) * 64, W8_GU); };
    { constexpr int PC = 4, NT = P0_NTASK - P0_T0; unsigned* ctr = WSP(unsigned, WS_CTL) + 320 + rep; volatile LAS int* slot = (volatile LAS int*)(F.lds + LDS_MISC - 16);
      if (F.tid == 0) { slot[0] = (int)__hip_atomic_fetch_add(ctr, (unsigned)PC, __ATOMIC_RELAXED, __HIP_MEMORY_SCOPE_AGENT); slot[1] = (int)__hip_atomic_fetch_add(ctr, (unsigned)PC, __ATOMIC_RELAXED, __HIP_MEMORY_SCOPE_AGENT); }
      __syncthreads();
      int t = slot[0], nbase = slot[1], k = 0, pend = 0; __syncthreads();
      if (t < NT) { TrTile cur = desc(P0_T0 + t); f32x4 va[4], vb[4]; tr_issue(cur, va, F.tid); int buf = 0;
        for (;;) { if (k == 0 && F.tid == 0) pend = (int)__hip_atomic_fetch_add(ctr, (unsigned)PC, __ATOMIC_RELAXED, __HIP_MEMORY_SCOPE_AGENT);
            const bool endc = (k == PC - 1); const int tn = endc ? nbase : t + 1; const bool more = tn < NT; TrTile nx = cur; if (more) { nx = desc(P0_T0 + tn); tr_issue(nx, vb, F.tid); }
            if (endc && F.tid == 0) slot[0] = pend;
            tr_finish(cur, va, F.lds, buf, F.tid); buf ^= 1;
            if (endc) nbase = slot[0];
            if (!more) break;
#pragma unroll
            for (int i = 0; i < 4; ++i) va[i] = vb[i];
            cur = nx; t = tn; k = endc ? 0 : k + 1; } } }
    __syncthreads();
}

DI void row_load(const float* src, int lane, f32x4 (&v)[8]) {
#pragma unroll
    for (int i = 0; i < 8; ++i) v[i] = *(const f32x4*)(src + i * 256 + lane * 4);
}
DI float row_rs(const f32x4 (&v)[8]) { float ss = 0.f;
#pragma unroll
    for (int i = 0; i < 8; ++i) ss += v[i][0] * v[i][0] + v[i][1] * v[i][1] + v[i][2] * v[i][2] + v[i][3] * v[i][3];
    ss = wave_sum(ss); return rsqrtf(ss * (1.0f / 2048.0f) + EPS); }
DI void row_norm_mod(f32x4 (&v)[8], const float* gain, const float* shift, const float* scale, bf16_t* dst, int lane, bool store = true) {
    const float rs = row_rs(v);
#pragma unroll
    for (int i = 0; i < 8; ++i) { const int c = i * 256 + lane * 4; const f32x4 g = *(const f32x4*)(gain + c), sh = *(const f32x4*)(shift + c), sc = *(const f32x4*)(scale + c);
        v[i] = (v[i] * rs * g) * (sc + 1.0f) + sh;
        u32x2 w; w.x = pk2(v[i][0], v[i][1]); w.y = pk2(v[i][2], v[i][3]); if (store) *(u32x2*)(dst + c) = w; }
}
DI void row_norm_mod8(f32x4 (&v)[8], const float* gain, const float* shift, const float* scale, unsigned char* dst, int lane, bool store) {
    const float rs = row_rs(v);
#pragma unroll
    for (int i = 0; i < 8; ++i) { const int c = i * 256 + lane * 4; const f32x4 g = *(const f32x4*)(gain + c), sh = *(const f32x4*)(shift + c), sc = *(const f32x4*)(scale + c);
        v[i] = (v[i] * rs * g) * (sc + 1.0f) + sh;
        if (store) *(unsigned*)(dst + c) = cvt4_fp8(v[i][0], v[i][1], v[i][2], v[i][3]); }
}
DI const float* stream_row_in(const Params& P, int layer_stream, int b, int t) {
    if (layer_stream == 0) return t < LCTX ? P.in[I_CTX] + (size_t)(b * LCTX + t) * DM : P.in[I_X] + (size_t)(b * NLAT + t - LCTX) * DM;
    return t < LCTX ? (const float*)WSP(float, WS_CTXW) + (size_t)(b * LCTX + t) * DM : (const float*)P.out + (size_t)(b * NLAT + t - LCTX) * DM;
}
DI float* stream_row_out(const Params& P, int b, int t) { return t < LCTX ? WSP(float, WS_CTXW) + (size_t)(b * LCTX + t) * DM : P.out + (size_t)(b * NLAT + t - LCTX) * DM; }

DI void p1_hall0(const Params& P, const Frame& F) {
    const float* modv = WSP(float, WS_MODV);
    for (int r = F.bid * 8 + F.wave; r < RR; r += F.G * 8) { const int b = r / TT, t = r % TT, mi = t < LCTX ? 2 : b;
        f32x4 v[8]; row_load(stream_row_in(P, 0, b, t), F.lane, v);
        const float* m = modv + (size_t)(0 * 3 + mi) * 12288;
        row_norm_mod(v, P.in[I_NORMG] + (0 * 4 + 0) * DM, m, m + DM, WSP(bf16_t, WS_HA) + (size_t)r * DM, F.lane); }
}
DI void hg_load8(const bf16_t* p, float (&o)[8]) { const u32x4 w = *(const u32x4*)p; o[0] = bflo(w.x); o[1] = bfhi(w.x); o[2] = bflo(w.y); o[3] = bfhi(w.y); o[4] = bflo(w.z); o[5] = bfhi(w.z); o[6] = bflo(w.w); o[7] = bfhi(w.w); }
DI bf16x8 tr_frag(const LAS bf16_t* base, int ld, int k0, int n0, int lane) { const int g = lane >> 4, qq = (lane & 15) >> 2, pp = lane & 3; const LAS bf16_t* p = base + (k0 + 8 * g + qq) * ld + n0 + 4 * pp;
    const s16x4 a = __builtin_amdgcn_ds_read_tr16_b64_v4i16((LAS s16x4*)p), b = __builtin_amdgcn_ds_read_tr16_b64_v4i16((LAS s16x4*)(p + 4 * ld));
    return (bf16x8){a[0], a[1], a[2], a[3], b[0], b[1], b[2], b[3]}; }
DI void cv8(const u32x4& w, float (&o)[8]) { o[0] = bflo(w.x); o[1] = bfhi(w.x); o[2] = bflo(w.y); o[3] = bfhi(w.y); o[4] = bflo(w.z); o[5] = bfhi(w.z); o[6] = bflo(w.w); o[7] = bfhi(w.w); }
DI void hga_item(const Params& P, const Frame& F, int item) {
    const int c = item % NCHUNK, bh = item / NCHUNK, h = bh % HGH, b = bh / HGH, tid = F.tid;
    const bf16_t* P0 = WSP(bf16_t, WS_P0) + (size_t)(b * TT + c * 64) * EVIN + h * 128;
    const float* LB = WSP(float, WS_LB);
    LAS float* LF = (LAS float*)F.lds;
    LAS bf16_t* KL = (LAS bf16_t*)(F.lds + 65536);
    LAS bf16_t* VL = (LAS bf16_t*)(F.lds + 100352);
    LAS float* SEG = (LAS float*)(F.lds + 117760);
    LAS bf16_t* OUT = (LAS bf16_t*)F.lds;
    LAS unsigned char* IMG0 = F.lds + 119808; LAS unsigned char* IMG1 = IMG0 + 9216;
    const TrTile tA = tr_moe_desc(P, 0, 2 * item, WSP(bf16_t, WS_WGU), WSP(bf16_t, WS_WDN)), tB = tr_moe_desc(P, 0, 2 * item + 1, WSP(bf16_t, WS_WGU), WSP(bf16_t, WS_WDN));
    f32x4 wa[4], wb[4]; t4_issue(tA, wa, tid); t4_issue(tB, wb, tid);
#pragma unroll
    for (int i = 0; i < 2; ++i) { const int idx = tid + 512 * i, tok = idx >> 4, k0 = (idx & 15) * 8; float x[8];
#pragma unroll
        for (int dir = 0; dir < 2; ++dir) { hg_load8(P0 + (size_t)tok * EVIN + 1024 * (1 + dir) + k0, x); float kk[8];
#pragma unroll
            for (int j = 0; j < 8; ++j) { const float lb = LB[dir * 1024 + h * 128 + k0 + j], f = lb + (1.0f - lb) * sigmoidf_(x[j]); LF[(dir * 64 + tok) * 128 + k0 + j] = __logf(f); kk[j] = 1.0f - f; }
            *(LAS u32x4*)(KL + (dir * 64 + tok) * 136 + k0) = (u32x4){pk2(kk[0], kk[1]), pk2(kk[2], kk[3]), pk2(kk[4], kk[5]), pk2(kk[6], kk[7])}; }
        *(LAS u32x4*)(VL + tok * 136 + k0) = *(const u32x4*)(P0 + (size_t)tok * EVIN + 3072 + k0); }
    __syncthreads();
    const int sdir = tid >> 8, sseg = (tid >> 7) & 1, skd = tid & 127;
    { float tot = 0.f;
#pragma unroll 8
      for (int s = 0; s < 32; ++s) { const int ss = sseg * 32 + s, t = sdir ? 63 - ss : ss; tot += LF[(sdir * 64 + t) * 128 + skd]; }
      SEG[(sdir * 2 + sseg) * 128 + skd] = tot; }
    t4_lds(tA, wa, IMG0, tid);
    __syncthreads();
    t4_store(tA, IMG0, tid);
    { const float s0 = SEG[(sdir * 2 + 0) * 128 + skd], s1 = SEG[(sdir * 2 + 1) * 128 + skd], tot = s0 + s1; float run = sseg ? s0 : 0.f;
#pragma unroll 8
      for (int s = 0; s < 32; ++s) { const int ss = sseg * 32 + s, t = sdir ? 63 - ss : ss; run += LF[(sdir * 64 + t) * 128 + skd];
          const float kk = bf2f(KL[(sdir * 64 + t) * 136 + skd]); KL[(sdir * 64 + t) * 136 + skd] = f2bf(kk * __expf(tot - run));
          if (ss == 31) WSP(float, WS_REFX)[(size_t)((bh * 2 + sdir) * NCHUNK + c) * 128 + skd] = __expf(run); }
      if (sseg == 0) WSP(float, WS_DEC)[(size_t)((bh * 2 + sdir) * NCHUNK + c) * 128 + skd] = __expf(tot); }
    t4_lds(tB, wb, IMG1, tid);
    const TrTile tC = tr_moe_desc(P, 1, L1Q_END + item, WSP(bf16_t, WS_WGU1), WSP(bf16_t, WS_WDN1)); t4_issue(tC, wa, tid);
    __syncthreads();
    t4_store(tB, IMG1, tid);
    {
        const int w = F.wave, lane = F.lane, l15 = lane & 15, q = lane >> 4;
        const bf16x8 a0 = tr_frag(VL, 136, 0, 16 * w, lane), a1 = tr_frag(VL, 136, 32, 16 * w, lane);
#pragma unroll 1
        for (int dir = 0; dir < 2; ++dir) {
#pragma unroll 2
            for (int nt = 0; nt < 8; ++nt) { f32x4 acc = {0, 0, 0, 0};
                acc = mfma16(a0, tr_frag(KL + dir * 64 * 136, 136, 0, 16 * nt, lane), acc); acc = mfma16(a1, tr_frag(KL + dir * 64 * 136, 136, 32, 16 * nt, lane), acc);
#pragma unroll
                for (int r = 0; r < 4; ++r) OUT[(16 * w + 4 * q + r) * 136 + 16 * nt + l15] = f2bf(acc[r]); }
            bf16_t* dst = WSP(bf16_t, WS_KVT) + (size_t)((bh * 2 + dir) * NCHUNK + c) * 16384;
#pragma unroll
            for (int i = 0; i < 4; ++i) { const int idx = lane + 64 * i, row = 16 * w + (idx >> 4), ch = idx & 15;
                *(u32x4*)(dst + row * 128 + ch * 8) = *(const LAS u32x4*)(OUT + row * 136 + ch * 8); }
        }
    }
    t4_lds(tC, wa, IMG0, tid);
    __syncthreads();
    t4_store(tC, IMG0, tid);
}
DI bf16x8 s5_ufrag(const bf16_t* P0, int g, int mt, int ks, int lane) { const int cr = 16 * mt + (lane & 15), q = lane >> 4;
    return *(const bf16x8*)(P0 + (size_t)(cr * 16 + 2 * ks + (q >> 1)) * EVIN + 5120 + g * 16 + 8 * (q & 1)); }
constexpr int S5_NPART = 9, S5_NTASK = S5G * S5_NPART;
DI void s5xl_group(const Params& P, const Frame& F, int gtask) {
    const int g = gtask / S5_NPART, part = gtask % S5_NPART;
    LAS bf16_t* WXf = (LAS bf16_t*)F.lds;
    const bf16_t* P0 = WSP(bf16_t, WS_P0); const bf16_t* WX = WSP(bf16_t, WS_S5WX) + (size_t)g * 65536; float* XL = WSP(float, WS_XL);
    const int lane = F.lane, l15 = lane & 15, q = lane >> 4;
    const int mt = part < 8 ? 8 * part + F.wave : 64 + (F.wave >> 2), nt_lo = part < 8 ? 0 : 4 * (F.wave & 3), nt_n = part < 8 ? 16 : 4;
    bf16x8 a[8];
#pragma unroll
    for (int ks = 0; ks < 8; ++ks) a[ks] = s5_ufrag(P0, g, mt, ks, lane);
    __syncthreads();
#pragma unroll
    for (int hh = 0; hh < 2; ++hh) { u32x4 w[8];
#pragma unroll
        for (int i = 0; i < 8; ++i) { const int idx = F.tid + 512 * (8 * hh + i), row = idx >> 5, ch = idx & 31; w[i] = *(const u32x4*)(WX + (size_t)row * 256 + ch * 8); }
#pragma unroll
        for (int i = 0; i < 8; ++i) { const int idx = F.tid + 512 * (8 * hh + i), row = idx >> 5, ch = idx & 31; *(LAS u32x4*)(WXf + row * 264 + ch * 8) = w[i]; } }
    __syncthreads();
#pragma unroll 2
    for (int k = 0; k < nt_n; ++k) { const int nt = nt_lo + k; f32x4 acc = {0, 0, 0, 0};
#pragma unroll
        for (int ks = 0; ks < 8; ++ks) acc = mfma16(lds_frag(WXf, 264, 16 * nt, 32 * ks, lane), a[ks], acc);
        { const int cr = 16 * mt + l15, b = cr / S5NCH, n = cr % S5NCH;
          *(f32x4*)(XL + ((size_t)(b * 64 + g) * S5NCH + n) * 256 + 16 * nt + 4 * q) = acc; } }
    __syncthreads();
}
#define BLK_QUEUE_LOOP(ctr, ntask, body) do { volatile LAS int* slot_ = (volatile LAS int*)(F.lds + LDS_MISC - 16); \
    if (F.tid == 0) *slot_ = (int)__hip_atomic_fetch_add((ctr), 1u, __ATOMIC_RELAXED, __HIP_MEMORY_SCOPE_AGENT); __syncthreads(); \
    for (;;) { const int task = *slot_; if (task >= (ntask)) break; int nxt_ = 0; if (F.tid == 0) nxt_ = (int)__hip_atomic_fetch_add((ctr), 1u, __ATOMIC_RELAXED, __HIP_MEMORY_SCOPE_AGENT); \
        body; if (F.tid == 0) *slot_ = nxt_; __syncthreads(); } } while (0)
DI void e2a(const Params& P, const Frame& F, int rep) {
    BLK_QUEUE_LOOP(WSP(unsigned, WS_CTL) + 128 + rep, S5_NTASK + NB * HGH * NCHUNK, { if (task < S5_NTASK) s5xl_group(P, F, task); else hga_item(P, F, task - S5_NTASK); });
}
DI void e2b(const Params& P, const Frame& F) {
    for (int t = F.bid; t < 256; t += F.G) { const int b = t >> 7, g = (t >> 1) & 63, dir = t & 1, p = F.lane, w = F.wave;
        const float* a16 = WSP(float, WS_S5A16) + (size_t)((dir * 64 + g) * 64 + p) * 2; const float ar = a16[0], ai = a16[1];
        const float* XL = WSP(float, WS_XL) + (size_t)(b * 64 + g) * S5NCH * 256 + dir * 128 + p; bf16_t* X0 = WSP(bf16_t, WS_X0) + (size_t)(b * 64 + g) * S5NCH * 256 + dir * 128 + p;
        LAS float* CAR = (LAS float*)F.lds;
        constexpr int SEG = S5NCH / 8;
        float xr = 0.f, xi = 0.f;
#pragma unroll 1
        for (int s0 = w * SEG; s0 < (w + 1) * SEG; s0 += 22) { float lr[22], li[22];
#pragma unroll
            for (int u = 0; u < 22; ++u) { const int sq = s0 + u, nn = dir == 0 ? sq : (sq < S5NCTX ? S5NCTX - 1 - sq : S5NCH + S5NCTX - 1 - sq); lr[u] = XL[(size_t)nn * 256]; li[u] = XL[(size_t)nn * 256 + 64]; }
#pragma unroll
            for (int u = 0; u < 22; ++u) { const float nr = ar * xr - ai * xi + lr[u], ni = ar * xi + ai * xr + li[u]; xr = nr; xi = ni; } }
        CAR[(w * 64 + p) * 2] = xr; CAR[(w * 64 + p) * 2 + 1] = xi;
        float pr = 1.f, pi = 0.f;
#pragma unroll 1
        for (int k = 0; k < SEG; ++k) { const float nr = pr * ar - pi * ai, ni = pr * ai + pi * ar; pr = nr; pi = ni; }
        __syncthreads();
        xr = 0.f; xi = 0.f;
        for (int k = 0; k < w; ++k) { const float er = CAR[(k * 64 + p) * 2], ei = CAR[(k * 64 + p) * 2 + 1]; const float nr = pr * xr - pi * xi + er, ni = pr * xi + pi * xr + ei; xr = nr; xi = ni; }
#pragma unroll 1
        for (int s0 = w * SEG; s0 < (w + 1) * SEG; s0 += 22) { float lr[22], li[22]; int nn[22];
#pragma unroll
            for (int u = 0; u < 22; ++u) { const int sq = s0 + u; nn[u] = dir == 0 ? sq : (sq < S5NCTX ? S5NCTX - 1 - sq : S5NCH + S5NCTX - 1 - sq); lr[u] = XL[(size_t)nn[u] * 256]; li[u] = XL[(size_t)nn[u] * 256 + 64]; }
#pragma unroll
            for (int u = 0; u < 22; ++u) { X0[(size_t)nn[u] * 256] = f2bf(xr); X0[(size_t)nn[u] * 256 + 64] = f2bf(xi);
                const float nr = ar * xr - ai * xi + lr[u], ni = ar * xi + ai * xr + li[u]; xr = nr; xi = ni; } }
        __syncthreads();
    }
    for (int u = F.bid; u < 256; u += F.G) { const int chain = u >> 3, part = u & 7, dir = chain & 1, e = (part * 512 + F.tid) * 4, kd = e & 127;
        const bf16_t* KVT = WSP(bf16_t, WS_KVT) + (size_t)chain * NCHUNK * 16384 + e; bf16_t* SST = WSP(bf16_t, WS_SST) + (size_t)chain * NCHUNK * 16384 + e;
        const float* DEC = WSP(float, WS_DEC) + (size_t)chain * NCHUNK * 128 + kd; const float* RFX = WSP(float, WS_REFX) + (size_t)chain * NCHUNK * 128 + kd;
        f32x4 s = {0, 0, 0, 0};
        for (int n0 = 0; n0 < NCHUNK; n0 += 12) { u32x2 kv[12]; f32x4 d[12], rx[12]; int cc[12];
#pragma unroll
            for (int k = 0; k < 12; ++k) { const int n = n0 + k; cc[k] = dir ? (n < 4 ? 3 - n : NCHUNK + 3 - n) : n; kv[k] = *(const u32x2*)(KVT + (size_t)cc[k] * 16384); d[k] = *(const f32x4*)(DEC + (size_t)cc[k] * 128); rx[k] = *(const f32x4*)(RFX + (size_t)cc[k] * 128); }
#pragma unroll
            for (int k = 0; k < 12; ++k) { u32x2 w; w.x = pk2(s[0] * rx[k][0], s[1] * rx[k][1]); w.y = pk2(s[2] * rx[k][2], s[3] * rx[k][3]); *(u32x2*)(SST + (size_t)cc[k] * 16384) = w;
                s[0] = s[0] * d[k][0] + bflo(kv[k].x); s[1] = s[1] * d[k][1] + bfhi(kv[k].x); s[2] = s[2] * d[k][2] + bflo(kv[k].y); s[3] = s[3] * d[k][3] + bfhi(kv[k].y); } }
    }
}
DI void hgc_item(const Params& P, const Frame& F, int item) {
    const int c = item % NCHUNK, bh = item / NCHUNK, h = bh % HGH, b = bh / HGH, tid = F.tid, lane = F.lane, l15 = lane & 15, q = lane >> 4, w = F.wave;
    const size_t r0 = (size_t)(b * TT + c * 64);
    const bf16_t* P0 = WSP(bf16_t, WS_P0) + r0 * EVIN + h * 128;
    const float* LB = WSP(float, WS_LB);
    LAS float* BF = (LAS float*)F.lds;
    LAS bf16_t* QH = (LAS bf16_t*)(F.lds + 32768);
    LAS bf16_t* KH = (LAS bf16_t*)(F.lds + 50176);
    LAS bf16_t* VL = (LAS bf16_t*)(F.lds + 67584);
    LAS bf16_t* ST = (LAS bf16_t*)(F.lds + 84992);
    LAS bf16_t* ATT = (LAS bf16_t*)(F.lds + 119808);
    LAS float* REFV = (LAS float*)(F.lds + 129024);
    LAS float* SEG = (LAS float*)(F.lds + 129536);
    LAS float* OST = (LAS float*)F.lds;
#pragma unroll
    for (int i = 0; i < 2; ++i) { const int idx = tid + 512 * i, tok = idx >> 4, k0 = (idx & 15) * 8; *(LAS u32x4*)(VL + tok * 136 + k0) = *(const u32x4*)(P0 + (size_t)tok * EVIN + 3072 + k0); }
    const int mt = w >> 1, sseg = tid >> 7, skd = tid & 127;
    u32x4 pq[2], pf[2][2], pg[2];
#pragma unroll
    for (int i = 0; i < 2; ++i) { const int idx = tid + 512 * i, tok = idx >> 4, k0 = (idx & 15) * 8; const bf16_t* rp = P0 + (size_t)tok * EVIN + k0;
        pf[0][i] = *(const u32x4*)(rp + 1024); pf[1][i] = *(const u32x4*)(rp + 2048); pq[i] = *(const u32x4*)rp; }
    { const int t = tid >> 3, v0 = (tid & 7) * 16; pg[0] = *(const u32x4*)(P0 + (size_t)t * EVIN + 4096 + v0); pg[1] = *(const u32x4*)(P0 + (size_t)t * EVIN + 4096 + v0 + 8); }
    f32x4 lbv[2][2], gnv[4];
    { const int k0 = (tid & 15) * 8, v0 = (tid & 7) * 16;
#pragma unroll
      for (int d = 0; d < 2; ++d) { lbv[d][0] = *(const f32x4*)(LB + d * 1024 + h * 128 + k0); lbv[d][1] = *(const f32x4*)(LB + d * 1024 + h * 128 + k0 + 4); }
#pragma unroll
      for (int i = 0; i < 4; ++i) gnv[i] = *(const f32x4*)(P.in[I_HGNG] + v0 + 4 * i); }
    LAS unsigned char* IMG = F.lds + 131584; f32x4 wt[4]; const int tile0 = 4224 + 4 * item; const bool host = tile0 + 3 < 12288;
    TrTile tcur = tr_moe_desc(P, 0, host ? tile0 : 0, WSP(bf16_t, WS_WGU), WSP(bf16_t, WS_WDN)); if (host) t4_issue(tcur, wt, tid);
    f32x4 oacc[4]; for (int i = 0; i < 4; ++i) oacc[i] = (f32x4){0, 0, 0, 0};
#pragma unroll
    for (int dir = 0; dir < 2; ++dir) {
#pragma unroll
        for (int i = 0; i < 2; ++i) { const int idx = tid + 512 * i, tok = idx >> 4, k0 = (idx & 15) * 8; float x[8], kk[8]; cv8(pf[dir][i], x);
#pragma unroll
            for (int j = 0; j < 8; ++j) { const float lb = lbv[dir][j >> 2][j & 3], f = lb + (1.0f - lb) * sigmoidf_(x[j]); BF[tok * 128 + k0 + j] = __logf(f); kk[j] = 1.0f - f; }
            *(LAS u32x4*)(KH + tok * 136 + k0) = (u32x4){pk2(kk[0], kk[1]), pk2(kk[2], kk[3]), pk2(kk[4], kk[5]), pk2(kk[6], kk[7])}; }
        u32x4 stv[4];
        { asm volatile("" ::: "memory"); const bf16_t* SS = WSP(bf16_t, WS_SST) + (size_t)((bh * 2 + dir) * NCHUNK + c) * 16384;
#pragma unroll
          for (int i = 0; i < 4; ++i) { const int idx = tid + 512 * i; stv[i] = *(const u32x4*)(SS + (idx >> 4) * 128 + (idx & 15) * 8); } }
        __syncthreads();
        { float tot = 0.f;
#pragma unroll
          for (int s = 0; s < 16; ++s) { const int ss = sseg * 16 + s, t = dir ? 63 - ss : ss; tot += BF[t * 128 + skd]; }
          SEG[sseg * 128 + skd] = tot; }
        if (host) t4_lds(tcur, wt, IMG, tid);
        __syncthreads();
        if (host) t4_store(tcur, IMG, tid);
        { float run = 0.f;
#pragma unroll
          for (int k = 0; k < 3; ++k) run += (k < sseg) ? SEG[k * 128 + skd] : 0.f;
#pragma unroll
          for (int s = 0; s < 16; ++s) { const int ss = sseg * 16 + s, t = dir ? 63 - ss : ss; run += BF[t * 128 + skd]; BF[t * 128 + skd] = run; if (ss == 31) REFV[skd] = run; } }
#pragma unroll
        for (int i = 0; i < 4; ++i) { const int idx = tid + 512 * i; *(LAS u32x4*)(ST + (idx >> 4) * 136 + (idx & 15) * 8) = stv[i]; }
        if (host) { asm volatile("" ::: "memory"); tcur = tr_moe_desc(P, 0, tile0 + 2 * dir + 1, WSP(bf16_t, WS_WGU), WSP(bf16_t, WS_WDN)); t4_issue(tcur, wt, tid); }
        __syncthreads();
#pragma unroll
        for (int i = 0; i < 2; ++i) { const int idx = tid + 512 * i, tok = idx >> 4, k0 = (idx & 15) * 8; float xq[8], xk[8];
            cv8(pq[i], xq); { const u32x4 kw = *(const LAS u32x4*)(KH + tok * 136 + k0); xk[0] = bflo(kw.x); xk[1] = bfhi(kw.x); xk[2] = bflo(kw.y); xk[3] = bfhi(kw.y); xk[4] = bflo(kw.z); xk[5] = bfhi(kw.z); xk[6] = bflo(kw.w); xk[7] = bfhi(kw.w); }
            unsigned qw[4], kw2[4];
#pragma unroll
            for (int j = 0; j < 8; j += 2) { const float d0 = BF[tok * 128 + k0 + j] - REFV[k0 + j], d1 = BF[tok * 128 + k0 + j + 1] - REFV[k0 + j + 1];
                qw[j >> 1] = pk2(xq[j] * __expf(d0), xq[j + 1] * __expf(d1)); kw2[j >> 1] = pk2(xk[j] * __expf(-d0), xk[j + 1] * __expf(-d1)); }
            *(LAS u32x4*)(QH + tok * 136 + k0) = (u32x4){qw[0], qw[1], qw[2], qw[3]}; *(LAS u32x4*)(KH + tok * 136 + k0) = (u32x4){kw2[0], kw2[1], kw2[2], kw2[3]}; }
        __syncthreads();
#pragma unroll
        for (int tt = 0; tt < 2; ++tt) { const int nt = 2 * (w & 1) + tt; f32x4 acc = {0, 0, 0, 0};
#pragma unroll
            for (int ks = 0; ks < 4; ++ks) acc = mfma16(lds_frag(QH, 136, 16 * mt, 32 * ks, lane), lds_frag(KH, 136, 16 * nt, 32 * ks, lane), acc);
#pragma unroll
            for (int r = 0; r < 4; ++r) { const int t = 16 * mt + 4 * q + r, s = 16 * nt + l15; const bool keep = dir ? (s >= t) : (s <= t); ATT[t * 72 + s] = f2bf(keep ? acc[r] : 0.f); } }
        if (host) t4_lds(tcur, wt, IMG, tid);
        __syncthreads();
        if (host) { t4_store(tcur, IMG, tid); if (dir == 0) { tcur = tr_moe_desc(P, 0, tile0 + 2, WSP(bf16_t, WS_WGU), WSP(bf16_t, WS_WDN)); t4_issue(tcur, wt, tid); } }
#pragma unroll
        for (int tt = 0; tt < 4; ++tt) { const int nt = 4 * (w & 1) + tt;
#pragma unroll
            for (int ks = 0; ks < 2; ++ks) oacc[tt] = mfma16(lds_frag(ATT, 72, 16 * mt, 32 * ks, lane), tr_frag(VL, 136, 32 * ks, 16 * nt, lane), oacc[tt]);
#pragma unroll
            for (int ks = 0; ks < 4; ++ks) oacc[tt] = mfma16(lds_frag(QH, 136, 16 * mt, 32 * ks, lane), lds_frag(ST, 136, 16 * nt, 32 * ks, lane), oacc[tt]); }
        __syncthreads();
    }
#pragma unroll
    for (int tt = 0; tt < 4; ++tt) { const int nt = 4 * (w & 1) + tt;
#pragma unroll
        for (int r = 0; r < 4; ++r) OST[(16 * mt + 4 * q + r) * 132 + 16 * nt + l15] = oacc[tt][r]; }
    __syncthreads();
    {   const int t = tid >> 3, v0 = (tid & 7) * 16; float o[16]; float ss = 0.f;
#pragma unroll
        for (int j = 0; j < 16; ++j) { o[j] = OST[t * 132 + v0 + j]; ss += o[j] * o[j]; }
        ss = row8_sum(ss);
        const float rs = rsqrtf(ss * (1.0f / 128.0f) + EPS);
        float gza[8], gzb[8]; cv8(pg[0], gza); cv8(pg[1], gzb);
        float ov[16];
#pragma unroll
        for (int j = 0; j < 16; ++j) { const float gn = gnv[j >> 2][j & 3]; const float z = j < 8 ? gza[j & 7] : gzb[j & 7]; ov[j] = o[j] * rs * gn * siluf_(z); }
        unsigned char* dst = WSP(unsigned char, WS_OCAT0) + (r0 + t) * DM + h * 128 + v0;
        *(u32x4*)dst = (u32x4){cvt4_fp8(ov[0], ov[1], ov[2], ov[3]), cvt4_fp8(ov[4], ov[5], ov[6], ov[7]), cvt4_fp8(ov[8], ov[9], ov[10], ov[11]), cvt4_fp8(ov[12], ov[13], ov[14], ov[15])}; }
    __syncthreads();
}
DI void s5y_group(const Params& P, const Frame& F, int gtask) {
    const int g = gtask / S5_NPART, part = gtask % S5_NPART;
    LAS bf16_t* WYh = (LAS bf16_t*)F.lds;
    const bf16_t* P0 = WSP(bf16_t, WS_P0); const bf16_t* WY = WSP(bf16_t, WS_S5WY) + (size_t)g * 256 * 512; const bf16_t* X0 = WSP(bf16_t, WS_X0);
    const int lane = F.lane, l15 = lane & 15, q = lane >> 4;
    const int mt = part < 8 ? 8 * part + F.wave : 64 + (F.wave >> 2), nt_lo = part < 8 ? 0 : 2 * (F.wave & 3), nt_n = part < 8 ? 8 : 2;
    bf16x8 gwa; { float t[4];
#pragma unroll
      for (int j = 0; j < 4; ++j) t[j] = P.in[I_S5GLUW][(g * 16 + 4 * q + j) * 16 + l15];
      gwa = __builtin_bit_cast(bf16x8, (u32x4){pk2(t[0], t[1]), pk2(t[2], t[3]), 0u, 0u}); }
    const f32x4 gbv = *(const f32x4*)(P.in[I_S5GLUB] + g * 16 + 4 * q);
    bf16x8 a[16];
#pragma unroll
    for (int ks = 0; ks < 8; ++ks) a[ks] = s5_ufrag(P0, g, mt, ks, lane);
    { const int cr = 16 * mt + l15, b = cr / S5NCH, n = cr % S5NCH; const bf16_t* xp = X0 + ((size_t)(b * 64 + g) * S5NCH + n) * 256 + 8 * q;
#pragma unroll
      for (int ks = 0; ks < 8; ++ks) a[8 + ks] = *(const bf16x8*)(xp + 32 * ks); }
    for (int nh = 0; nh < 2; ++nh) {
        __syncthreads();
#pragma unroll
        for (int hh = 0; hh < 2; ++hh) { u32x4 w[8];
#pragma unroll
            for (int i = 0; i < 8; ++i) { const int idx = F.tid + 512 * (8 * hh + i), row = idx >> 6, ch = idx & 63; w[i] = *(const u32x4*)(WY + (size_t)(nh * 128 + row) * 512 + ch * 8); }
#pragma unroll
            for (int i = 0; i < 8; ++i) { const int idx = F.tid + 512 * (8 * hh + i), row = idx >> 6, ch = idx & 63; *(LAS u32x4*)(WYh + row * 520 + ch * 8) = w[i]; } }
        __syncthreads();
#pragma unroll 1
        for (int k = 0; k < nt_n; ++k) { const int nt = nt_lo + k; f32x4 acc = {0, 0, 0, 0};
#pragma unroll
            for (int ks = 0; ks < 16; ++ks) acc = mfma16(lds_frag(WYh, 520, 16 * nt, 32 * ks, lane), a[ks], acc);
            float y[4];
#pragma unroll
            for (int r = 0; r < 4; ++r) { const float x = acc[r], u = 0.7978845608f * (x + 0.044715f * x * x * x); y[r] = 0.5f * x * (2.0f - 2.0f * rcpf_(1.0f + __expf(2.0f * u))); }
            const bf16x8 yb = __builtin_bit_cast(bf16x8, (u32x4){pk2(y[0], y[1]), pk2(y[2], y[3]), 0u, 0u});
            const f32x4 z = mfma16(gwa, yb, gbv);
            const int j = 8 * nh + nt, cr = 16 * mt + l15;
            float ov[4];
#pragma unroll
            for (int r = 0; r < 4; ++r) { ov[r] = y[r] * sigmoidf_(z[r]);
#ifdef MK_DBG_NO_S5
                ov[r] = 0.f;
#endif
            }
            *(unsigned*)(WSP(unsigned char, WS_OCAT0) + (size_t)(cr * 16 + j) * DM + 1024 + g * 16 + 4 * q) = cvt4_fp8(ov[0], ov[1], ov[2], ov[3]);
        }
    }
    __syncthreads();
}
DI void e2c(const Params& P, const Frame& F, int rep) {
    BLK_QUEUE_LOOP(WSP(unsigned, WS_CTL) + 192 + rep, S5_NTASK + NB * HGH * NCHUNK, { if (task < S5_NTASK) s5y_group(P, F, task); else hgc_item(P, F, task - S5_NTASK); });
}
DI void row_post_mixer(const Params& P, const Frame& F, int layer) {
    LAS float* RWT = (LAS float*)F.lds;
    { const float* rw = P.in[I_ROUTER] + (size_t)layer * DM * NEXP; f32x4 rv[16];
#pragma unroll
      for (int j = 0; j < 16; ++j) rv[j] = *(const f32x4*)(rw + (size_t)(F.tid + 512 * j) * 4);
#pragma unroll
      for (int j = 0; j < 16; ++j) { const int i4 = F.tid + 512 * j, k = i4 >> 2, e0 = (i4 & 3) * 4;
#pragma unroll
          for (int jj = 0; jj < 4; ++jj) RWT[(e0 + jj) * DM + k] = rv[j][jj]; } }
    __syncthreads();
    const float* modv = WSP(float, WS_MODV); const float* ng = P.in[I_NORMG] + (size_t)layer * 4 * DM;
    const int nrows = layer == 0 ? RR : NB * NLAT, lane = F.lane, stride = F.G * 8;
    for (int rr0 = F.bid * 8 + F.wave; rr0 < nrows; rr0 += 2 * stride) {
        int b[2], t[2]; bool ok[2]; f32x4 v[2][8], x[2][8]; const float* m[2]; float* xo[2];
#pragma unroll
        for (int u = 0; u < 2; ++u) { int rr = rr0 + u * stride; ok[u] = rr < nrows; if (!ok[u]) rr = rr0;
            const bf16_t* mix;
            if (layer == 0) { b[u] = rr / TT; t[u] = rr % TT; mix = WSP(bf16_t, WS_MIX) + (size_t)rr * DM; } else { b[u] = rr / NLAT; t[u] = LCTX + rr % NLAT; mix = WSP(bf16_t, WS_MIX1) + (size_t)rr * DM; }
            const int mi = t[u] < LCTX ? 2 : b[u]; m[u] = modv + (size_t)(layer * 3 + mi) * 12288; xo[u] = stream_row_out(P, b[u], t[u]);
#pragma unroll
            for (int i = 0; i < 8; ++i) { const u32x2 w2 = *(const u32x2*)(mix + i * 256 + lane * 4); v[u][i] = (f32x4){bflo(w2.x), bfhi(w2.x), bflo(w2.y), bfhi(w2.y)}; }
            row_load(stream_row_in(P, layer, b[u], t[u]), lane, x[u]); }
#pragma unroll
        for (int u = 0; u < 2; ++u) { const float rs = row_rs(v[u]);
#pragma unroll
            for (int i = 0; i < 8; ++i) { const int c = i * 256 + lane * 4; const f32x4 g = *(const f32x4*)(ng + 1 * DM + c), m2 = *(const f32x4*)(m[u] + 2 * DM + c);
#ifndef MK_DBG_NOUPD
                x[u][i] = x[u][i] + m2 * (v[u][i] * rs * g);
#endif
                if (ok[u]) *(f32x4*)(xo[u] + c) = x[u][i]; }
            row_norm_mod8(x[u], ng + 2 * DM, m[u] + 3 * DM, m[u] + 4 * DM, WSP(unsigned char, WS_HA8) + (size_t)(b[u] * TT + t[u]) * DM, lane, ok[u]); }
        float pa[2][16];
#pragma unroll
        for (int e = 0; e < 16; ++e) { f32x2 s0 = {0.f, 0.f}, s1 = {0.f, 0.f};
#pragma unroll
            for (int i = 0; i < 8; ++i) { const f32x4 w = *(const LAS f32x4*)(RWT + e * DM + i * 256 + lane * 4); const f32x2 wl = {w[0], w[1]}, wh = {w[2], w[3]};
                s0 += wl * (f32x2){x[0][i][0], x[0][i][1]}; s0 += wh * (f32x2){x[0][i][2], x[0][i][3]}; s1 += wl * (f32x2){x[1][i][0], x[1][i][1]}; s1 += wh * (f32x2){x[1][i][2], x[1][i][3]}; }
            pa[0][e] = s0[0] + s0[1]; pa[1][e] = s1[0] + s1[1]; asm volatile("" ::: "memory"); }
        float mine[2];
#pragma unroll
        for (int u = 0; u < 2; ++u) {
#pragma unroll
            for (int j = 0; j < 8; ++j) { const bool hi = lane & 1; const float keep = hi ? pa[u][2 * j + 1] : pa[u][2 * j], send = hi ? pa[u][2 * j] : pa[u][2 * j + 1]; pa[u][j] = keep + xor1f(send); }
#pragma unroll
            for (int j = 0; j < 4; ++j) { const bool hi = lane & 2; const float keep = hi ? pa[u][2 * j + 1] : pa[u][2 * j], send = hi ? pa[u][2 * j] : pa[u][2 * j + 1]; pa[u][j] = keep + xor2f(send); }
#pragma unroll
            for (int j = 0; j < 2; ++j) { const bool hi = lane & 4; const float keep = hi ? pa[u][2 * j + 1] : pa[u][2 * j], send = hi ? pa[u][2 * j] : pa[u][2 * j + 1]; pa[u][j] = keep + __shfl_xor(send, 4); }
            { const bool hi = lane & 8; const float keep = hi ? pa[u][1] : pa[u][0], send = hi ? pa[u][0] : pa[u][1]; float v = keep + __shfl_xor(send, 8); v += __shfl_xor(v, 16); v += __shfl_xor(v, 32); mine[u] = v; } }
#pragma unroll
        for (int u = 0; u < 2; ++u) { float mx = mine[u];
            mx = row16_max(mx);
            const float ex = __expf(mine[u] - mx); float den = ex;
            den = row16_sum(den);
            if (lane < 16 && ok[u]) { const float a = ex * rcpf_(den);
                if (t[u] < LCTX) WSP(float, WS_AFFC)[(size_t)(b[u] * 16 + lane) * LCTX + t[u]] = a; else WSP(float, WS_AFF)[(size_t)(b[u] * 16 + lane) * NLAT + (t[u] - LCTX)] = a; } }
    }
}
DI void topk_task(const Params& P, const Frame& F, const float* vals, int n, int K, int srow0  , int e, int stack0  ) {
    LAS unsigned* keys = (LAS unsigned*)F.lds;
    LAS unsigned* hist = (LAS unsigned*)(F.lds + 32768);
    LAS unsigned* wsum = (LAS unsigned*)(F.lds + 32768 + 1024);
    LAS unsigned* sel = (LAS unsigned*)(F.lds + 32768 + 1024 + 64);
    LAS int* srcl = (LAS int*)(F.lds + 36864);
    const int tid = F.tid;
    for (int i = tid; i < n; i += 512) keys[i] = __float_as_uint(vals[i]);
    if (tid == 0) { sel[0] = 0u; sel[1] = (unsigned)K; }
    unsigned mask = 0u;
#pragma unroll 1
    for (int shift = 24; shift >= 0; shift -= 8) {
        if (tid < 256) hist[tid] = 0u;
        __syncthreads();
        const unsigned prefix = sel[0];
        for (int i = tid; i < n; i += 512) { const unsigned k = keys[i]; if ((k & mask) == prefix) (void)__hip_atomic_fetch_add(&hist[(k >> shift) & 255u], 1u, __ATOMIC_RELAXED, __HIP_MEMORY_SCOPE_WORKGROUP); }
        __syncthreads();
        if (F.wave == 0) {
            const unsigned kk = sel[1]; const int l = F.lane; unsigned c[4];
#pragma unroll
            for (int j = 0; j < 4; ++j) c[j] = hist[255 - 4 * l - j];
            const unsigned mysum = (c[0] + c[1]) + (c[2] + c[3]); unsigned incl = mysum;
#pragma unroll
            for (int o = 1; o < 64; o <<= 1) { const unsigned v = __shfl_up(incl, o); if (l >= o) incl += v; }
            const unsigned long long bal = __ballot(incl >= kk); const int first = bal ? __builtin_ctzll(bal) : 63;
            if (l == first) { unsigned cum = incl - mysum; int j = 0;
#pragma unroll
                for (; j < 3; ++j) { if (cum + c[j] >= kk) break; cum += c[j]; }
                sel[0] = prefix | ((unsigned)(255 - 4 * l - j) << shift); sel[1] = kk - cum; } }
        mask |= 255u << shift;
        __syncthreads();
    }
    const unsigned thr = sel[0], need_eq = sel[1], total_gt = (unsigned)K - need_eq;
    const int per = (n + 511) / 512, i0 = tid * per;
    unsigned cnt = 0u;
    for (int j = 0; j < per; ++j) { const int i = i0 + j; if (i < n) { const unsigned k = keys[i]; cnt += (k > thr ? 1u : 0u) + (k == thr ? 65536u : 0u); } }
    unsigned inc = cnt;
#pragma unroll
    for (int o = 1; o < 64; o <<= 1) { const unsigned v = __shfl_up(inc, o); if (F.lane >= o) inc += v; }
    if (F.lane == 63) wsum[F.wave] = inc;
    __syncthreads();
    unsigned base = 0u;
    for (int w = 0; w < F.wave; ++w) base += wsum[w];
    unsigned run = base + inc - cnt;
    unsigned rgt = run & 0xffffu, req = run >> 16;
    float* gatev = WSP(float, WS_GATEV); int* idxo = WSP(int, WS_IDX); int* slot = WSP(int, WS_SLOT);
    for (int j = 0; j < per; ++j) { const int i = i0 + j; if (i < n) { const unsigned k = keys[i]; int s = -1;
        if (k > thr) { s = (int)rgt; ++rgt; } else if (k == thr) { if (req < need_eq) s = (int)(total_gt + req); ++req; }
        slot[(size_t)(srow0 + i) * 16 + e] = s;
        if (s >= 0) { gatev[stack0 + s] = __uint_as_float(k); idxo[stack0 + s] = srow0 + i; srcl[s] = srow0 + i; } } }
    __syncthreads();
    {
        unsigned* vt = WSP(unsigned, WS_VOFF); const int tile0 = stack0 >> 8, row00 = stack0 & 255, ntile = (K + 255) >> 8;
        for (int tl = 0; tl < ntile; ++tl)
#pragma unroll
            for (int hi = 0; hi < 4; ++hi) { int R, C; pg8::stage_rc(tid * 16 + (hi & 1) * 8192, R, C); const int row = tl * 256 + (hi >> 1) * 128 + R - row00;
                const bool mine = row >= 0 && row < K, dummy = (K < 256) && row00 == 0 && (row >= 64);
                if (mine || dummy) vt[((size_t)(tile0 + tl) * 512 + tid) * 4 + hi] = (unsigned)((mine ? srcl[row] : 0) * (DM / 2) + C) * 2u; }
    }
    __syncthreads();
}
DI void moe_topk(const Params& P, const Frame& F, int layer) {
    const int ntask = layer == 0 ? 64 : 32;
    for (int task = F.bid; task < ntask; task += F.G) {
        if (task < 32) { const int b = task >> 4, e = task & 15; topk_task(P, F, WSP(float, WS_AFF) + (size_t)task * NLAT, NLAT, CAPL, b * TT + LCTX, e, task * 1024); }
        else { const int t2 = task - 32, b = t2 >> 4, e = t2 & 15; topk_task(P, F, WSP(float, WS_AFFC) + (size_t)t2 * LCTX, LCTX, CAPC, b * TT, e, 32768 + e * 256 + b * 32); }
    }
}
DI void moe_gather(const Params& P, const Frame& F, int layer) {
    const int nrows = 32768 + (layer == 0 ? 1024 : 0); const int* idx = WSP(int, WS_IDX); const bf16_t* HA = WSP(bf16_t, WS_HA); bf16_t* XS = WSP(bf16_t, WS_XS);
    for (int r = F.bid * 8 + F.wave; r < nrows; r += F.G * 8) { int st = r; if (r >= 32768) { const int qq = r - 32768; st = 32768 + (qq >> 6) * 256 + (qq & 63); }
        const int srow = idx[st]; const u32x4* s = (const u32x4*)(HA + (size_t)srow * DM); u32x4* d = (u32x4*)(XS + (size_t)st * DM);
#pragma unroll
        for (int i = 0; i < 4; ++i) d[i * 64 + F.lane] = s[i * 64 + F.lane]; }
}
DI void moe_combine(const Params& P, const Frame& F, int layer) {
    const float* modv = WSP(float, WS_MODV); const float* ng = P.in[I_NORMG] + (size_t)layer * 4 * DM; const int* slot = WSP(int, WS_SLOT); const bf16_t* Y = WSP(bf16_t, WS_Y);
    const int nrows = layer == 0 ? RR : NB * NLAT, lane = F.lane, stride = F.G * 8;
    for (int rr0 = F.bid * 8 + F.wave; rr0 < nrows; rr0 += 2 * stride) {
        int b[2], t[2], r[2]; bool ok[2]; const float* m[2]; f32x4 acc[2][8], x[2][8];
#pragma unroll
        for (int u = 0; u < 2; ++u) { int rr = rr0 + u * stride; ok[u] = rr < nrows; if (!ok[u]) rr = rr0;
            if (layer == 0) { b[u] = rr / TT; t[u] = rr % TT; } else { b[u] = rr / NLAT; t[u] = LCTX + rr % NLAT; }
            r[u] = b[u] * TT + t[u]; const int mi = t[u] < LCTX ? 2 : b[u]; m[u] = modv + (size_t)(layer * 3 + mi) * 12288;
            row_load(stream_row_in(P, 1, b[u], t[u]), lane, x[u]);
#pragma unroll
            for (int i = 0; i < 8; ++i) acc[u][i] = (f32x4){0, 0, 0, 0}; }
        int sl[2][16];
#pragma unroll
        for (int u = 0; u < 2; ++u)
#pragma unroll
            for (int e = 0; e < 16; ++e) sl[u][e] = __builtin_amdgcn_readfirstlane(slot[(size_t)r[u] * 16 + e]);
#pragma unroll
        for (int e = 0; e < 16; ++e)
#pragma unroll
            for (int u = 0; u < 2; ++u) { const int s = sl[u][e];
                if (s >= 0) { const size_t yrow = t[u] >= LCTX ? (size_t)(b[u] * 16 + e) * 1024 + s : (size_t)32768 + e * 256 + b[u] * 32 + s; const bf16_t* yp = Y + yrow * DM + lane * 4;
#pragma unroll
                    for (int i = 0; i < 8; ++i) { const u32x2 w = *(const u32x2*)(yp + i * 256); acc[u][i][0] += bflo(w.x); acc[u][i][1] += bfhi(w.x); acc[u][i][2] += bflo(w.y); acc[u][i][3] += bfhi(w.y); } } }
#pragma unroll
        for (int u = 0; u < 2; ++u) { const float rs = row_rs(acc[u]); float* xo = stream_row_out(P, b[u], t[u]);
#pragma unroll
            for (int i = 0; i < 8; ++i) { const int c = i * 256 + lane * 4; const f32x4 g = *(const f32x4*)(ng + 3 * DM + c), m5 = *(const f32x4*)(m[u] + 5 * DM + c);
                x[u][i] = x[u][i] + m5 * (acc[u][i] * rs * g); if (ok[u]) *(f32x4*)(xo + c) = x[u][i]; }
            if (layer == 0) { const int mi = t[u] < LCTX ? 2 : b[u]; const float* m1 = modv + (size_t)(1 * 3 + mi) * 12288; row_norm_mod(x[u], P.in[I_NORMG] + (size_t)(1 * 4 + 0) * DM, m1, m1 + DM, WSP(bf16_t, WS_HA) + (size_t)r[u] * DM, lane, ok[u]);
                if (ok[u]) { unsigned char* d8 = WSP(unsigned char, WS_HA8B) + (size_t)r[u] * DM;
#pragma unroll
                    for (int i = 0; i < 8; ++i) *(unsigned*)(d8 + i * 256 + lane * 4) = cvt4_fp8(x[u][i][0], x[u][i][1], x[u][i][2], x[u][i][3]); } } }
    }
}
DI void cv_unpack(const u32x4& w, float (&o)[8]) { o[0] = bflo(w.x); o[1] = bfhi(w.x); o[2] = bflo(w.y); o[3] = bfhi(w.y); o[4] = bflo(w.z); o[5] = bfhi(w.z); o[6] = bflo(w.w); o[7] = bfhi(w.w); }
DI void dn_conv_walk(const Params& P, int b, int isctx, int gy, int cg, int xs, int lane) {
    const bf16_t* PQ = WSP(bf16_t, WS_PQ); bf16_t* QC = WSP(bf16_t, WS_QKVC); const float* CW = P.in[I_ODCONV];
    const int ch0 = (cg * 64 + lane) * 8, nx = isctx ? LCTX : 64;
    const size_t rowbase = (size_t)b * TT + (isctx ? 0 : LCTX + gy * 64);
    const bool up = !isctx && gy > 0, dn = !isctx && gy < 127;
    float wgt[9][8];
#pragma unroll
    for (int k = 0; k < 9; ++k) { const f32x4 w0 = *(const f32x4*)(CW + (size_t)k * DNQKV + ch0), w1 = *(const f32x4*)(CW + (size_t)k * DNQKV + ch0 + 4);
#pragma unroll
        for (int j = 0; j < 4; ++j) { wgt[k][j] = w0[j]; wgt[k][4 + j] = w1[j]; } }
#pragma unroll
    for (int kx = 0; kx < 3; ++kx)
#pragma unroll
        for (int j = 0; j < 8; ++j) { if (!up) wgt[kx][j] = 0.f; if (!dn) wgt[6 + kx][j] = 0.f; }
    const u32x4 zero = {0u, 0u, 0u, 0u};
    u32x4 raw[3][3];
    float fc[3][3][8];
#define CV_LOAD(dst, x) do { const int xc = (x) < 0 ? 0 : ((x) >= nx ? nx - 1 : (x)); const bf16_t* pp = PQ + (rowbase + xc) * DNQKV + ch0; \
        dst[0] = *(const u32x4*)(pp - (up ? (size_t)64 * DNQKV : 0)); dst[1] = *(const u32x4*)pp; dst[2] = *(const u32x4*)(pp + (dn ? (size_t)64 * DNQKV : 0)); } while (0)
#define CV_CONV(slot, x) do { cv_unpack(raw[slot][0], fc[slot][0]); cv_unpack(raw[slot][1], fc[slot][1]); cv_unpack(raw[slot][2], fc[slot][2]); \
        if (!((x) >= 0 && (x) < nx)) { _Pragma("unroll") for (int ky_ = 0; ky_ < 3; ++ky_) _Pragma("unroll") for (int e_ = 0; e_ < 8; ++e_) fc[slot][ky_][e_] = 0.f; } } while (0)
    CV_LOAD(raw[0], xs - 1); CV_LOAD(raw[1], xs); CV_LOAD(raw[2], xs + 1);
    CV_CONV(0, xs - 1); CV_CONV(1, xs); CV_CONV(2, xs + 1);
    CV_LOAD(raw[0], xs + 2); CV_LOAD(raw[1], xs + 3); CV_LOAD(raw[2], xs + 4);
#pragma unroll 1
    for (int x0 = xs; x0 < xs + 32; x0 += 3) {
#pragma unroll
        for (int j = 0; j < 3; ++j) { const int x = x0 + j;
            float acc[8];
#pragma unroll
            for (int e = 0; e < 8; e += 2) { f32x2 a2 = (f32x2){fc[j][0][e], fc[j][0][e + 1]} * (f32x2){wgt[0][e], wgt[0][e + 1]};
#pragma unroll
                for (int ky = 0; ky < 3; ++ky)
#pragma unroll
                    for (int kx = 0; kx < 3; ++kx) { if (ky == 0 && kx == 0) continue; const int sl = (j + kx) % 3;
                        a2 = __builtin_elementwise_fma((f32x2){fc[sl][ky][e], fc[sl][ky][e + 1]}, (f32x2){wgt[ky * 3 + kx][e], wgt[ky * 3 + kx][e + 1]}, a2); }
                acc[e] = a2[0]; acc[e + 1] = a2[1]; }
            CV_CONV(j, x + 2);
            CV_LOAD(raw[j], x + 5);
            float ss = 0.f;
#pragma unroll
            for (int e = 0; e < 8; ++e) { acc[e] = siluf_(acc[e]); ss += acc[e] * acc[e]; }
            if (cg < 8) { ss = row16_sum(ss); const float rs = rsqrtf(ss + EPS);
#pragma unroll
                for (int e = 0; e < 8; ++e) acc[e] *= rs; }
            if (x < xs + 32) { bf16_t* orow = QC + (rowbase + x) * DNQKV;
                if (cg < 8) {
                    const int cc = (ch0 & 31) >> 3; bf16_t* dst = orow + (ch0 & ~31) + 16 * (cc & 1) + 4 * (cc >> 1);
                    *(u32x2*)dst = (u32x2){pk2(acc[0], acc[1]), pk2(acc[2], acc[3])}; *(u32x2*)(dst + 8) = (u32x2){pk2(acc[4], acc[5]), pk2(acc[6], acc[7])}; }
                else *(u32x4*)(orow + ch0) = (u32x4){pk2(acc[0], acc[1]), pk2(acc[2], acc[3]), pk2(acc[4], acc[5]), pk2(acc[6], acc[7])}; }
        }
    }
#undef CV_CONV
#undef CV_LOAD
}
DI void dn_conv(const Params& P, const Frame& F, int rep) {
    const float* GA = WSP(float, WS_GATES); float* G2 = WSP(float, WS_G2); const int lane = F.lane;
    unsigned* ctr = WSP(unsigned, WS_CTL) + 64 + rep;
    for (;;) { unsigned t = 0; if (lane == 0) t = __hip_atomic_fetch_add(ctr, 1u, __ATOMIC_RELAXED, __HIP_MEMORY_SCOPE_AGENT); t = __builtin_amdgcn_readfirstlane(t);
        if (t >= 256u + 8192u) break;
        if (t < 256u) dn_conv_walk(P, (int)t >> 7, 1, 0, ((int)t >> 3) & 15, ((int)t & 7) * 32, lane);
        else { const int u = (int)t - 256; dn_conv_walk(P, u >> 12, 0, (u >> 5) & 127, (u >> 1) & 15, (u & 1) * 32, lane); } }
    for (int r = F.bid * 8 + F.wave; r < RR; r += F.G * 8) {
#pragma unroll
        for (int hh = 0; hh < 2; ++hh) { const int j = lane + 64 * hh; const float x = GA[(size_t)r * 128 + j]; float o;
            if (j < 64) o = sigmoidf_(x);
            else { const int dh = j - 64; const float y = x + P.in[I_ODDTB][dh]; const float sp = y > 20.f ? y : log1pf(__expf(y)); o = -__expf(P.in[I_ODALOG][dh]) * sp; }
            G2[(size_t)r * 128 + j] = o; }
    }
}
DI int dn_perm(int j) { return (j & ~31) + 8 * ((j & 15) >> 2) + 4 * ((j >> 4) & 1) + (j & 3); }
DI int dn_seq_to_chunk(int dir, int n) { return dir ? (n < 4 ? 3 - n : NCHUNK + 3 - n) : n; }
DI bf16x8 pp_pack(const f32x4& a, const f32x4& b) { return __builtin_bit_cast(bf16x8, (u32x4){pk2(a[0], a[1]), pk2(a[2], a[3]), pk2(b[0], b[1]), pk2(b[2], b[3])}); }
DI void dn_prep_variant(const Params& P, int vid, int lane) {
    const int chain = vid / NCHUNK, seq = vid % NCHUNK, dir = chain & 1, hv = (chain >> 1) & 31, b = chain >> 6, hqk = hv >> 1, c = dn_seq_to_chunk(dir, seq), l15 = lane & 15, q = lane >> 4;
    const size_t r0 = (size_t)b * TT + c * 64;
    const bf16_t* QC = WSP(bf16_t, WS_QKVC); const float* G2 = WSP(float, WS_G2);
    float gcs, bes;
    { const size_t rw = r0 + (dir ? 63 - lane : lane); const float g = G2[rw * 128 + 64 + dir * 32 + hv]; bes = G2[rw * 128 + dir * 32 + hv]; float inc = g;
#pragma unroll
      for (int o = 1; o < 64; o <<= 1) { const float v = __shfl_up(inc, o); if (lane >= o) inc += v; }
      gcs = inc; WSP(float, WS_GC)[(size_t)vid * 64 + lane] = inc; }
    float gcc[4], bec[4];
#pragma unroll
    for (int t = 0; t < 4; ++t) { gcc[t] = __shfl(gcs, 16 * t + l15); bec[t] = __shfl(bes, 16 * t + l15); }
    bf16x8 kf[4][4];
    {   bf16x8 qf[4][4];
#pragma unroll
        for (int t = 0; t < 4; ++t) { const int sr = 16 * t + l15; const unsigned ro = (((unsigned)r0 + (unsigned)(dir ? 63 - sr : sr)) * (unsigned)DNQKV + (unsigned)(hqk * 128 + 8 * q)) * 2u;
#pragma unroll
            for (int ks = 0; ks < 4; ++ks) { kf[t][ks] = *(const bf16x8*)((const char*)QC + ro + (unsigned)(DNQK + 32 * ks) * 2u); qf[t][ks] = *(const bf16x8*)((const char*)QC + ro + (unsigned)(32 * ks) * 2u); } }
        bf16_t* QM = WSP(bf16_t, WS_QKM) + (size_t)vid * 4096;
#pragma unroll
        for (int jt = 0; jt < 4; ++jt) { float gcrj[4];
#pragma unroll
            for (int r = 0; r < 4; ++r) gcrj[r] = __shfl(gcs, 16 * jt + 4 * q + r);
#pragma unroll
            for (int it = 0; it < 4; ++it) { f32x4 acc = {0, 0, 0, 0};
                if (it >= jt) {
#pragma unroll
                    for (int ks = 0; ks < 4; ++ks) acc = mfma16(kf[jt][ks], qf[it][ks], acc); }
                float o[4];
#pragma unroll
                for (int r = 0; r < 4; ++r) { const int j = 16 * jt + 4 * q + r, i = 16 * it + l15; o[r] = (j <= i) ? 0.08838834764831845f * acc[r] * __expf(fminf(gcc[it] - gcrj[r], 0.f)) : 0.f; }
                *(u32x2*)(QM + (16 * it + l15) * 64 + 32 * (jt >> 1) + 8 * q + 4 * (jt & 1)) = (u32x2){pk2(o[0], o[1]), pk2(o[2], o[3])}; } }
    }
    f32x4 X[4][4], XT[4][4]; bf16x8 Mf[4][2];
#pragma unroll
    for (int rt = 0; rt < 4; ++rt) { float gcra[4], bera[4];
#pragma unroll
        for (int r = 0; r < 4; ++r) { gcra[r] = __shfl(gcs, 16 * rt + 4 * q + r); bera[r] = __shfl(bes, 16 * rt + 4 * q + r); }
#pragma unroll
        for (int ct = 0; ct < 4; ++ct) { f32x4 kk = {0, 0, 0, 0};
#pragma unroll
            for (int ks = 0; ks < 4; ++ks) kk = mfma16(kf[rt][ks], kf[ct][ks], kk);
#pragma unroll
            for (int r = 0; r < 4; ++r) { const int a = 16 * rt + 4 * q + r, bb = 16 * ct + l15;
                X[rt][ct][r] = (bb < a) ? -(bera[r] * kk[r] * __expf(fminf(gcra[r] - gcc[ct], 0.f))) : (a == bb ? 1.f : 0.f);
                XT[rt][ct][r] = (a < bb) ? -(bec[ct] * kk[r] * __expf(fminf(gcc[ct] - gcra[r], 0.f))) : (a == bb ? 1.f : 0.f); } } }
#pragma unroll
    for (int ib = 0; ib < 4; ++ib)
#pragma unroll
        for (int ks = 0; ks < 2; ++ks) { f32x4 m0, m1;
#pragma unroll
            for (int r = 0; r < 4; ++r) { m0[r] = ((16 * (2 * ks) + 4 * q + r) == (16 * ib + l15) ? 2.f : 0.f) - XT[2 * ks][ib][r]; m1[r] = ((16 * (2 * ks + 1) + 4 * q + r) == (16 * ib + l15) ? 2.f : 0.f) - XT[2 * ks + 1][ib][r]; }
            Mf[ib][ks] = pp_pack(m0, m1); }
#pragma unroll 1
    for (int it = 0; it < 5; ++it) {
        bf16x8 Xp[4][2], Xf[4][2], Qp[4][2];
#pragma unroll
        for (int t = 0; t < 4; ++t)
#pragma unroll
            for (int ks = 0; ks < 2; ++ks) { Xp[t][ks] = pp_pack(X[2 * ks][t], X[2 * ks + 1][t]); Xf[t][ks] = pp_pack(XT[2 * ks][t], XT[2 * ks + 1][t]); }
#pragma unroll
        for (int nt = 0; nt < 4; ++nt) { f32x4 qa[4];
#pragma unroll
            for (int ib = 0; ib < 4; ++ib) { f32x4 acc = {0, 0, 0, 0}; if (nt <= ib) { if (nt <= 1) acc = mfma16(Mf[ib][0], Xp[nt][0], acc); if (ib >= 2) acc = mfma16(Mf[ib][1], Xp[nt][1], acc); }
#pragma unroll
                for (int r = 0; r < 4; ++r) qa[ib][r] = ((16 * ib + 4 * q + r) == (16 * nt + l15) ? 2.f : 0.f) - acc[r]; }
            Qp[nt][0] = pp_pack(qa[0], qa[1]); Qp[nt][1] = pp_pack(qa[2], qa[3]); }
#pragma unroll
        for (int ib = 0; ib < 4; ++ib)
#pragma unroll
            for (int nt = 0; nt < 4; ++nt) { f32x4 a1 = {0, 0, 0, 0}, a2 = {0, 0, 0, 0};
                if (nt <= ib) {
                    if (nt <= 1) { a1 = mfma16(Xf[ib][0], Qp[nt][0], a1); a2 = mfma16(Qp[nt][0], Xf[ib][0], a2); }
                    if (ib >= 2) { a1 = mfma16(Xf[ib][1], Qp[nt][1], a1); a2 = mfma16(Qp[nt][1], Xf[ib][1], a2); } }
                X[ib][nt] = a1; XT[nt][ib] = a2; }
    }
    bf16_t* TM = WSP(bf16_t, WS_TM) + (size_t)vid * 4096;
#pragma unroll
    for (int nt = 0; nt < 4; ++nt)
#pragma unroll
        for (int ib = 0; ib < 4; ++ib) *(u32x2*)(TM + (16 * ib + l15) * 64 + 32 * (nt >> 1) + 8 * q + 4 * (nt & 1)) = (u32x2){pk2(XT[nt][ib][0], XT[nt][ib][1]), pk2(XT[nt][ib][2], XT[nt][ib][3])};
}
DI void dn_prep(const Params& P, const Frame& F) { for (int vid = F.wave * F.G + F.bid; vid < NB * 32 * 2 * NCHUNK; vid += F.G * 8) dn_prep_variant(P, vid, F.lane); }


constexpr int RC_K = 0, RC_Q = 17408, RC_V = 34816, RC_T = 44032, RC_QK = 53248, RC_SC = 62464, RC_STAGE = 63488;
struct RcG { u32x4 k[4], q[4], v[2], t[2], qk[2]; float be, gc, gcl; };
DI int rc_row(int b, int dir, int n, int s) { const int c = dn_seq_to_chunk(dir, n); return b * TT + c * 64 + (dir ? 63 - s : s); }
DI void rc_load(const Params& P, RcG& g, int b, int hv, int dir, int vhalf, int chain, int n, int ht) {
    const bf16_t* QC = WSP(bf16_t, WS_QKVC); const int hqk = hv >> 1;
#pragma unroll
    for (int i = 0; i < 4; ++i) { const int idx = ht + 256 * i, s = idx >> 4, ch = (idx & 15) * 8; const size_t r = rc_row(b, dir, n, s);
        g.k[i] = *(const u32x4*)(QC + r * DNQKV + DNQK + hqk * 128 + ch); g.q[i] = *(const u32x4*)(QC + r * DNQKV + hqk * 128 + ch); }
#pragma unroll
    for (int i = 0; i < 2; ++i) { const int idx = ht + 256 * i, s = idx >> 3, ch = (idx & 7) * 8; const size_t r = rc_row(b, dir, n, s);
        g.v[i] = *(const u32x4*)(QC + r * DNQKV + 2 * DNQK + hv * 128 + vhalf * 64 + ch); }
    const bf16_t* TM = WSP(bf16_t, WS_TM) + ((size_t)chain * NCHUNK + n) * 4096; const bf16_t* QM = WSP(bf16_t, WS_QKM) + ((size_t)chain * NCHUNK + n) * 4096;
#pragma unroll
    for (int i = 0; i < 2; ++i) { const int idx = ht + 256 * i; g.t[i] = *(const u32x4*)(TM + idx * 8); g.qk[i] = *(const u32x4*)(QM + idx * 8); }
#ifdef MK_PROBE_RCBW
    { u32x4 dk[4];
#pragma unroll
      for (int i = 0; i < 4; ++i) { const int idx = ht + 256 * i, s = idx >> 4, ch = (idx & 15) * 8; const size_t r = rc_row(b, dir, n, s); dk[i] = *(const u32x4*)(QC + r * DNQKV + 2 * DNQK + ((hv + 7) & 31) * 128 + ch); }
      asm volatile("" :: "v"(dk[0]), "v"(dk[1]), "v"(dk[2]), "v"(dk[3])); }
#endif
    { const int s = ht & 63; const float* gc = WSP(float, WS_GC) + ((size_t)chain * NCHUNK + n) * 64;
      g.be = WSP(float, WS_G2)[(size_t)rc_row(b, dir, n, s) * 128 + dir * 32 + hv]; g.gc = gc[s]; g.gcl = gc[63]; }
}
DI void rc_store(const RcG& g, LAS unsigned char* st, int ht) {
    LAS bf16_t* KL = (LAS bf16_t*)(st + RC_K); LAS bf16_t* QL = (LAS bf16_t*)(st + RC_Q); LAS bf16_t* VL = (LAS bf16_t*)(st + RC_V); LAS bf16_t* TL = (LAS bf16_t*)(st + RC_T); LAS bf16_t* QKL = (LAS bf16_t*)(st + RC_QK); LAS float* SC = (LAS float*)(st + RC_SC);
#pragma unroll
    for (int i = 0; i < 4; ++i) { const int idx = ht + 256 * i, s = idx >> 4, ch = (idx & 15) * 8; *(LAS u32x4*)(KL + s * 136 + ch) = g.k[i]; *(LAS u32x4*)(QL + s * 136 + ch) = g.q[i]; }
#pragma unroll
    for (int i = 0; i < 2; ++i) { const int idx = ht + 256 * i, s = idx >> 3, ch = (idx & 7) * 8; *(LAS u32x4*)(VL + s * 72 + ch) = g.v[i]; *(LAS u32x4*)(TL + s * 72 + ch) = g.t[i]; *(LAS u32x4*)(QKL + s * 72 + ch) = g.qk[i]; }
    if (ht < 64) { SC[ht] = g.be; SC[64 + ht] = __expf(g.gc); SC[128 + ht] = __expf(g.gcl - g.gc); if (ht == 0) SC[192] = __expf(g.gcl); }
#ifdef MK_PROBE_RCST2
    asm volatile("" ::: "memory");
#pragma unroll
    for (int i = 0; i < 4; ++i) { const int idx = ht + 256 * i, s = idx >> 4, ch = (idx & 15) * 8; *(LAS u32x4*)(KL + s * 136 + ch) = g.k[i]; *(LAS u32x4*)(QL + s * 136 + ch) = g.q[i]; }
#pragma unroll
    for (int i = 0; i < 2; ++i) { const int idx = ht + 256 * i, s = idx >> 3, ch = (idx & 7) * 8; *(LAS u32x4*)(VL + s * 72 + ch) = g.v[i]; *(LAS u32x4*)(TL + s * 72 + ch) = g.t[i]; *(LAS u32x4*)(QKL + s * 72 + ch) = g.qk[i]; }
#endif
}
DI bf16x8 rc_afrag(const LAS bf16_t* base, int ld, int row0, int k0, int lane) { return *(const LAS bf16x8*)(base + (row0 + (lane & 15)) * ld + k0 + 8 * (lane >> 4)); }
DI bf16x8 rc_afrag_tr(const LAS bf16_t* base, int ld, int mt, int k0, int lane) { const int g = lane >> 4, qq = (lane & 15) >> 2, pp = lane & 3; const LAS bf16_t* p = base + (k0 + 4 * g + qq) * ld + 32 * (mt >> 1) + 8 * pp + 4 * (mt & 1);
    const s16x4 a = __builtin_amdgcn_ds_read_tr16_b64_v4i16((LAS s16x4*)p), b = __builtin_amdgcn_ds_read_tr16_b64_v4i16((LAS s16x4*)(p + 16 * ld));
#ifdef MK_PROBE_TR2
    { const s16x4 a2 = __builtin_amdgcn_ds_read_tr16_b64_v4i16((LAS s16x4*)(p + 8)), b2 = __builtin_amdgcn_ds_read_tr16_b64_v4i16((LAS s16x4*)(p + 16 * ld + 8));
      asm volatile("" :: "v"(a2), "v"(b2)); }
#endif
    return (bf16x8){a[0], a[1], a[2], a[3], b[0], b[1], b[2], b[3]}; }
DI bf16x8 rc_pack(const f32x4& a, const f32x4& b) { return __builtin_bit_cast(bf16x8, (u32x4){pk2(a[0], a[1]), pk2(a[2], a[3]), pk2(b[0], b[1]), pk2(b[2], b[3])}); }
#define RC_BAR() asm volatile("s_waitcnt lgkmcnt(0)\n\ts_barrier" ::: "memory")
DI void dn_recur_unit(const Params& P, const Frame& F, int unit) {
    const int vhalf = unit & 1, chain = unit >> 1, dir = chain & 1, hv = (chain >> 1) & 31, b = chain >> 6, lane = F.lane, l15 = lane & 15, q = lane >> 4, w = F.wave;
    LAS unsigned char* lds = F.lds;
    __syncthreads();
    if (w >= 4) {
        const int ht = F.tid - 256; RcG g0, g1;
        rc_load(P, g0, b, hv, dir, vhalf, chain, 0, ht); rc_store(g0, lds, ht);
        rc_load(P, g0, b, hv, dir, vhalf, chain, 1, ht); rc_load(P, g1, b, hv, dir, vhalf, chain, 2, ht);
        RC_BAR();
#pragma unroll 1
        for (int n = 0; n < NCHUNK; n += 2) {
            rc_store(g0, lds + RC_STAGE, ht);
            rc_load(P, g0, b, hv, dir, vhalf, chain, n + 3 < NCHUNK ? n + 3 : NCHUNK - 1, ht);
            RC_BAR();
            rc_store(g1, lds, ht);
            rc_load(P, g1, b, hv, dir, vhalf, chain, n + 4 < NCHUNK ? n + 4 : NCHUNK - 1, ht);
            RC_BAR();
        }
    } else {
        __builtin_amdgcn_s_setprio(3);
        f32x4 S[8];
#pragma unroll
        for (int i = 0; i < 8; ++i) S[i] = (f32x4){0, 0, 0, 0};
        char* ODu = (char*)(WSP(bf16_t, WS_ODIR) + (size_t)dir * RR * DNV + hv * 128 + vhalf * 64 + 16 * w);
        RC_BAR();
#pragma unroll 1
        for (int n = 0; n < NCHUNK; ++n) {
            int lane = F.lane; asm volatile("" : "+v"(lane)); const int l15 = lane & 15, q = lane >> 4;
            const LAS unsigned char* st = lds + (n & 1) * RC_STAGE;
            const LAS bf16_t* KL = (const LAS bf16_t*)(st + RC_K); const LAS bf16_t* QL = (const LAS bf16_t*)(st + RC_Q); const LAS bf16_t* VL = (const LAS bf16_t*)(st + RC_V);
            const LAS bf16_t* TL = (const LAS bf16_t*)(st + RC_T); const LAS bf16_t* QKL = (const LAS bf16_t*)(st + RC_QK); const LAS float* SC = (const LAS float*)(st + RC_SC);
            f32x4 ks_[4], qs_[4];
#define RC_SCHED() __builtin_amdgcn_sched_barrier(0)
            bf16x8 fa[8], fb[8];
#pragma unroll
            for (int m = 0; m < 4; ++m) { fa[m] = rc_afrag(KL, 136, 16 * m, 0, lane); fa[4 + m] = rc_afrag(QL, 136, 16 * m, 0, lane); }
            RC_SCHED();
#pragma unroll
            for (int kk = 0; kk < 4; ++kk) {
                if (kk < 3) {
#pragma unroll
                    for (int m = 0; m < 4; ++m) { fb[m] = rc_afrag(KL, 136, 16 * m, 32 * (kk + 1), lane); fb[4 + m] = rc_afrag(QL, 136, 16 * m, 32 * (kk + 1), lane); } }
                else {
#pragma unroll
                    for (int m = 0; m < 4; ++m) { fb[m] = rc_afrag(TL, 72, 16 * m, 0, lane); if (m >= 2) fb[4 + m] = rc_afrag(TL, 72, 16 * m, 32, lane); } }
                const bf16x8 sb = rc_pack(S[2 * kk], S[2 * kk + 1]);
                RC_SCHED();
#pragma unroll
                for (int m = 0; m < 4; ++m) { ks_[m] = mfma16(fa[m], sb, kk == 0 ? (f32x4){0, 0, 0, 0} : ks_[m]); qs_[m] = mfma16(sb, fa[4 + m], kk == 0 ? (f32x4){0, 0, 0, 0} : qs_[m]); }
                RC_SCHED();
#pragma unroll
                for (int m = 0; m < 8; ++m) fa[m] = fb[m];
            }
            f32x4 rr_[4];
            {   const int gq = lane >> 4, qq = (lane & 15) >> 2, pp = lane & 3;
#pragma unroll
                for (int m = 0; m < 4; ++m) { fb[m] = rc_afrag(QKL, 72, 16 * m, 0, lane); if (m >= 2) fb[4 + m] = rc_afrag(QKL, 72, 16 * m, 32, lane); }
#pragma unroll
                for (int m = 0; m < 4; ++m) { const s16x4 vv = __builtin_amdgcn_ds_read_tr16_b64_v4i16((LAS s16x4*)(VL + (16 * m + 4 * gq + qq) * 72 + 16 * w + 4 * pp));
                    const f32x4 be = *(const LAS f32x4*)(SC + 16 * m + 4 * q), eg = *(const LAS f32x4*)(SC + 64 + 16 * m + 4 * q);
#pragma unroll
                    for (int e = 0; e < 4; ++e) rr_[m][e] = be[e] * (bf2f((unsigned short)vv[e]) - eg[e] * ks_[m][e]);
                    qs_[m] = qs_[m] * (SC[64 + 16 * m + l15] * 0.08838834764831845f); }
            }
            f32x4 vn[4];
            { const bf16x8 rb0 = rc_pack(rr_[0], rr_[1]), rb1 = rc_pack(rr_[2], rr_[3]);
              RC_SCHED();
#pragma unroll
              for (int m = 0; m < 4; ++m) { vn[m] = mfma16(fa[m], rb0, (f32x4){0, 0, 0, 0}); if (m >= 2) vn[m] = mfma16(fa[4 + m], rb1, vn[m]); }
              RC_SCHED(); }
#pragma unroll
            for (int mt = 0; mt < 4; ++mt) { fa[mt] = rc_afrag_tr(KL, 136, mt, 0, lane); fa[4 + mt] = rc_afrag_tr(KL, 136, mt, 32, lane); }
            { const bf16x8 vb0 = rc_pack(vn[0], vn[1]), vb1 = rc_pack(vn[2], vn[3]);
              RC_SCHED();
#pragma unroll
              for (int m = 0; m < 4; ++m) { qs_[m] = mfma16(vb0, fb[m], qs_[m]); if (m >= 2) qs_[m] = mfma16(vb1, fb[4 + m], qs_[m]); }
              RC_SCHED(); }
#pragma unroll
            for (int mt = 0; mt < 4; ++mt) { fb[mt] = rc_afrag_tr(KL, 136, 4 + mt, 0, lane); fb[4 + mt] = rc_afrag_tr(KL, 136, 4 + mt, 32, lane); }
#pragma unroll
            for (int m = 0; m < 4; ++m) vn[m] = vn[m] * *(const LAS f32x4*)(SC + 128 + 16 * m + 4 * q);
            const float gl = SC[192];
            const bf16x8 nb0 = rc_pack(vn[0], vn[1]), nb1 = rc_pack(vn[2], vn[3]);
#pragma unroll
            for (int mt = 0; mt < 8; ++mt) S[mt] = S[mt] * gl;
            RC_SCHED();
#pragma unroll
            for (int mt = 0; mt < 4; ++mt) { S[mt] = mfma16(fa[mt], nb0, S[mt]); S[mt] = mfma16(fa[4 + mt], nb1, S[mt]); }
            RC_SCHED();
            { const int cch = dn_seq_to_chunk(dir, n); char* obase = ODu + ((size_t)b * TT + cch * 64) * (DNV * 2);
#pragma unroll
              for (int m = 0; m < 4; ++m) { const int s = 16 * m + l15; *(u32x2*)(obase + (unsigned)((dir ? 63 - s : s) * (DNV * 2) + q * 8)) = (u32x2){pk2(qs_[m][0], qs_[m][1]), pk2(qs_[m][2], qs_[m][3])}; } }
            RC_SCHED();
#pragma unroll
            for (int mt = 0; mt < 4; ++mt) { S[4 + mt] = mfma16(fb[mt], nb0, S[4 + mt]); S[4 + mt] = mfma16(fb[4 + mt], nb1, S[4 + mt]); }
            RC_BAR();
        }
        __builtin_amdgcn_s_setprio(0);
    }
}
DI void dn_recur(const Params& P, const Frame& F) {
    for (int i = F.bid; i < 256; i += F.G) { int u = i;
        if (F.G == 256) { const int x = i & 7, j = i >> 3, grp = (j >> 2) * 8 + x, mem = j & 3, dir = grp & 1, bq = grp >> 1;
            const int hv = 2 * (bq & 15) + (mem >> 1), b = bq >> 4; u = (((b * 32 + hv) * 2 + dir) << 1) | (mem & 1); }
        dn_recur_unit(P, F, u); }
}
DI void dn_post(const Params& P, const Frame& F) {
    const bf16_t* OD = WSP(bf16_t, WS_ODIR); const bf16_t* PZ = WSP(bf16_t, WS_PZ); unsigned char* OC = WSP(unsigned char, WS_OCAT1); const int lane = F.lane;
    const int w0 = F.bid * 8 + F.wave, stride = F.G * 8, ntrip = w0 < NB * NLAT ? ((NB * NLAT - 1 - w0) / stride + 1) * 8 : 0;
    const f32x4 g0 = *(const f32x4*)(P.in[I_ODNG] + ((lane * 8) & 127)), g1 = *(const f32x4*)(P.in[I_ODNG] + ((lane * 8) & 127) + 4);
    u32x4 xa0, xc0, xz0, xa1, xc1, xz1, xa2, xc2, xz2;
#define DP_LOAD(t_, A_, C_, Z_) do { const int rr_ = w0 + ((t_) >> 3) * stride, b_ = rr_ / NLAT, tok_ = rr_ % NLAT; const size_t e_ = ((size_t)b_ * TT + LCTX + tok_) * DNV + (((t_) & 7) * 64 + lane) * 8; \
        A_ = *(const u32x4*)(OD + e_); C_ = *(const u32x4*)(OD + (size_t)RR * DNV + e_); Z_ = *(const u32x4*)(PZ + e_); } while (0)
    if (ntrip > 0) {
        int i0 = 0, i1 = 1 < ntrip ? 1 : ntrip - 1, i2 = 0;
        DP_LOAD(i0, xa0, xc0, xz0); DP_LOAD(i1, xa1, xc1, xz1);
#define DP_STEP(I_, A_, C_, Z_, NI_, NA_, NC_, NZ_, nidx_) do { NI_ = (nidx_) < ntrip ? (nidx_) : ntrip - 1; __builtin_amdgcn_sched_barrier(0); DP_LOAD(NI_, NA_, NC_, NZ_); __builtin_amdgcn_sched_barrier(0); \
        float a[8], c2[8], z[8]; cv8(A_, a); cv8(C_, c2); cv8(Z_, z); float ss = 0.f; \
        _Pragma("unroll") for (int j = 0; j < 8; ++j) { a[j] += c2[j]; ss += a[j] * a[j]; } \
        ss = row16_sum(ss); const float rs = rsqrtf(ss * (1.0f / 128.0f) + EPS); \
        _Pragma("unroll") for (int j = 0; j < 8; ++j) a[j] = a[j] * rs * (j < 4 ? g0[j & 3] : g1[j & 3]) * siluf_(z[j]); \
        const int rr = w0 + ((I_) >> 3) * stride; \
        *(u32x2*)(OC + (size_t)rr * DNV + (((I_) & 7) * 64 + lane) * 8) = (u32x2){cvt4_fp8(a[0], a[1], a[2], a[3]), cvt4_fp8(a[4], a[5], a[6], a[7])}; } while (0)
#pragma unroll 1
        for (int t = 0; t < ntrip; t += 3) {
            DP_STEP(i0, xa0, xc0, xz0, i2, xa2, xc2, xz2, t + 2);
            DP_STEP(i1, xa1, xc1, xz1, i0, xa0, xc0, xz0, t + 3);
            DP_STEP(i2, xa2, xc2, xz2, i1, xa1, xc1, xz1, t + 4);
        }
#undef DP_STEP
    }
#undef DP_LOAD
    l1w_from_queue(P, F, -1);
}
#ifndef MK_FUSED
#define MK_FUSED 1
#endif
#ifndef MK_LAST_PHASE
#define MK_LAST_PHASE 22
#endif
enum { PH_PRO = 0, PH_H0, PH_EVIN, PH_E2A, PH_E2B, PH_E2C, PH_EVOUT, PH_ROW0, PH_TOPK0, PH_GU0, PH_DN0, PH_COMB0, PH_ODIN, PH_CONV, PH_PREP, PH_REC, PH_POST, PH_ODOUT, PH_ROW1, PH_TOPK1, PH_GU1, PH_DN1, PH_COMB1, NPH_ALL };
constexpr int NPH = MK_LAST_PHASE + 1;

__global__ void __launch_bounds__(512, 2) fwd_kernel(Params P) {
    extern __shared__ __attribute__((aligned(16))) unsigned char shm[];
    Frame F; F.lds = (LAS unsigned char*)shm; F.tid = threadIdx.x; F.lane = F.tid & 63; F.wave = __builtin_amdgcn_readfirstlane(F.tid >> 6); F.G = gridDim.x; F.bid = blockIdx.x;
    volatile LAS unsigned* xbw = (volatile LAS unsigned*)(F.lds + LDS_MISC);
    if (F.tid < 4) xbw[F.tid] = 0u;
    __syncthreads();
    XcdBarrier bar; bar.bar = WSP(unsigned, WS_CTL) + 1024; bar.x = 0; bar.st = xbw;
    if (MK_FUSED) bar = xcd_barrier_post(WSP(unsigned, WS_CTL) + 1024, xbw);
    const int lo = P.ph_lo, hi = P.ph_hi;
#ifndef MK_ONLY
#define MK_ONLY -1
#endif
#define IN(k) ((MK_ONLY < 0 || (k) == MK_ONLY) && lo <= (k) && (k) < hi)
#ifndef MK_REPMASK
#define MK_REPMASK 0u
#endif
#ifndef MK_REPN
#define MK_REPN 2
#endif
#define NREP(k) (((MK_REPMASK >> (k)) & 1u) ? 1 + MK_REPN : 1)
#define SEAM(k) do { if (MK_FUSED && (IN((k) + 1) || rep + 1 < NREP(k))) xcd_barrier(bar); } while (0)
    if (IN(PH_PRO)) _Pragma("unroll") for (int rep = 0; rep < NREP(PH_PRO); ++rep) { p0_prologue(P, F, rep); SEAM(PH_PRO); }
    if (IN(PH_H0)) _Pragma("unroll") for (int rep = 0; rep < NREP(PH_H0); ++rep) { p1_hall0(P, F); SEAM(PH_H0); }
    if (IN(PH_EVIN)) _Pragma("unroll") for (int rep = 0; rep < NREP(PH_EVIN); ++rep) { pg8::Gemm g{WSP(bf16_t, WS_HA), WSP(bf16_t, WS_WEVIN), RR, EVIN, DM}; pg8::StaticOrder S; S.init(RR, EVIN, F.G, F.bid);
        pg8::EpiBf E{WSP(bf16_t, WS_P0), EVIN, 1.0f}; pg8::gemm_phase<pg8::EpiBf, pg8::StaticOrder>(F.lds, g, S, E); if ((int)F.bid >= (RR / 256 * (EVIN / 256)) % F.G) l1w_from_queue(P, F, 14); SEAM(PH_EVIN); }
    if (IN(PH_E2A)) _Pragma("unroll") for (int rep = 0; rep < NREP(PH_E2A); ++rep) { e2a(P, F, rep); SEAM(PH_E2A); }
    if (IN(PH_E2B)) _Pragma("unroll") for (int rep = 0; rep < NREP(PH_E2B); ++rep) { e2b(P, F); SEAM(PH_E2B); }
    if (IN(PH_E2C)) _Pragma("unroll") for (int rep = 0; rep < NREP(PH_E2C); ++rep) { e2c(P, F, rep); SEAM(PH_E2C); }
    if (IN(PH_EVOUT)) _Pragma("unroll") for (int rep = 0; rep < NREP(PH_EVOUT); ++rep) { pg8::Gemm g{WSP(bf16_t, WS_OCAT0), WSP(bf16_t, WS_WEVOUT), RR, DM, DM / 2}; pg8::StaticOrder S; S.init(RR, DM, F.G, F.bid);
        pg8::EpiBf E{WSP(bf16_t, WS_MIX), DM, 1.0f / W8_GU}; pg8::gemm_phase<pg8::EpiBf, pg8::StaticOrder, false, true>(F.lds, g, S, E); if ((int)F.bid >= (RR / 256 * (DM / 256)) % F.G) l1w_from_queue(P, F, 14); SEAM(PH_EVOUT); }
    if (IN(PH_ROW0)) _Pragma("unroll") for (int rep = 0; rep < NREP(PH_ROW0); ++rep) { row_post_mixer(P, F, 0); SEAM(PH_ROW0); }
    if (IN(PH_TOPK0)) _Pragma("unroll") for (int rep = 0; rep < NREP(PH_TOPK0); ++rep) { moe_topk(P, F, 0); SEAM(PH_TOPK0); }
    if (IN(PH_GU0)) _Pragma("unroll") for (int rep = 0; rep < NREP(PH_GU0); ++rep) { pg8::Gemm g{WSP(bf16_t, WS_HA8), WSP(bf16_t, WS_WGU), MOE_ROWS, 0, DM / 2}; pg8::MoeOrder S{F.G, F.bid, 128, WSP(unsigned, WS_VOFF)};
        pg8::EpiSwiGlu E{WSP(unsigned char, WS_HID), 1.0f / W8_GU}; pg8::gemm_phase<pg8::EpiSwiGlu, pg8::MoeOrder, true, true>(F.lds, g, S, E); if ((int)F.bid >= (1024 + 128) % F.G) l1w_from_queue(P, F, 7); SEAM(PH_GU0); }
    if (IN(PH_DN0)) _Pragma("unroll") for (int rep = 0; rep < NREP(PH_DN0); ++rep) { pg8::Gemm g{WSP(bf16_t, WS_HID), WSP(bf16_t, WS_WDN), MOE_ROWS, 0, EFF / 2}; pg8::MoeOrder S{F.G, F.bid, 128, nullptr};
        pg8::EpiDown E{WSP(bf16_t, WS_Y), WSP(float, WS_GATEV), 1.0f / W8_DN}; pg8::gemm_phase<pg8::EpiDown, pg8::MoeOrder, false, true>(F.lds, g, S, E); if ((int)F.bid >= (1024 + 128) % F.G) l1w_from_queue(P, F, 3); SEAM(PH_DN0); }
    if (IN(PH_COMB0)) _Pragma("unroll") for (int rep = 0; rep < NREP(PH_COMB0); ++rep) { moe_combine(P, F, 0); SEAM(PH_COMB0); }
    if (IN(PH_ODIN)) _Pragma("unroll") for (int rep = 0; rep < NREP(PH_ODIN); ++rep) {
        { pg8::Gemm g{WSP(bf16_t, WS_HA), WSP(bf16_t, WS_WODIN), RR, ODA_N, DM}; pg8::StaticOrder S; S.init(RR, ODA_N, F.G, F.bid);
          pg8::EpiOdA E{WSP(bf16_t, WS_PQ), WSP(float, WS_GATES)}; pg8::gemm_phase<pg8::EpiOdA, pg8::StaticOrder>(F.lds, g, S, E); }
        { pg8::Gemm g{WSP(bf16_t, WS_HA8B), WSP(bf16_t, WS_WODIN8), RR, ODB_N, DM / 2}; pg8::HeldOrder S; S.init(RR, ODB_N, F.G, F.G - 1 - F.bid);
          const int nbf = RR / 256 * (ODA_N / 256); S.nheld = (OD8_MODE == 3 && nbf < F.G) ? nbf : 0; S.r0 = S.nheld ? 11 : (1 << 20);
          pg8::EpiOdB E{WSP(bf16_t, WS_PQ), WSP(bf16_t, WS_PZ), 1.0f / W8_GU}; pg8::gemm_phase<pg8::EpiOdB, pg8::HeldOrder, false, true>(F.lds, g, S, E); }
        if (OD8_MODE == 3 ? ((int)F.bid >= 66 && (int)F.bid < 94) : (int)(F.G - 1 - F.bid) >= (RR / 256 * (ODB_N / 256)) % F.G) l1w_from_queue(P, F, 14); SEAM(PH_ODIN); }
    if (IN(PH_CONV)) _Pragma("unroll") for (int rep = 0; rep < NREP(PH_CONV); ++rep) { dn_conv(P, F, rep); SEAM(PH_CONV); }
    if (IN(PH_PREP)) _Pragma("unroll") for (int rep = 0; rep < NREP(PH_PREP); ++rep) { dn_prep(P, F); SEAM(PH_PREP); }
    if (IN(PH_REC)) _Pragma("unroll") for (int rep = 0; rep < NREP(PH_REC); ++rep) { dn_recur(P, F); SEAM(PH_REC); }
    if (IN(PH_POST)) _Pragma("unroll") for (int rep = 0; rep < NREP(PH_POST); ++rep) { dn_post(P, F); SEAM(PH_POST); }
    if (IN(PH_ODOUT)) _Pragma("unroll") for (int rep = 0; rep < NREP(PH_ODOUT); ++rep) { pg8::Gemm g{WSP(bf16_t, WS_OCAT1), WSP(bf16_t, WS_WODOUT), NB * NLAT, DM, DNV / 2}; pg8::StaticOrder S; S.init(NB * NLAT, DM, F.G, F.bid);
        pg8::EpiBf E{WSP(bf16_t, WS_MIX1), DM, 1.0f / W8_GU}; pg8::gemm_phase<pg8::EpiBf, pg8::StaticOrder, false, true>(F.lds, g, S, E); SEAM(PH_ODOUT); }
    if (IN(PH_ROW1)) _Pragma("unroll") for (int rep = 0; rep < NREP(PH_ROW1); ++rep) { row_post_mixer(P, F, 1); SEAM(PH_ROW1); }
    if (IN(PH_TOPK1)) _Pragma("unroll") for (int rep = 0; rep < NREP(PH_TOPK1); ++rep) { moe_topk(P, F, 1); SEAM(PH_TOPK1); }
    if (IN(PH_GU1)) _Pragma("unroll") for (int rep = 0; rep < NREP(PH_GU1); ++rep) { pg8::Gemm g{WSP(bf16_t, WS_HA8), WSP(bf16_t, WS_WGU1), MOE_ROWS, 0, DM / 2}; pg8::MoeOrder S{F.G, F.bid, 0, WSP(unsigned, WS_VOFF)};
        pg8::EpiSwiGlu E{WSP(unsigned char, WS_HID), 1.0f / W8_GU}; pg8::gemm_phase<pg8::EpiSwiGlu, pg8::MoeOrder, true, true>(F.lds, g, S, E); SEAM(PH_GU1); }
    if (IN(PH_DN1)) _Pragma("unroll") for (int rep = 0; rep < NREP(PH_DN1); ++rep) { pg8::Gemm g{WSP(bf16_t, WS_HID), WSP(bf16_t, WS_WDN1), MOE_ROWS, 0, EFF / 2}; pg8::MoeOrder S{F.G, F.bid, 0, nullptr};
        pg8::EpiDown E{WSP(bf16_t, WS_Y), WSP(float, WS_GATEV), 1.0f / W8_DN}; pg8::gemm_phase<pg8::EpiDown, pg8::MoeOrder, false, true>(F.lds, g, S, E); SEAM(PH_DN1); }
    if (IN(PH_COMB1)) _Pragma("unroll") for (int rep = 0; rep < NREP(PH_COMB1); ++rep) { moe_combine(P, F, 1); SEAM(PH_COMB1); }
#undef IN
#undef SEAM
}

extern "C" void kernel_launch(void* const* d_in, const int* in_sizes, int n_in, void* d_out, int out_size, void* d_ws, size_t ws_size, hipStream_t stream) {
    static int grid = 0;
    if (grid == 0) {
        if (n_in != 31 || out_size != NB * NLAT * DM || ws_size < WS_END) { fprintf(stderr, "kernel_launch: unexpected shapes (n_in %d, out %d, ws %zu < %zu); nothing launched\n", n_in, out_size, ws_size, (size_t)WS_END); grid = -1; return; }
        int dev = 0, cus = 0, per_cu = 0;
        if (hipGetDevice(&dev) != hipSuccess || hipDeviceGetAttribute(&cus, hipDeviceAttributeMultiprocessorCount, dev) != hipSuccess) { grid = -1; return; }
        if (hipFuncSetAttribute((const void*)fwd_kernel, hipFuncAttributeMaxDynamicSharedMemorySize, LDS_BYTES) != hipSuccess) { fprintf(stderr, "kernel_launch: hipFuncSetAttribute failed\n"); grid = -1; return; }
        if (hipOccupancyMaxActiveBlocksPerMultiprocessor(&per_cu, (const void*)fwd_kernel, 512, LDS_BYTES) != hipSuccess || per_cu < 1) { fprintf(stderr, "kernel_launch: occupancy query reports %d\n", per_cu); (void)hipGetLastError(); grid = -1; return; }
        grid = cus;
    }
    if (grid < 0) return;
    if (hipMemsetAsync((char*)d_ws + WS_CTL, 0, CTL_ZERO_BYTES, stream) != hipSuccess) return;
    Params p{};
    for (int i = 0; i < 31; ++i) p.in[i] = (const float*)d_in[i];
    p.out = (float*)d_out; p.ws = (unsigned char*)d_ws;
#if MK_FUSED
    p.ph_lo = 0; p.ph_hi = NPH;
    hipLaunchKernelGGL(fwd_kernel, dim3(grid), dim3(512), LDS_BYTES, stream, p);
#else
    for (int k = 0; k < NPH; ++k) { p.ph_lo = k; p.ph_hi = k + 1; hipLaunchKernelGGL(fwd_kernel, dim3(grid), dim3(512), LDS_BYTES, stream, p); }
#endif
}
```

```cpp
#include <hip/hip_runtime.h>
#include <cstdio>
#include <cstdint>
#define DI __device__ __forceinline__
#define LAS __attribute__((address_space(3)))
typedef unsigned short bf16_t;
typedef short bf16x8 __attribute__((ext_vector_type(8)));
typedef float f32x4 __attribute__((ext_vector_type(4)));
typedef float f32x2 __attribute__((ext_vector_type(2)));
typedef unsigned u32x4 __attribute__((ext_vector_type(4)));
typedef unsigned u32x2 __attribute__((ext_vector_type(2)));
typedef __bf16 bfx2 __attribute__((ext_vector_type(2)));
typedef short s16x4 __attribute__((ext_vector_type(4)));

DI unsigned pk2(float lo, float hi) { f32x2 v = {lo, hi}; bfx2 b = __builtin_convertvector(v, bfx2); return __builtin_bit_cast(unsigned, b); }
DI bf16_t f2bf(float f) { return (bf16_t)(pk2(f, 0.f) & 0xffffu); }
DI unsigned cvt4_fp8(float a, float b, float c, float d) { int w = 0; w = __builtin_amdgcn_cvt_pk_fp8_f32(a, b, w, false); w = __builtin_amdgcn_cvt_pk_fp8_f32(c, d, w, true); return (unsigned)w; }
DI float bf2f(unsigned h) { return __uint_as_float(h << 16); }
DI float bflo(unsigned w) { return __uint_as_float(w << 16); }
DI float bfhi(unsigned w) { return __uint_as_float(w & 0xffff0000u); }
DI float rcpf_(float x) { return __builtin_amdgcn_rcpf(x); }
DI float sigmoidf_(float x) { return rcpf_(1.0f + __expf(-x)); }
DI float siluf_(float x) { return x * rcpf_(1.0f + __expf(-x)); }
template <int CTRL> DI float dppf(float x) { return __builtin_bit_cast(float, __builtin_amdgcn_mov_dpp(__builtin_bit_cast(int, x), CTRL, 0xf, 0xf, true)); }
DI float xor1f(float x) { return dppf<0xB1>(x); }
DI float xor2f(float x) { return dppf<0x4E>(x); }
DI float row8_sum(float x) { x += dppf<0xB1>(x); x += dppf<0x4E>(x); x += dppf<0x141>(x); return x; }
DI float row16_sum(float x) { x = row8_sum(x); x += dppf<0x128>(x); return x; }
DI float row16_max(float x) { x = fmaxf(x, dppf<0xB1>(x)); x = fmaxf(x, dppf<0x4E>(x)); x = fmaxf(x, dppf<0x141>(x)); x = fmaxf(x, dppf<0x128>(x)); return x; }
DI float wave_sum(float v) {
    v = row16_sum(v);
    const auto s = __builtin_amdgcn_permlane16_swap(__builtin_bit_cast(unsigned, v), __builtin_bit_cast(unsigned, v), false, false);
    v = __builtin_bit_cast(float, (unsigned)s[0]) + __builtin_bit_cast(float, (unsigned)s[1]);
    const auto t = __builtin_amdgcn_permlane32_swap(__builtin_bit_cast(unsigned, v), __builtin_bit_cast(unsigned, v), false, false);
    return __builtin_bit_cast(float, (unsigned)t[0]) + __builtin_bit_cast(float, (unsigned)t[1]);
}
DI f32x4 mfma16(bf16x8 a, bf16x8 b, f32x4 c) { return __builtin_amdgcn_mfma_f32_16x16x32_bf16(a, b, c, 0, 0, 0); }
DI bf16x8 lds_frag(const LAS bf16_t* base, int ld, int row0, int k0, int lane) { return *(const LAS bf16x8*)(base + (row0 + (lane & 15)) * ld + k0 + 8 * (lane >> 4)); }

constexpr int NB = 2, NLAT = 8192, LCTX = 256, TT = NLAT + LCTX, RR = NB * TT, DM = 2048;
constexpr int NMOD = 6;
constexpr int HGW = 1024, HGH = 8, EVIN = 6144;
constexpr int S5G = 64, S5P = 64, S5C = 16, S5CS = 16, S5NCH = TT / S5CS  , S5NCTX = LCTX / S5CS  ;
constexpr int DNQK = 2048, DNV = 4096, DNQKV = 8192, ODIN = 12416, ODIN_PAD = 12544, DNHV = 32;
constexpr int NEXP = 16, EFF = 1024, CAPL = 1024, CAPC = 32;
constexpr int NCHUNK = TT / 64;
constexpr float EPS = 1e-6f;
constexpr float W8_GU = 64.0f, W8_DN = 32.0f;

constexpr size_t MiB = 1u << 20;
constexpr size_t WS_CTL = 0, CTL_ZERO_BYTES = 1 * MiB;
constexpr size_t WS_MODV = 1 * MiB;
constexpr size_t WS_LB = 2 * MiB;
constexpr size_t WS_S5A16 = 2 * MiB + 65536;
constexpr size_t WS_CTXW = 8 * MiB;
constexpr size_t WS_S5WY = 12 * MiB;
constexpr size_t WS_S5WX = 28 * MiB;
constexpr int OD8_MODE = 3;
constexpr int ODA_N = OD8_MODE == 1 ? 4352 : (OD8_MODE == 2 ? 2304 : 256), ODB_N = OD8_MODE == 1 ? 8192 : (OD8_MODE == 2 ? 10240 : 12288);
constexpr size_t WS_WODIN = 36 * MiB;
constexpr size_t WS_WODIN8 = 56 * MiB;
constexpr size_t WS_WODOUT = 85 * MiB;
constexpr size_t WS_HA = 101 * MiB;
constexpr size_t WS_AFF = 167 * MiB;
constexpr size_t WS_AFFC = 168 * MiB;
constexpr size_t WS_GATEV = 168 * MiB + 65536;
constexpr size_t WS_IDX = 168 * MiB + 524288;
constexpr size_t WS_SLOT = 169 * MiB;
constexpr size_t WS_VOFF = 171 * MiB;
constexpr size_t WS_W0 = 176 * MiB;
constexpr size_t WS_WEVIN = WS_W0;
constexpr size_t WS_WEVOUT = WS_W0 + 24 * MiB;
constexpr size_t WS_WGU = WS_W0 + 32 * MiB;
constexpr size_t WS_WDN = WS_W0 + 160 * MiB;
constexpr size_t WS_WGU1 = 1123 * MiB;
constexpr size_t WS_WDN1 = 1187 * MiB;
constexpr size_t WS_ACT = 400 * MiB;
constexpr size_t WS_P0 = WS_ACT;
constexpr size_t WS_MIX = WS_ACT;
constexpr size_t WS_OCAT0 = 598 * MiB;
constexpr size_t WS_KVT = 664 * MiB;
constexpr size_t WS_SST = 796 * MiB;
constexpr size_t WS_DEC = 928 * MiB;
constexpr size_t WS_REFX = 1030 * MiB;
constexpr size_t WS_XL = 931 * MiB;
constexpr size_t WS_X0 = 997 * MiB;
constexpr size_t WS_XS = WS_ACT;
constexpr size_t WS_HA8 = 508 * MiB;
constexpr size_t WS_HID = 544 * MiB;
constexpr size_t WS_Y = 616 * MiB;
constexpr size_t WS_TM = 176 * MiB;
constexpr size_t WS_HA8B = WS_TM;
constexpr size_t WS_QKM = 308 * MiB;
constexpr size_t WS_PQ = 440 * MiB;
constexpr size_t WS_ODIR = WS_PQ;
constexpr size_t WS_MIX1 = WS_PQ;
constexpr size_t WS_PZ = 704 * MiB;
constexpr size_t WS_GATES = 836 * MiB;
constexpr size_t WS_G2 = 845 * MiB;
constexpr size_t WS_GC = 854 * MiB;
constexpr size_t WS_QKVC = 859 * MiB;
constexpr size_t WS_OCAT1 = WS_QKVC;
constexpr size_t WS_END = 1219 * MiB;
constexpr int MOE_ROWS = 32 * 1024 + 16 * 256;
constexpr int LDS_BYTES = 147456;
constexpr int LDS_MISC = LDS_BYTES - 16;
namespace pg8 {
#define PG8_LAS __attribute__((address_space(3)))
typedef unsigned short bf16_t;
typedef short bf16x8 __attribute__((ext_vector_type(8)));
typedef float f32x4 __attribute__((ext_vector_type(4)));
typedef unsigned u32x4 __attribute__((ext_vector_type(4)));
typedef int i32x8 __attribute__((ext_vector_type(8)));
constexpr int BM = 256, BK = 64, HALF = 128, HTB = HALF * BK * 2  , STAGE_BYTES = 8 * HTB, NXCD = 8, WGM = 8;

__host__ __device__ __forceinline__ int lds_byte(int r, int c) { const int st = (r >> 4) * 2 + (c >> 5), rr = r & 15, cc = c & 31, ob = rr * 64 + cc * 2; return st * 1024 + (ob ^ (((ob >> 9) & 1) << 5)); }
__host__ __device__ __forceinline__ void stage_rc(int b, int& R, int& C) { const int st = b / 1024, sb = b % 1024, swz = sb ^ (((sb >> 9) & 1) << 5); R = (st >> 1) * 16 + swz / 64; C = (st & 1) * 32 + (swz % 64) / 2; }
__host__ __device__ __forceinline__ int perm32(int rho) { const int n = rho >> 4, i = rho & 15; return 8 * (i >> 2) + 4 * n + (i & 3); }

struct Unit { int pm, pn; };
struct Gemm { const bf16_t* A; const bf16_t* Bt; int M, N, K; };

struct StaticOrder {
    int nM, nN, nwg, G, c;
    __host__ __device__ void init(int M, int N, int G_, int c_) { nM = M / BM; nN = N / BM; nwg = nM * nN; G = G_; c = c_; }
    __host__ __device__ bool next(int i, Unit& u) const { return unit_of((long)i * G + c, u); }
    __host__ __device__ bool unit_of(long L, Unit& u) const {
        if (L >= nwg) return false;
        int wgid = (int)L; { const int q = nwg / NXCD, r = nwg % NXCD, xcd = wgid % NXCD, off = wgid / NXCD; wgid = (xcd < r ? xcd * (q + 1) : r * (q + 1) + (xcd - r) * q) + off; }
        const int nig = WGM * nN, gid = wgid / nig, fm = gid * WGM, gsz = (nM - fm) < WGM ? (nM - fm) : WGM;
        u.pm = fm + ((wgid % nig) % gsz); u.pn = (wgid % nig) / gsz; return true;
    }
    __device__ __forceinline__ void a_ready(const Unit&) const {}
    __device__ __forceinline__ void done(const Unit&) const {}
};

struct HeldOrder : StaticOrder {
    int nheld, r0;
    __host__ __device__ bool next(int i, Unit& u) const {
        if (i < r0) return unit_of((long)i * G + c, u);
        if (c >= G - nheld) return false;
        return unit_of((long)r0 * G + (long)(i - r0) * (G - nheld) + c, u); }
};
__device__ __forceinline__ unsigned cvt_pk_bf16(float lo, float hi) { unsigned r; asm volatile("v_cvt_pk_bf16_f32 %0, %1, %2" : "=v"(r) : "v"(lo), "v"(hi)); return r; }
template <class Epi, class Sched, bool GATHER = false, bool FP8 = false, bool ALIGN_EPI = true, bool SP2 = true>
__device__ __forceinline__ void gemm_phase(PG8_LAS unsigned char* lds, const Gemm g, const Sched& S, const Epi& E) {
    const int tid = threadIdx.x, wid = __builtin_amdgcn_readfirstlane(tid >> 6), lane = tid & 63, wr = wid >> 2, wc = wid & 3, fr = lane & 15, fq = lane >> 4;
    const int K = g.K, nt = K / BK;
    unsigned voffA[2], voffB[2];
#pragma unroll
    for (int i = 0; i < 2; ++i) { int R, C; stage_rc(tid * 16 + i * 8192, R, C); const int Rb = Epi::PERM ? ((R & ~31) + perm32(R & 31)) : R;
        voffA[i] = (unsigned)(R * K + C) * 2u; voffB[i] = (unsigned)(Rb * K + C) * 2u; }
    const size_t kstep = (size_t)(BK * 2);
    const size_t hstep = (size_t)HALF * K * 2;
    const size_t tstep = 2 * hstep;
    const unsigned ldsw = (unsigned)wid * 1024u;
    const int aoff = lds_byte(wr * 64 + fr, fq * 8), boff = lds_byte(wc * 32 + fr, fq * 8);
#define PG8_SA(b, h) (((b) * 2 + (h)) * HTB)
#define PG8_SB(b, h) ((4 + (b) * 2 + (h)) * HTB)
#define PG8_STAGE(bufoff, gbase, voff) do { _Pragma("unroll") for (int _i = 0; _i < 2; ++_i) \
        __builtin_amdgcn_global_load_lds((const unsigned*)((const char*)(gbase) + (voff)[_i]), (PG8_LAS unsigned*)(lds + (bufoff) + ldsw + _i * 8192), 16, 0, 0); } while (0)
#define PG8_LDA(dst, b, h) do { _Pragma("unroll") for (int m = 0; m < 4; ++m) _Pragma("unroll") for (int k = 0; k < 2; ++k) dst[m][k] = *(const PG8_LAS bf16x8*)(lds + PG8_SA(b, h) + aoff + m * 2048 + k * 1024); } while (0)
#define PG8_LDB(dst, b, h) do { _Pragma("unroll") for (int n = 0; n < 2; ++n) _Pragma("unroll") for (int k = 0; k < 2; ++k) dst[n][k] = *(const PG8_LAS bf16x8*)(lds + PG8_SB(b, h) + boff + n * 2048 + k * 1024); } while (0)
#define PG8_MMA(ai, bj, At, Bt) do { __builtin_amdgcn_s_setprio(1); if constexpr (FP8) { _Pragma("unroll") for (int m = 0; m < 4; ++m) _Pragma("unroll") for (int n = 0; n < 2; ++n) { \
            typedef int i32x4_ __attribute__((ext_vector_type(4))); \
            const i32x8 bb_ = __builtin_shufflevector(__builtin_bit_cast(i32x4_, Bt[n][0]), __builtin_bit_cast(i32x4_, Bt[n][1]), 0, 1, 2, 3, 4, 5, 6, 7), aa_ = __builtin_shufflevector(__builtin_bit_cast(i32x4_, At[m][0]), __builtin_bit_cast(i32x4_, At[m][1]), 0, 1, 2, 3, 4, 5, 6, 7); \
            asm volatile("v_mfma_scale_f32_16x16x128_f8f6f4 %0, %1, %2, %0, %3, %3 op_sel_hi:[0,0,0]" : "+v"(acc[ai][bj][m][n]) : "v"(bb_), "v"(aa_), "v"(scl8)); } } \
        else { _Pragma("unroll") for (int m = 0; m < 4; ++m) _Pragma("unroll") for (int n = 0; n < 2; ++n) _Pragma("unroll") for (int k = 0; k < 2; ++k) \
        acc[ai][bj][m][n] = __builtin_amdgcn_mfma_f32_16x16x32_bf16(Bt[n][k], At[m][k], acc[ai][bj][m][n], 0, 0, 0); } __builtin_amdgcn_s_setprio(0); } while (0)
#define PG8_WAIT_V(n) asm volatile("s_waitcnt vmcnt(" #n ")" ::: "memory")
#define PG8_WAIT_L(n) asm volatile("s_waitcnt lgkmcnt(" #n ")" ::: "memory")
#define PG8_BAR __builtin_amdgcn_s_barrier()
#define PG8_SCHED __builtin_amdgcn_sched_barrier(0)
    const int scl8 = 0x7f7f7f7f;
    Unit cur, nxt; int ui = 0;
    if (!S.next(0, cur)) return;
    f32x4 acc[2][2][4][2];
#pragma unroll
    for (int a = 0; a < 2; ++a)
#pragma unroll
        for (int b = 0; b < 2; ++b)
#pragma unroll
            for (int m = 0; m < 4; ++m)
#pragma unroll
                for (int n = 0; n < 2; ++n) acc[a][b][m][n] = (f32x4){0.f, 0.f, 0.f, 0.f};
    bf16x8 At[4][2], B0[2][2], B1[2][2];
    const char* cA = GATHER ? (const char*)g.A : (const char*)g.A + (size_t)cur.pm * tstep; const char* cB = (const char*)g.Bt + (size_t)cur.pn * tstep;
    const size_t hstepA = GATHER ? 0 : hstep;
    unsigned cv0[2], cv1[2], nv0[2], nv1[2];
    if constexpr (GATHER) { const u32x4 vv = S.voff(cur); cv0[0] = vv.x; cv0[1] = vv.y; cv1[0] = vv.z; cv1[1] = vv.w; } else { cv0[0] = cv1[0] = voffA[0]; cv0[1] = cv1[1] = voffA[1]; }
    nv0[0] = cv0[0]; nv0[1] = cv0[1]; nv1[0] = cv1[0]; nv1[1] = cv1[1];
    S.a_ready(cur);
    if constexpr (SP2) {
        PG8_STAGE(PG8_SB(0, 0), cB, voffB); PG8_STAGE(PG8_SB(0, 1), cB + hstep, voffB); PG8_STAGE(PG8_SA(0, 0), cA, cv0); PG8_STAGE(PG8_SA(0, 1), cA + hstepA, cv1);
        if (wr == 1) PG8_BAR;
        PG8_WAIT_V(2); PG8_BAR;
        PG8_STAGE(PG8_SB(1, 0), cB + kstep, voffB); PG8_STAGE(PG8_SA(1, 0), cA + kstep, cv0); PG8_STAGE(PG8_SB(1, 1), cB + hstep + kstep, voffB);
        PG8_WAIT_V(6); PG8_BAR;
    } else {
        PG8_STAGE(PG8_SB(0, 0), cB, voffB); PG8_STAGE(PG8_SA(0, 0), cA, cv0); PG8_STAGE(PG8_SB(0, 1), cB + hstep, voffB); PG8_STAGE(PG8_SA(0, 1), cA + hstepA, cv1);
        if (wr == 1) PG8_BAR;
        PG8_WAIT_V(4); PG8_BAR;
        PG8_STAGE(PG8_SB(1, 0), cB + kstep, voffB); PG8_STAGE(PG8_SA(1, 0), cA + kstep, cv0); PG8_STAGE(PG8_SB(1, 1), cB + hstep + kstep, voffB);
        PG8_WAIT_V(6); PG8_BAR;
    }
    for (;;) {
        const bool has_next = S.next(ui + 1, nxt);
        if constexpr (GATHER) { if (has_next) { const u32x4 vv = S.voff(nxt); nv0[0] = vv.x; nv0[1] = vv.y; nv1[0] = vv.z; nv1[1] = vv.w; } }
        const char* nA = GATHER ? cA : (has_next ? (const char*)g.A + (size_t)nxt.pm * tstep : cA); const char* nB = has_next ? (const char*)g.Bt + (size_t)nxt.pn * tstep : cB;
#pragma unroll 1
        for (int t = 0; t < nt; t += 2) {
            const bool last = (t == nt - 2);
            const char* a1 = cA + (size_t)(t + 1) * kstep;
            const char* a2 = last ? nA : cA + (size_t)(t + 2) * kstep; const char* b2 = last ? nB : cB + (size_t)(t + 2) * kstep;
            const char* a3 = a2 + kstep; const char* b3 = b2 + kstep;
            unsigned sv0[2], sv1[2];
            sv0[0] = last ? nv0[0] : cv0[0]; sv0[1] = last ? nv0[1] : cv0[1]; sv1[0] = last ? nv1[0] : cv1[0]; sv1[1] = last ? nv1[1] : cv1[1];
            if (last && has_next) S.a_ready(nxt);
            if constexpr (SP2) {
            PG8_LDB(B0, 0, 0); PG8_LDB(B1, 0, 1); PG8_SCHED; PG8_LDA(At, 0, 0); PG8_STAGE(PG8_SA(1, 1), a1 + hstepA, cv1);
            PG8_WAIT_V(8); PG8_WAIT_L(0); PG8_BAR; PG8_MMA(0, 0, At, B0); PG8_MMA(0, 1, At, B1); PG8_BAR; PG8_SCHED;
            PG8_LDA(At, 0, 1); PG8_STAGE(PG8_SB(0, 0), b2, voffB); PG8_STAGE(PG8_SB(0, 1), b2 + hstep, voffB); PG8_STAGE(PG8_SA(0, 0), a2, sv0);
            PG8_WAIT_V(8); PG8_WAIT_L(0); PG8_BAR; PG8_MMA(1, 0, At, B0); PG8_MMA(1, 1, At, B1); PG8_BAR; PG8_SCHED;
            PG8_LDB(B0, 1, 0); PG8_LDB(B1, 1, 1); PG8_SCHED; PG8_LDA(At, 1, 0); PG8_STAGE(PG8_SA(0, 1), a2 + hstepA, sv1);
            PG8_WAIT_V(8); PG8_WAIT_L(0); PG8_BAR; PG8_MMA(0, 0, At, B0); PG8_MMA(0, 1, At, B1); PG8_BAR; PG8_SCHED;
            PG8_LDA(At, 1, 1); PG8_STAGE(PG8_SB(1, 0), b3, voffB); PG8_STAGE(PG8_SB(1, 1), b3 + hstep, voffB); PG8_STAGE(PG8_SA(1, 0), a3, sv0);
            PG8_WAIT_V(8); PG8_WAIT_L(0); PG8_BAR; PG8_MMA(1, 0, At, B0); PG8_MMA(1, 1, At, B1); PG8_BAR; PG8_SCHED;
            } else {
            PG8_LDB(B0, 0, 0); PG8_SCHED; PG8_LDA(At, 0, 0); PG8_STAGE(PG8_SA(1, 1), a1 + hstepA, cv1);
            PG8_WAIT_L(8); PG8_BAR; PG8_WAIT_L(0); PG8_MMA(0, 0, At, B0); PG8_BAR; PG8_SCHED;
            PG8_LDB(B1, 0, 1); PG8_STAGE(PG8_SB(0, 0), b2, voffB);
            PG8_BAR; PG8_WAIT_L(0); PG8_MMA(0, 1, At, B1); PG8_BAR;
            PG8_LDA(At, 0, 1); PG8_STAGE(PG8_SA(0, 0), a2, sv0);
            PG8_BAR; PG8_WAIT_L(0); PG8_MMA(1, 0, At, B0); PG8_BAR; PG8_SCHED;
            PG8_STAGE(PG8_SB(0, 1), b2 + hstep, voffB);
            PG8_WAIT_V(6); PG8_BAR; PG8_MMA(1, 1, At, B1); PG8_BAR;
            PG8_LDB(B0, 1, 0); PG8_SCHED; PG8_LDA(At, 1, 0); PG8_STAGE(PG8_SA(0, 1), a2 + hstepA, sv1);
            PG8_WAIT_L(8); PG8_BAR; PG8_WAIT_L(0); PG8_MMA(0, 0, At, B0); PG8_BAR; PG8_SCHED;
            PG8_LDB(B1, 1, 1); PG8_STAGE(PG8_SB(1, 0), b3, voffB);
            PG8_BAR; PG8_WAIT_L(0); PG8_MMA(0, 1, At, B1); PG8_BAR;
            PG8_LDA(At, 1, 1); PG8_STAGE(PG8_SA(1, 0), a3, sv0);
            PG8_BAR; PG8_WAIT_L(0); PG8_MMA(1, 0, At, B0); PG8_BAR; PG8_SCHED;
            PG8_STAGE(PG8_SB(1, 1), b3 + hstep, voffB);
            PG8_WAIT_V(6); PG8_BAR; PG8_MMA(1, 1, At, B1); PG8_BAR;
                    }
        }
        if constexpr (FP8) asm volatile("s_nop 15\n\ts_nop 15\n\ts_nop 7" ::: "memory");
        if constexpr (ALIGN_EPI) { if (wr == 0) PG8_BAR; }
        if constexpr (!Epi::AFTER_DRAIN) { E(acc, cur, wr, wc, fr, fq); S.done(cur); }
        if (!has_next) break;
#pragma unroll
        for (int a = 0; a < 2; ++a)
#pragma unroll
            for (int b = 0; b < 2; ++b)
#pragma unroll
                for (int m = 0; m < 4; ++m)
#pragma unroll
                    for (int n = 0; n < 2; ++n) acc[a][b][m][n] = (f32x4){0.f, 0.f, 0.f, 0.f};
        cur = nxt; cA = nA; cB = nB; ++ui; cv0[0] = nv0[0]; cv0[1] = nv0[1]; cv1[0] = nv1[0]; cv1[1] = nv1[1];
        if constexpr (ALIGN_EPI) { if (wr == 1) PG8_BAR; }
    }
    PG8_WAIT_V(0);
    if constexpr (!ALIGN_EPI) { if (wr == 0) PG8_BAR; }
    PG8_BAR;
    if constexpr (Epi::AFTER_DRAIN) { E.fused(acc, cur, wr, wc, fr, fq, lds, wid, lane); S.done(cur); }
#undef PG8_SA
#undef PG8_SB
#undef PG8_STAGE
#undef PG8_LDA
#undef PG8_LDB
#undef PG8_MMA
#undef PG8_WAIT_V
#undef PG8_WAIT_L
#undef PG8_BAR
#undef PG8_SCHED
}
}

namespace pg8 {
struct EpiBf {
    static constexpr bool PERM = true, AFTER_DRAIN = false;
    bf16_t* O; int ldc; float sc;
    __device__ __forceinline__ void operator()(const f32x4 (&acc)[2][2][4][2], const Unit& u, int wr, int wc, int fr, int fq) const {
        const int row0 = u.pm * BM + wr * 64 + fr, col0 = u.pn * BM + wc * 32 + 8 * fq;
#pragma unroll
        for (int ai = 0; ai < 2; ++ai)
#pragma unroll
            for (int m = 0; m < 4; ++m) { bf16_t* rowp = O + (size_t)(row0 + ai * HALF + m * 16) * ldc + col0;
#pragma unroll
                for (int bj = 0; bj < 2; ++bj) { const f32x4 v0 = acc[ai][bj][m][0] * sc, v1 = acc[ai][bj][m][1] * sc;
                    u32x4 w; w.x = cvt_pk_bf16(v0[0], v0[1]); w.y = cvt_pk_bf16(v0[2], v0[3]); w.z = cvt_pk_bf16(v1[0], v1[1]); w.w = cvt_pk_bf16(v1[2], v1[3]);
                    *(u32x4*)(rowp + bj * HALF) = w; } }
    }
};
struct EpiF32 {
    static constexpr bool PERM = false, AFTER_DRAIN = false;
    float* C; int ldc;
    __device__ __forceinline__ void operator()(const f32x4 (&acc)[2][2][4][2], const Unit& u, int wr, int wc, int fr, int fq) const {
        const int row0 = u.pm * BM + wr * 64 + fr, col0 = u.pn * BM + wc * 32 + 4 * fq;
#pragma unroll
        for (int ai = 0; ai < 2; ++ai)
#pragma unroll
            for (int m = 0; m < 4; ++m) { float* rowp = C + (size_t)(row0 + ai * HALF + m * 16) * ldc + col0;
#pragma unroll
                for (int bj = 0; bj < 2; ++bj)
#pragma unroll
                    for (int n = 0; n < 2; ++n) *(f32x4*)(rowp + bj * HALF + n * 16) = acc[ai][bj][m][n]; }
    }
};
struct EpiOdA {
    static constexpr bool PERM = true, AFTER_DRAIN = false;
    bf16_t* PQ; float* GATES;
    __device__ __forceinline__ void operator()(const f32x4 (&acc)[2][2][4][2], const Unit& u, int wr, int wc, int fr, int fq) const {
        const int row0 = u.pm * BM + wr * 64 + fr;
        if (u.pn < ODA_N / 256 - 1) {
            const int col0 = (OD8_MODE == 2 ? 2048 : 0) + u.pn * BM + wc * 32 + 8 * fq;
#pragma unroll
            for (int ai = 0; ai < 2; ++ai)
#pragma unroll
                for (int m = 0; m < 4; ++m) { bf16_t* rowp = PQ + (size_t)(row0 + ai * HALF + m * 16) * 8192 + col0;
#pragma unroll
                    for (int bj = 0; bj < 2; ++bj) { const f32x4 v0 = acc[ai][bj][m][0], v1 = acc[ai][bj][m][1];
                        u32x4 w; w.x = cvt_pk_bf16(v0[0], v0[1]); w.y = cvt_pk_bf16(v0[2], v0[3]); w.z = cvt_pk_bf16(v1[0], v1[1]); w.w = cvt_pk_bf16(v1[2], v1[3]);
                        *(u32x4*)(rowp + bj * HALF) = w; } }
        } else {
            const int col0 = wc * 32 + 8 * fq;
#pragma unroll
            for (int ai = 0; ai < 2; ++ai)
#pragma unroll
                for (int m = 0; m < 4; ++m) { float* rowp = GATES + (size_t)(row0 + ai * HALF + m * 16) * 128 + col0;
                    *(f32x4*)(rowp) = acc[ai][0][m][0]; *(f32x4*)(rowp + 4) = acc[ai][0][m][1]; }
        }
    }
};
struct EpiOdB {
    static constexpr bool PERM = true, AFTER_DRAIN = false;
    bf16_t* PQ; bf16_t* PZ; float sc;
    __device__ __forceinline__ void operator()(const f32x4 (&acc)[2][2][4][2], const Unit& u, int wr, int wc, int fr, int fq) const {
        const int row0 = u.pm * BM + wr * 64 + fr;
        constexpr int NQK = OD8_MODE == 1 ? 0 : (OD8_MODE == 2 ? 8 : 16);
        bf16_t* base; int ldc, colt;
        if (u.pn < NQK) { base = PQ; ldc = 8192; colt = u.pn * BM; }
        else if (u.pn < NQK + 16) { base = PQ; ldc = 8192; colt = 4096 + (u.pn - NQK) * BM; }
        else { base = PZ; ldc = 4096; colt = (u.pn - NQK - 16) * BM; }
        const int col0 = colt + wc * 32 + 8 * fq;
#pragma unroll
        for (int ai = 0; ai < 2; ++ai)
#pragma unroll
            for (int m = 0; m < 4; ++m) { bf16_t* rowp = base + (size_t)(row0 + ai * HALF + m * 16) * ldc + col0;
#pragma unroll
                for (int bj = 0; bj < 2; ++bj) { const f32x4 v0 = acc[ai][bj][m][0] * sc, v1 = acc[ai][bj][m][1] * sc;
                    u32x4 w; w.x = cvt_pk_bf16(v0[0], v0[1]); w.y = cvt_pk_bf16(v0[2], v0[3]); w.z = cvt_pk_bf16(v1[0], v1[1]); w.w = cvt_pk_bf16(v1[2], v1[3]);
                    *(u32x4*)(rowp + bj * HALF) = w; } }
    }
};
struct EpiSwiGlu {
    static constexpr bool PERM = true, AFTER_DRAIN = false;
    unsigned char* H; float inv;
    __device__ __forceinline__ void operator()(const f32x4 (&acc)[2][2][4][2], const Unit& u, int wr, int wc, int fr, int fq) const {
        const int row0 = u.pm * BM + wr * 64 + fr, col0 = (u.pn & 7) * HALF + wc * 32 + 8 * fq;
#pragma unroll
        for (int ai = 0; ai < 2; ++ai)
#pragma unroll
            for (int m = 0; m < 4; ++m) { unsigned char* rowp = H + (size_t)(row0 + ai * HALF + m * 16) * 1024 + col0;
                float v[8];
#pragma unroll
                for (int n = 0; n < 2; ++n)
#pragma unroll
                    for (int j = 0; j < 4; ++j) { const float gt = acc[ai][0][m][n][j] * inv, up = acc[ai][1][m][n][j] * inv; v[n * 4 + j] = gt * __builtin_amdgcn_rcpf(1.0f + __expf(-gt)) * up; }
                int w0 = 0, w1 = 0; w0 = __builtin_amdgcn_cvt_pk_fp8_f32(v[0], v[1], w0, false); w0 = __builtin_amdgcn_cvt_pk_fp8_f32(v[2], v[3], w0, true);
                w1 = __builtin_amdgcn_cvt_pk_fp8_f32(v[4], v[5], w1, false); w1 = __builtin_amdgcn_cvt_pk_fp8_f32(v[6], v[7], w1, true);
                typedef unsigned u32x2_ __attribute__((ext_vector_type(2))); *(u32x2_*)(rowp) = (u32x2_){(unsigned)w0, (unsigned)w1}; }
    }
};
struct EpiDown {
    static constexpr bool PERM = true, AFTER_DRAIN = false;
    bf16_t* Y; const float* gate; float inv;
    __device__ __forceinline__ void operator()(const f32x4 (&acc)[2][2][4][2], const Unit& u, int wr, int wc, int fr, int fq) const {
        const int row0 = u.pm * BM + wr * 64 + fr, col0 = (u.pn & 7) * BM + wc * 32 + 8 * fq;
#pragma unroll
        for (int ai = 0; ai < 2; ++ai)
#pragma unroll
            for (int m = 0; m < 4; ++m) { const int row = row0 + ai * HALF + m * 16; const float gt = gate[row] * inv; bf16_t* rowp = Y + (size_t)row * 2048 + col0;
#pragma unroll
                for (int bj = 0; bj < 2; ++bj) { const f32x4 v0 = acc[ai][bj][m][0] * gt, v1 = acc[ai][bj][m][1] * gt;
                    u32x4 w; w.x = cvt_pk_bf16(v0[0], v0[1]); w.y = cvt_pk_bf16(v0[2], v0[3]); w.z = cvt_pk_bf16(v1[0], v1[1]); w.w = cvt_pk_bf16(v1[2], v1[3]);
                    *(u32x4*)(rowp + bj * HALF) = w; } }
    }
};
struct MoeOrder {
    int G, c, nctx;
    const unsigned* vtab;
    __device__ __forceinline__ u32x4 voff(const Unit& u) const { return *(const u32x4*)(vtab + ((size_t)u.pm * 512 + threadIdx.x) * 4); }
    __device__ __forceinline__ bool next(int i, Unit& u) const {
        long L = (long)i * G + c;
        if (L < 1024) { const int l = (int)L; const int lp = (G == 256) ? (l / 256) * 256 + (l % 8) * 32 + (l % 256) / 8 : l;
            const int s = lp / 32, w = lp % 32, e = s / 2, b = s % 2; u.pm = (b * 16 + e) * 4 + (w % 4); u.pn = e * 8 + (w / 4); return true; }
        L -= 1024; if (L < nctx) { const int e = (int)L / 8; u.pm = 128 + e; u.pn = e * 8 + (int)L % 8; return true; }
        return false;
    }
    __device__ __forceinline__ void a_ready(const Unit&) const {}
    __device__ __forceinline__ void done(const Unit&) const {}
};
}
#define XB_TMO      128
#define XB_XCNT(j)  (256  + 64 * (j))
#define XB_XSUB(j)  (1280 + 64 * (j))
#define XB_XGEN(j)  (2304 + 64 * (j))
#define XB_TOP      3328
#define XB_TOPGEN   3392
#define XCD_BAR_WORDS 3456
#define XB_SPIN_CAP (1u << 22)

__device__ __forceinline__ unsigned xb_ld(unsigned* p)              { return __hip_atomic_load(p, __ATOMIC_RELAXED, __HIP_MEMORY_SCOPE_AGENT); }
__device__ __forceinline__ unsigned xb_add(unsigned* p, unsigned v) { return __hip_atomic_fetch_add(p, v, __ATOMIC_RELAXED, __HIP_MEMORY_SCOPE_AGENT); }
__device__ __forceinline__ unsigned xb_xcc_id() { return (unsigned)__builtin_amdgcn_s_getreg((3 << 11) | 20) & 0xFu; }
#define XB_SPIN(cond, bar) do { unsigned _sp = 0; while (cond) { __builtin_amdgcn_s_sleep(1); \
    if ((++_sp & 255u) == 0u) { if (xb_ld(&(bar)[XB_TMO])) break; if (_sp > XB_SPIN_CAP) { atomicAdd(&(bar)[XB_TMO], 1u); break; } } } } while (0)

struct XcdBarrier {
    unsigned* bar; unsigned x;
    volatile LAS unsigned* st;
};

__device__ __forceinline__ XcdBarrier xcd_barrier_post(unsigned* bar, volatile LAS unsigned* st) {
    XcdBarrier b; b.bar = bar; b.x = xb_xcc_id(); b.st = st;
    if (threadIdx.x == 0) (void)xb_add(&bar[XB_XCNT(b.x)], 1u);
    return b;
}
__device__ __forceinline__ void xcd_barrier_complete(unsigned* bar, unsigned x, unsigned& nloc, unsigned& nx) {
    const unsigned G = gridDim.x * gridDim.y * gridDim.z;
    unsigned sum, cnt, mine, sp = 0u;
    for (;;) {
        sum = 0u; cnt = 0u; mine = 0u;
#pragma unroll
        for (unsigned j = 0; j < 16; ++j) { const unsigned c = xb_ld(&bar[XB_XCNT(j)]); sum += c; cnt += (c > 0u) ? 1u : 0u; mine = (j == x) ? c : mine; }
        if (sum == G) break;
        __builtin_amdgcn_s_sleep(1);
        if ((++sp & 255u) == 0u) { if (xb_ld(&bar[XB_TMO])) break; if (sp > XB_SPIN_CAP) { atomicAdd(&bar[XB_TMO], 1u); break; } }
    }
    nloc = mine > 0u ? mine : 1u; nx = cnt > 0u ? cnt : 1u;
}

__device__ __forceinline__ void xcd_barrier(const XcdBarrier& b) {
    asm volatile("s_waitcnt vmcnt(0)" ::: "memory");
    __syncthreads();
    if (threadIdx.x == 0) {
        unsigned* bar = b.bar;
        __builtin_amdgcn_s_waitcnt(0);
        unsigned nloc = b.st[0], nx = b.st[1];
        if (nloc == 0u) { xcd_barrier_complete(bar, b.x, nloc, nx); b.st[0] = nloc; b.st[1] = nx; }
        const unsigned old = xb_add(&bar[XB_XSUB(b.x)], 1u);
        const unsigned gen = old / nloc;
        if (old + 1u == (gen + 1u) * nloc) {
            __builtin_amdgcn_fence(__ATOMIC_RELEASE, "agent");
            asm volatile("s_waitcnt vmcnt(0)" ::: "memory");
            const unsigned og = xb_add(&bar[XB_TOP], 1u);
            const unsigned tg = og / nx;
            if (og + 1u == (tg + 1u) * nx) xb_add(&bar[XB_TOPGEN], 1u);
            else XB_SPIN(xb_ld(&bar[XB_TOPGEN]) == tg, bar);
            __builtin_amdgcn_fence(__ATOMIC_ACQUIRE, "agent");
            xb_add(&bar[XB_XGEN(b.x)], 1u);
            asm volatile("s_waitcnt vmcnt(0)" ::: "memory");
        } else {
            XB_SPIN(xb_ld(&bar[XB_XGEN(b.x)]) == gen, bar);
            __builtin_amdgcn_fence(__ATOMIC_ACQUIRE, "agent");
            asm volatile("s_waitcnt vmcnt(0)" ::: "memory");
        }
    }
    __syncthreads();
}

struct Params { const float* in[31]; float* out; unsigned char* ws; int ph_lo, ph_hi; };
enum { I_X = 0, I_C, I_CTX, I_CCTX, I_MODW, I_MODB, I_NORMG, I_EVWIN, I_EVWOUT, I_HGLB, I_HGNG, I_S5ARE, I_S5AIM, I_S5LDT, I_S5BRE, I_S5BIM, I_S5CRE, I_S5CIM, I_S5D, I_S5GLUW, I_S5GLUB,
       I_ODWIN, I_ODCONV, I_ODALOG, I_ODDTB, I_ODNG, I_ODWOUT, I_ROUTER, I_MOEG, I_MOEU, I_MOED };
struct Frame { LAS unsigned char* lds; int tid, lane, wave, G, bid; };
#define WSP(T, off) ((T*)(P.ws + (off)))

struct TrTile { const float* src; bf16_t* dst; int N, K; float s8; };
DI void tr_issue(const TrTile& t, f32x4 (&v)[4], int tid) {
#pragma unroll
    for (int i = 0; i < 4; ++i) { const int idx = tid + 512 * i, kr = idx >> 4, nc = (idx & 15) * 4; v[i] = *(const f32x4*)(t.src + (size_t)kr * t.N + nc); }
}
DI void tr_finish(const TrTile& t, const f32x4 (&v)[4], LAS unsigned char* lds, int buf, int tid) {
    if (t.s8 != 0.f) {
        LAS unsigned char* t8 = lds + buf * 17408;
#pragma unroll
        for (int i = 0; i < 4; ++i) { const int idx = tid + 512 * i, kr = idx >> 4, nc = (idx & 15) * 4; const unsigned w = cvt4_fp8(v[i][0] * t.s8, v[i][1] * t.s8, v[i][2] * t.s8, v[i][3] * t.s8);
            t8[(nc + 0) * 144 + kr] = (unsigned char)(w & 0xffu); t8[(nc + 1) * 144 + kr] = (unsigned char)((w >> 8) & 0xffu); t8[(nc + 2) * 144 + kr] = (unsigned char)((w >> 16) & 0xffu); t8[(nc + 3) * 144 + kr] = (unsigned char)(w >> 24); }
        __syncthreads();
        { const int n = tid >> 3, ch = tid & 7; *(u32x4*)((unsigned char*)t.dst + (size_t)n * t.K + ch * 16) = *(const LAS u32x4*)(t8 + n * 144 + ch * 16); }
        return; }
    LAS bf16_t* tT = (LAS bf16_t*)(lds + buf * 17408);
#pragma unroll
    for (int i = 0; i < 4; ++i) { const int idx = tid + 512 * i, kr = idx >> 4, nc = (idx & 15) * 4;
        const unsigned a = pk2(v[i][0], v[i][1]), b = pk2(v[i][2], v[i][3]);
        tT[(nc + 0) * 136 + kr] = (bf16_t)(a & 0xffffu); tT[(nc + 1) * 136 + kr] = (bf16_t)(a >> 16); tT[(nc + 2) * 136 + kr] = (bf16_t)(b & 0xffffu); tT[(nc + 3) * 136 + kr] = (bf16_t)(b >> 16); }
    __syncthreads();
#pragma unroll
    for (int i = 0; i < 2; ++i) { const int idx = tid + 512 * i, n = idx >> 4, ch = idx & 15;
        const u32x4 w = *(const LAS u32x4*)(tT + n * 136 + ch * 8);
        *(u32x4*)(t.dst + (size_t)n * t.K + ch * 8) = w; }
}
DI TrTile tr_desc(const float* src, int N, int k0, int n0, bf16_t* dst, int K, int drow0) { TrTile t; t.src = src + (size_t)k0 * N + n0; t.dst = dst + (size_t)drow0 * K + k0; t.N = N; t.K = K; t.s8 = 0.f; return t; }
DI TrTile tr_desc8(const float* src, int N, int k0, int n0, unsigned char* dst, int K, int drow0, float s8) { TrTile t; t.src = src + (size_t)k0 * N + n0; t.dst = (bf16_t*)(dst + (size_t)drow0 * K + k0); t.N = N; t.K = K; t.s8 = s8; return t; }
DI TrTile tr_moe_desc(const Params& P, int layer, int idx, bf16_t* WGU, bf16_t* WDN) {
    const int e = idx / 768, rem = idx % 768, which = rem / 256, t = rem % 256;
    if (which < 2) { const float* src = P.in[which ? I_MOEU : I_MOEG] + (size_t)(layer * 16 + e) * 2048 * 1024; const int kt = t / 16, nt = t % 16, n0 = nt * 64;
        return tr_desc8(src, 1024, kt * 128, n0, (unsigned char*)WGU + (size_t)e * 2048 * 2048, 2048, (n0 / 128) * 256 + (n0 % 128) + which * 128, W8_GU); }
    const float* src = P.in[I_MOED] + (size_t)(layer * 16 + e) * 1024 * 2048; const int kt = t / 32, nt = t % 32;
    return tr_desc8(src, 2048, kt * 128, nt * 64, (unsigned char*)WDN + (size_t)e * 2048 * 1024, 1024, nt * 64, W8_DN);
}
DI void t4_issue(const TrTile& t, f32x4 (&v)[4], int tid) { const int kb = tid >> 4, nb = tid & 15;
#pragma unroll
    for (int r = 0; r < 4; ++r) v[r] = *(const f32x4*)(t.src + (size_t)(4 * kb + r) * t.N + 4 * nb); }
DI void t4_lds(const TrTile& t, const f32x4 (&v)[4], LAS unsigned char* img, int tid) { const int kb = tid >> 4, nb = tid & 15;
#pragma unroll
    for (int j = 0; j < 4; ++j) *(LAS unsigned*)(img + (4 * nb + j) * 144 + 4 * kb) = cvt4_fp8(v[0][j] * t.s8, v[1][j] * t.s8, v[2][j] * t.s8, v[3][j] * t.s8); }
DI void t4_store(const TrTile& t, const LAS unsigned char* img, int tid) { const int n = tid >> 3, ch = tid & 7; *(u32x4*)((unsigned char*)t.dst + (size_t)n * t.K + ch * 16) = *(const LAS u32x4*)(img + n * 144 + ch * 16); }
constexpr int L1Q_END = 12288 - NB * HGH * NCHUNK;
DI void l1w_from_queue(const Params& P, const Frame& F, int quota) {
    volatile LAS int* slot = (volatile LAS int*)(F.lds + LDS_MISC - 16); unsigned* ctr = WSP(unsigned, WS_CTL) + 256;
    __syncthreads();
    if (F.tid == 0) *slot = quota > 0 ? (int)__hip_atomic_fetch_add(ctr, (unsigned)quota, __ATOMIC_RELAXED, __HIP_MEMORY_SCOPE_AGENT) : (int)__hip_atomic_load(ctr, __ATOMIC_RELAXED, __HIP_MEMORY_SCOPE_AGENT);
    __syncthreads();
    int t = *slot, step = 1, end = t + quota;
    if (quota < 0) { t += F.bid; step = F.G; end = L1Q_END; }
    if (end > L1Q_END) end = L1Q_END;
    if (t >= end) return;
    TrTile cur = tr_moe_desc(P, 1, t, WSP(bf16_t, WS_WGU1), WSP(bf16_t, WS_WDN1)); f32x4 va[4], vb[4]; tr_issue(cur, va, F.tid); int buf = 0;
    for (;;) { const int tn = t + step; const bool more = tn < end; TrTile nx = cur; if (more) { nx = tr_moe_desc(P, 1, tn, WSP(bf16_t, WS_WGU1), WSP(bf16_t, WS_WDN1)); tr_issue(nx, vb, F.tid); }
        tr_finish(cur, va, F.lds, buf, F.tid); buf ^= 1;
        if (!more) break;
#pragma unroll
        for (int i = 0; i < 4; ++i) va[i] = vb[i];
        cur = nx; t = tn; }
    __syncthreads();
}
constexpr int P0_NMOD = 384, P0_NS5 = 64, P0_T0 = P0_NMOD + P0_NS5 + 1;
constexpr int P0_TEVIN = 16 * 96, P0_TEVOUT = 16 * 32, P0_TODIN = 16 * 194, P0_TODOUT = 32 * 32, P0_TMOE = 12288;
constexpr int P0_NTASK = P0_T0 + P0_TEVIN + P0_TEVOUT + P0_TODIN + P0_TODOUT;
constexpr int P0_LDS_SC = 20480, P0_LDS_RED = 45056;

DI void p0_modgemv(const Params& P, const Frame& F, int task) {
    const int layer = task / 192, cg = task % 192, rg = F.tid >> 4, l16 = F.tid & 15, col = cg * 64 + l16 * 4;
    const LAS float* SC = (const LAS float*)(F.lds + P0_LDS_SC); LAS float* RED = (LAS float*)(F.lds + P0_LDS_RED);
    const float* W = P.in[I_MODW] + (size_t)layer * 2048 * 12288 + col;
    f32x4 a0 = {0, 0, 0, 0}, a1 = a0, a2 = a0;
#pragma unroll 8
    for (int kk = 0; kk < 64; ++kk) { const int k = rg + 32 * kk; const f32x4 w = *(const f32x4*)(W + (size_t)k * 12288);
        a0 += w * SC[k]; a1 += w * SC[2048 + k]; a2 += w * SC[4096 + k]; }
#pragma unroll
    for (int j = 0; j < 4; ++j) { RED[(rg * 3 + 0) * 64 + l16 * 4 + j] = a0[j]; RED[(rg * 3 + 1) * 64 + l16 * 4 + j] = a1[j]; RED[(rg * 3 + 2) * 64 + l16 * 4 + j] = a2[j]; }
    __syncthreads();
    if (F.tid < 192) { const int i = F.tid / 64, cc = F.tid % 64; float s = 0.f;
#pragma unroll 8
        for (int r = 0; r < 32; ++r) s += RED[(r * 3 + i) * 64 + cc];
        WSP(float, WS_MODV)[(size_t)(layer * 3 + i) * 12288 + cg * 64 + cc] = s + P.in[I_MODB][layer * 12288 + cg * 64 + cc]; }
    __syncthreads();
}
DI void p0_s5(const Params& P, const Frame& F, int g) {
    LAS float* BBr = (LAS float*)F.lds; LAS float* BBi = BBr + 2048; LAS float* CMr = BBr + 4096; LAS float* CMi = BBr + 6144;
    LAS float* APr = BBr + 8192; LAS float* APi = APr + 2176;
    LAS float* KT = BBr + 8192 + 4352;
    const int tid = F.tid;
    if (tid < 128) { const int dir = tid >> 6, p = tid & 63; const int gi = (dir * 64 + g) * 64 + p;
        const float ar = P.in[I_S5ARE][gi], ai = P.in[I_S5AIM][gi], dt = __expf(P.in[I_S5LDT][dir * 64 + g]);
        const float mag = ar * dt, ang = ai * dt; float sn, cs; sincosf(ang, &sn, &cs); const float em = expf(mag);
        const float nr = em * cs - 1.0f, ni = em * sn, den = 1.0f / (ar * ar + ai * ai);
        const float cr = (nr * ar + ni * ai) * den, ci = (ni * ar - nr * ai) * den;
        for (int c = 0; c < 16; ++c) { const float br = P.in[I_S5BRE][(size_t)gi * 16 + c], bi = P.in[I_S5BIM][(size_t)gi * 16 + c];
            BBr[(dir * 64 + p) * 16 + c] = cr * br - ci * bi; BBi[(dir * 64 + p) * 16 + c] = cr * bi + ci * br; }
        for (int l = 0; l <= 16; ++l) { float s2, c2; sincosf((float)l * ang, &s2, &c2); const float e2 = expf((float)l * mag); APr[(dir * 17 + l) * 64 + p] = e2 * c2; APi[(dir * 17 + l) * 64 + p] = e2 * s2; }
        float* a16 = WSP(float, WS_S5A16) + (size_t)gi * 2; a16[0] = APr[(dir * 17 + 16) * 64 + p]; a16[1] = APi[(dir * 17 + 16) * 64 + p]; }
    for (int i = tid; i < 2048; i += 512) { const int dir = i >> 10, c = (i >> 6) & 15, p = i & 63; const size_t gi = ((size_t)(dir * 64 + g) * 16 + c) * 64 + p;
        CMr[i] = P.in[I_S5CRE][gi]; CMi[i] = P.in[I_S5CIM][gi]; }
    __syncthreads();
    for (int i = tid; i < 8192; i += 512) { const int dir = i >> 12, l = (i >> 8) & 15, c = (i >> 4) & 15, c2 = i & 15; float acc = 0.f;
        for (int p = 0; p < 64; ++p) { const float Cr = CMr[(dir * 16 + c) * 64 + p], Ci = CMi[(dir * 16 + c) * 64 + p], Pr = APr[(dir * 17 + l) * 64 + p], Pi = APi[(dir * 17 + l) * 64 + p];
            const float tr = Cr * Pr - Ci * Pi, ti = Cr * Pi + Ci * Pr; acc += tr * BBr[(dir * 64 + p) * 16 + c2] - ti * BBi[(dir * 64 + p) * 16 + c2]; }
        KT[i] = acc; }
    __syncthreads();
    bf16_t* WY = WSP(bf16_t, WS_S5WY) + (size_t)g * 256 * 512; bf16_t* WX = WSP(bf16_t, WS_S5WX) + (size_t)g * 256 * 256;
    for (int i = tid; i < 256 * 512; i += 512) { const int row = i >> 9, col = i & 511, j = row >> 4, c = row & 15; float v;
        if (col < 256) { const int ii = col >> 4, c2 = col & 15; v = 0.f;
            if (ii <= j) v += KT[((0 * 16 + (j - ii)) * 16 + c) * 16 + c2];
            if (ii >= j) v += KT[((1 * 16 + (ii - j)) * 16 + c) * 16 + c2];
            if (ii == j && c == c2) v += P.in[I_S5D][g * 16 + c]; }
        else { const int q = col - 256, part = q >> 6, p = q & 63, dir = part >> 1, im = part & 1, l = dir == 0 ? j + 1 : 16 - j;
            const float Cr = CMr[(dir * 16 + c) * 64 + p], Ci = CMi[(dir * 16 + c) * 64 + p], Pr = APr[(dir * 17 + l) * 64 + p], Pi = APi[(dir * 17 + l) * 64 + p];
            v = im ? -(Cr * Pi + Ci * Pr) : (Cr * Pr - Ci * Pi); }
        WY[i] = f2bf(v); }
    for (int i = tid; i < 256 * 256; i += 512) { const int row = i >> 8, col = i & 255, part = row >> 6, p = row & 63, dir = part >> 1, im = part & 1, ii = col >> 4, c2 = col & 15, l = dir == 0 ? 15 - ii : ii;
        const float Pr = APr[(dir * 17 + l) * 64 + p], Pi = APi[(dir * 17 + l) * 64 + p], Br = BBr[(dir * 64 + p) * 16 + c2], Bi = BBi[(dir * 64 + p) * 16 + c2];
        WX[i] = f2bf(im ? (Pr * Bi + Pi * Br) : (Pr * Br - Pi * Bi)); }
    __syncthreads();
}
DI void p0_prologue(const Params& P, const Frame& F, int rep) {
    if (F.bid < P0_NMOD) {
        LAS float* SC = (LAS float*)(F.lds + P0_LDS_SC);
        for (int i = F.tid; i < 6144; i += 512) { const float v = i < 4096 ? P.in[I_C][i] : P.in[I_CCTX][i - 4096]; SC[i] = siluf_(v); }
        __syncthreads();
    }
    int task = F.bid;
    for (; task < P0_T0; task += F.G) {
        if (task < P0_NMOD) p0_modgemv(P, F, task);
        else if (task < P0_NMOD + P0_NS5) p0_s5(P, F, task - P0_NMOD);
        else { for (int i = F.tid; i < 2048; i += 512) { const float a0 = P.in[I_HGLB][i], a1 = P.in[I_HGLB][2048 + i]; WSP(float, WS_LB)[i] = 1.0f / (1.0f + __expf(a1 - a0)); } }
    }
    __syncthreads();
    auto desc = [&](int tk) -> TrTile { int t = tk - P0_T0;
        if (t < P0_TEVIN) return tr_desc(P.in[I_EVWIN], 6144, (t / 96) * 128, (t % 96) * 64, WSP(bf16_t, WS_WEVIN), 2048, (t % 96) * 64); t -= P0_TEVIN;
        if (t < P0_TEVOUT) return tr_desc8(P.in[I_EVWOUT], 2048, (t / 32) * 128, (t % 32) * 64, WSP(unsigned char, WS_WEVOUT), 2048, (t % 32) * 64, W8_GU); t -= P0_TEVOUT;
        if (t < P0_TODIN) { const int k0 = (t / 194) * 128, j = t % 194;
            const bool q8 = OD8_MODE >= 2, k8 = OD8_MODE >= 3;
            int r8 = -1, rb = -1;
            if (j < 32) { if (q8) r8 = j * 64; else rb = j * 64; }
            else if (j < 64) { if (k8) r8 = j * 64; else rb = (q8 ? j - 32 : j) * 64; }
            else if (j < 192) r8 = (j - 64) * 64 + (q8 ? 2048 : 0) + (k8 ? 2048 : 0);
            else rb = ODA_N - 256 + (j - 192) * 64;
            if (r8 >= 0) return tr_desc8(P.in[I_ODWIN], ODIN, k0, j * 64, WSP(unsigned char, WS_WODIN8), 2048, r8, W8_GU);
            return tr_desc(P.in[I_ODWIN], ODIN, k0, j * 64, WSP(bf16_t, WS_WODIN), 2048, rb); }
        t -= P0_TODIN;
        return tr_desc8(P.in[I_ODWOUT], 2048, (t / 32) * 128, (t % 32) * 64, WSP(unsigned char, WS_WODOUT), 4096, (t % 32) * 64, W8_GU); };
    { constexpr int PC = 4, NT = P0_NTASK - P0_T0; unsigned* ctr = WSP(unsigned, WS_CTL) + 320 + rep; volatile LAS int* slot = (volatile LAS int*)(F.lds + LDS_MISC - 16);
      if (F.tid == 0) { slot[0] = (int)__hip_atomic_fetch_add(ctr, (unsigned)PC, __ATOMIC_RELAXED, __HIP_MEMORY_SCOPE_AGENT); slot[1] = (int)__hip_atomic_fetch_add(ctr, (unsigned)PC, __ATOMIC_RELAXED, __HIP_MEMORY_SCOPE_AGENT); }
      __syncthreads();
      int t = slot[0], nbase = slot[1], k = 0, pend = 0; __syncthreads();
      if (t < NT) { TrTile cur = desc(P0_T0 + t); f32x4 va[4], vb[4]; tr_issue(cur, va, F.tid); int buf = 0;
        for (;;) { if (k == 0 && F.tid == 0) pend = (int)__hip_atomic_fetch_add(ctr, (unsigned)PC, __ATOMIC_RELAXED, __HIP_MEMORY_SCOPE_AGENT);
            const bool endc = (k == PC - 1); const int tn = endc ? nbase : t + 1; const bool more = tn < NT; TrTile nx = cur; if (more) { nx = desc(P0_T0 + tn); tr_issue(nx, vb, F.tid); }
            if (endc && F.tid == 0) slot[0] = pend;
            tr_finish(cur, va, F.lds, buf, F.tid); buf ^= 1;
            if (endc) nbase = slot[0];
            if (!more) break;
#pragma unroll
            for (int i = 0; i < 4; ++i) va[i] = vb[i];
            cur = nx; t = tn; k = endc ? 0 : k + 1; } } }
    __syncthreads();
}

DI void row_load(const float* src, int lane, f32x4 (&v)[8]) {
#pragma unroll
    for (int i = 0; i < 8; ++i) v[i] = *(const f32x4*)(src + i * 256 + lane * 4);
}
DI float row_rs(const f32x4 (&v)[8]) { float ss = 0.f;
#pragma unroll
    for (int i = 0; i < 8; ++i) ss += v[i][0] * v[i][0] + v[i][1] * v[i][1] + v[i][2] * v[i][2] + v[i][3] * v[i][3];
    ss = wave_sum(ss); return rsqrtf(ss * (1.0f / 2048.0f) + EPS); }
DI void row_norm_mod(f32x4 (&v)[8], const float* gain, const float* shift, const float* scale, bf16_t* dst, int lane, bool store = true) {
    const float rs = row_rs(v);
#pragma unroll
    for (int i = 0; i < 8; ++i) { const int c = i * 256 + lane * 4; const f32x4 g = *(const f32x4*)(gain + c), sh = *(const f32x4*)(shift + c), sc = *(const f32x4*)(scale + c);
        v[i] = (v[i] * rs * g) * (sc + 1.0f) + sh;
        u32x2 w; w.x = pk2(v[i][0], v[i][1]); w.y = pk2(v[i][2], v[i][3]); if (store) *(u32x2*)(dst + c) = w; }
}
DI void row_norm_mod8(f32x4 (&v)[8], const float* gain, const float* shift, const float* scale, unsigned char* dst, int lane, bool store) {
    const float rs = row_rs(v);
#pragma unroll
    for (int i = 0; i < 8; ++i) { const int c = i * 256 + lane * 4; const f32x4 g = *(const f32x4*)(gain + c), sh = *(const f32x4*)(shift + c), sc = *(const f32x4*)(scale + c);
        v[i] = (v[i] * rs * g) * (sc + 1.0f) + sh;
        if (store) *(unsigned*)(dst + c) = cvt4_fp8(v[i][0], v[i][1], v[i][2], v[i][3]); }
}
DI const float* stream_row_in(const Params& P, int layer_stream, int b, int t) {
    if (layer_stream == 0) return t < LCTX ? P.in[I_CTX] + (size_t)(b * LCTX + t) * DM : P.in[I_X] + (size_t)(b * NLAT + t - LCTX) * DM;
    return t < LCTX ? (const float*)WSP(float, WS_CTXW) + (size_t)(b * LCTX + t) * DM : (const float*)P.out + (size_t)(b * NLAT + t - LCTX) * DM;
}
DI float* stream_row_out(const Params& P, int b, int t) { return t < LCTX ? WSP(float, WS_CTXW) + (size_t)(b * LCTX + t) * DM : P.out + (size_t)(b * NLAT + t - LCTX) * DM; }

DI void p1_hall0(const Params& P, const Frame& F) {
    const float* modv = WSP(float, WS_MODV);
    for (int r = F.bid * 8 + F.wave; r < RR; r += F.G * 8) { const int b = r / TT, t = r % TT, mi = t < LCTX ? 2 : b;
        f32x4 v[8]; row_load(stream_row_in(P, 0, b, t), F.lane, v);
        const float* m = modv + (size_t)(0 * 3 + mi) * 12288;
        row_norm_mod(v, P.in[I_NORMG] + (0 * 4 + 0) * DM, m, m + DM, WSP(bf16_t, WS_HA) + (size_t)r * DM, F.lane); }
}
DI void hg_load8(const bf16_t* p, float (&o)[8]) { const u32x4 w = *(const u32x4*)p; o[0] = bflo(w.x); o[1] = bfhi(w.x); o[2] = bflo(w.y); o[3] = bfhi(w.y); o[4] = bflo(w.z); o[5] = bfhi(w.z); o[6] = bflo(w.w); o[7] = bfhi(w.w); }
DI bf16x8 tr_frag(const LAS bf16_t* base, int ld, int k0, int n0, int lane) { const int g = lane >> 4, qq = (lane & 15) >> 2, pp = lane & 3; const LAS bf16_t* p = base + (k0 + 8 * g + qq) * ld + n0 + 4 * pp;
    const s16x4 a = __builtin_amdgcn_ds_read_tr16_b64_v4i16((LAS s16x4*)p), b = __builtin_amdgcn_ds_read_tr16_b64_v4i16((LAS s16x4*)(p + 4 * ld));
    return (bf16x8){a[0], a[1], a[2], a[3], b[0], b[1], b[2], b[3]}; }
DI void cv8(const u32x4& w, float (&o)[8]) { o[0] = bflo(w.x); o[1] = bfhi(w.x); o[2] = bflo(w.y); o[3] = bfhi(w.y); o[4] = bflo(w.z); o[5] = bfhi(w.z); o[6] = bflo(w.w); o[7] = bfhi(w.w); }
DI void hga_item(const Params& P, const Frame& F, int item) {
    const int c = item % NCHUNK, bh = item / NCHUNK, h = bh % HGH, b = bh / HGH, tid = F.tid;
    const bf16_t* P0 = WSP(bf16_t, WS_P0) + (size_t)(b * TT + c * 64) * EVIN + h * 128;
    const float* LB = WSP(float, WS_LB);
    LAS float* LF = (LAS float*)F.lds;
    LAS bf16_t* KL = (LAS bf16_t*)(F.lds + 65536);
    LAS bf16_t* VL = (LAS bf16_t*)(F.lds + 100352);
    LAS float* SEG = (LAS float*)(F.lds + 117760);
    LAS bf16_t* OUT = (LAS bf16_t*)F.lds;
    LAS unsigned char* IMG0 = F.lds + 119808; LAS unsigned char* IMG1 = IMG0 + 9216;
    const TrTile tA = tr_moe_desc(P, 0, 2 * item, WSP(bf16_t, WS_WGU), WSP(bf16_t, WS_WDN)), tB = tr_moe_desc(P, 0, 2 * item + 1, WSP(bf16_t, WS_WGU), WSP(bf16_t, WS_WDN));
    f32x4 wa[4], wb[4]; t4_issue(tA, wa, tid); t4_issue(tB, wb, tid);
#pragma unroll
    for (int i = 0; i < 2; ++i) { const int idx = tid + 512 * i, tok = idx >> 4, k0 = (idx & 15) * 8; float x[8];
#pragma unroll
        for (int dir = 0; dir < 2; ++dir) { hg_load8(P0 + (size_t)tok * EVIN + 1024 * (1 + dir) + k0, x); float kk[8];
#pragma unroll
            for (int j = 0; j < 8; ++j) { const float lb = LB[dir * 1024 + h * 128 + k0 + j], f = lb + (1.0f - lb) * sigmoidf_(x[j]); LF[(dir * 64 + tok) * 128 + k0 + j] = __logf(f); kk[j] = 1.0f - f; }
            *(LAS u32x4*)(KL + (dir * 64 + tok) * 136 + k0) = (u32x4){pk2(kk[0], kk[1]), pk2(kk[2], kk[3]), pk2(kk[4], kk[5]), pk2(kk[6], kk[7])}; }
        *(LAS u32x4*)(VL + tok * 136 + k0) = *(const u32x4*)(P0 + (size_t)tok * EVIN + 3072 + k0); }
    __syncthreads();
    const int sdir = tid >> 8, sseg = (tid >> 7) & 1, skd = tid & 127;
    { float tot = 0.f;
#pragma unroll 8
      for (int s = 0; s < 32; ++s) { const int ss = sseg * 32 + s, t = sdir ? 63 - ss : ss; tot += LF[(sdir * 64 + t) * 128 + skd]; }
      SEG[(sdir * 2 + sseg) * 128 + skd] = tot; }
    t4_lds(tA, wa, IMG0, tid);
    __syncthreads();
    t4_store(tA, IMG0, tid);
    { const float s0 = SEG[(sdir * 2 + 0) * 128 + skd], s1 = SEG[(sdir * 2 + 1) * 128 + skd], tot = s0 + s1; float run = sseg ? s0 : 0.f;
#pragma unroll 8
      for (int s = 0; s < 32; ++s) { const int ss = sseg * 32 + s, t = sdir ? 63 - ss : ss; run += LF[(sdir * 64 + t) * 128 + skd];
          const float kk = bf2f(KL[(sdir * 64 + t) * 136 + skd]); KL[(sdir * 64 + t) * 136 + skd] = f2bf(kk * __expf(tot - run));
          if (ss == 31) WSP(float, WS_REFX)[(size_t)((bh * 2 + sdir) * NCHUNK + c) * 128 + skd] = __expf(run); }
      if (sseg == 0) WSP(float, WS_DEC)[(size_t)((bh * 2 + sdir) * NCHUNK + c) * 128 + skd] = __expf(tot); }
    t4_lds(tB, wb, IMG1, tid);
    const TrTile tC = tr_moe_desc(P, 1, L1Q_END + item, WSP(bf16_t, WS_WGU1), WSP(bf16_t, WS_WDN1)); t4_issue(tC, wa, tid);
    __syncthreads();
    t4_store(tB, IMG1, tid);
    {
        const int w = F.wave, lane = F.lane, l15 = lane & 15, q = lane >> 4;
        const bf16x8 a0 = tr_frag(VL, 136, 0, 16 * w, lane), a1 = tr_frag(VL, 136, 32, 16 * w, lane);
#pragma unroll 1
        for (int dir = 0; dir < 2; ++dir) {
#pragma unroll 2
            for (int nt = 0; nt < 8; ++nt) { f32x4 acc = {0, 0, 0, 0};
                acc = mfma16(tr_frag(KL + dir * 64 * 136, 136, 0, 16 * nt, lane), a0, acc); acc = mfma16(tr_frag(KL + dir * 64 * 136, 136, 32, 16 * nt, lane), a1, acc);
                *(LAS u32x2*)(OUT + (16 * w + l15) * 136 + 16 * nt + 4 * q) = (u32x2){pk2(acc[0], acc[1]), pk2(acc[2], acc[3])}; }
            bf16_t* dst = WSP(bf16_t, WS_KVT) + (size_t)((bh * 2 + dir) * NCHUNK + c) * 16384;
#pragma unroll
            for (int i = 0; i < 4; ++i) { const int idx = lane + 64 * i, row = 16 * w + (idx >> 4), ch = idx & 15;
                *(u32x4*)(dst + row * 128 + ch * 8) = *(const LAS u32x4*)(OUT + row * 136 + ch * 8); }
        }
    }
    t4_lds(tC, wa, IMG0, tid);
    __syncthreads();
    t4_store(tC, IMG0, tid);
}
DI bf16x8 s5_ufrag(const bf16_t* P0, int g, int mt, int ks, int lane) { const int cr = 16 * mt + (lane & 15), q = lane >> 4;
    return *(const bf16x8*)(P0 + (size_t)(cr * 16 + 2 * ks + (q >> 1)) * EVIN + 5120 + g * 16 + 8 * (q & 1)); }
constexpr int S5_NPART = 9, S5_NTASK = S5G * S5_NPART;
DI void s5xl_group(const Params& P, const Frame& F, int gtask) {
    const int g = gtask / S5_NPART, part = gtask % S5_NPART;
    LAS bf16_t* WXf = (LAS bf16_t*)F.lds;
    const bf16_t* P0 = WSP(bf16_t, WS_P0); const bf16_t* WX = WSP(bf16_t, WS_S5WX) + (size_t)g * 65536; float* XL = WSP(float, WS_XL);
    const int lane = F.lane, l15 = lane & 15, q = lane >> 4;
    const int mt = part < 8 ? 8 * part + F.wave : 64 + (F.wave >> 2), nt_lo = part < 8 ? 0 : 4 * (F.wave & 3), nt_n = part < 8 ? 16 : 4;
    bf16x8 a[8];
#pragma unroll
    for (int ks = 0; ks < 8; ++ks) a[ks] = s5_ufrag(P0, g, mt, ks, lane);
    __syncthreads();
#pragma unroll
    for (int hh = 0; hh < 2; ++hh) { u32x4 w[8];
#pragma unroll
        for (int i = 0; i < 8; ++i) { const int idx = F.tid + 512 * (8 * hh + i), row = idx >> 5, ch = idx & 31; w[i] = *(const u32x4*)(WX + (size_t)row * 256 + ch * 8); }
#pragma unroll
        for (int i = 0; i < 8; ++i) { const int idx = F.tid + 512 * (8 * hh + i), row = idx >> 5, ch = idx & 31; *(LAS u32x4*)(WXf + row * 264 + ch * 8) = w[i]; } }
    __syncthreads();
#pragma unroll 2
    for (int k = 0; k < nt_n; ++k) { const int nt = nt_lo + k; f32x4 acc = {0, 0, 0, 0};
#pragma unroll
        for (int ks = 0; ks < 8; ++ks) acc = mfma16(lds_frag(WXf, 264, 16 * nt, 32 * ks, lane), a[ks], acc);
        { const int cr = 16 * mt + l15, b = cr / S5NCH, n = cr % S5NCH;
          *(f32x4*)(XL + ((size_t)(b * 64 + g) * S5NCH + n) * 256 + 16 * nt + 4 * q) = acc; } }
    __syncthreads();
}
#define BLK_QUEUE_LOOP(ctr, ntask, body) do { volatile LAS int* slot_ = (volatile LAS int*)(F.lds + LDS_MISC - 16); \
    if (F.tid == 0) *slot_ = (int)__hip_atomic_fetch_add((ctr), 1u, __ATOMIC_RELAXED, __HIP_MEMORY_SCOPE_AGENT); __syncthreads(); \
    for (;;) { const int task = *slot_; if (task >= (ntask)) break; int nxt_ = 0; if (F.tid == 0) nxt_ = (int)__hip_atomic_fetch_add((ctr), 1u, __ATOMIC_RELAXED, __HIP_MEMORY_SCOPE_AGENT); \
        body; if (F.tid == 0) *slot_ = nxt_; __syncthreads(); } } while (0)
DI void e2a(const Params& P, const Frame& F, int rep) {
    BLK_QUEUE_LOOP(WSP(unsigned, WS_CTL) + 128 + rep, S5_NTASK + NB * HGH * NCHUNK, { if (task < S5_NTASK) s5xl_group(P, F, task); else hga_item(P, F, task - S5_NTASK); });
}
DI void e2b(const Params& P, const Frame& F) {
    for (int t = F.bid; t < 256; t += F.G) { const int b = t >> 7, g = (t >> 1) & 63, dir = t & 1, p = F.lane, w = F.wave;
        const float* a16 = WSP(float, WS_S5A16) + (size_t)((dir * 64 + g) * 64 + p) * 2; const float ar = a16[0], ai = a16[1];
        const float* XL = WSP(float, WS_XL) + (size_t)(b * 64 + g) * S5NCH * 256 + dir * 128 + p; bf16_t* X0 = WSP(bf16_t, WS_X0) + (size_t)(b * 64 + g) * S5NCH * 256 + dir * 128 + p;
        LAS float* CAR = (LAS float*)F.lds;
        constexpr int SEG = S5NCH / 8;
        float xr = 0.f, xi = 0.f;
#pragma unroll 1
        for (int s0 = w * SEG; s0 < (w + 1) * SEG; s0 += 22) { float lr[22], li[22];
#pragma unroll
            for (int u = 0; u < 22; ++u) { const int sq = s0 + u, nn = dir == 0 ? sq : (sq < S5NCTX ? S5NCTX - 1 - sq : S5NCH + S5NCTX - 1 - sq); lr[u] = XL[(size_t)nn * 256]; li[u] = XL[(size_t)nn * 256 + 64]; }
#pragma unroll
            for (int u = 0; u < 22; ++u) { const float nr = ar * xr - ai * xi + lr[u], ni = ar * xi + ai * xr + li[u]; xr = nr; xi = ni; } }
        CAR[(w * 64 + p) * 2] = xr; CAR[(w * 64 + p) * 2 + 1] = xi;
        float pr = 1.f, pi = 0.f;
#pragma unroll 1
        for (int k = 0; k < SEG; ++k) { const float nr = pr * ar - pi * ai, ni = pr * ai + pi * ar; pr = nr; pi = ni; }
        __syncthreads();
        xr = 0.f; xi = 0.f;
        for (int k = 0; k < w; ++k) { const float er = CAR[(k * 64 + p) * 2], ei = CAR[(k * 64 + p) * 2 + 1]; const float nr = pr * xr - pi * xi + er, ni = pr * xi + pi * xr + ei; xr = nr; xi = ni; }
#pragma unroll 1
        for (int s0 = w * SEG; s0 < (w + 1) * SEG; s0 += 22) { float lr[22], li[22]; int nn[22];
#pragma unroll
            for (int u = 0; u < 22; ++u) { const int sq = s0 + u; nn[u] = dir == 0 ? sq : (sq < S5NCTX ? S5NCTX - 1 - sq : S5NCH + S5NCTX - 1 - sq); lr[u] = XL[(size_t)nn[u] * 256]; li[u] = XL[(size_t)nn[u] * 256 + 64]; }
#pragma unroll
            for (int u = 0; u < 22; ++u) { X0[(size_t)nn[u] * 256] = f2bf(xr); X0[(size_t)nn[u] * 256 + 64] = f2bf(xi);
                const float nr = ar * xr - ai * xi + lr[u], ni = ar * xi + ai * xr + li[u]; xr = nr; xi = ni; } }
        __syncthreads();
    }
    for (int u = F.bid; u < 256; u += F.G) { const int chain = u >> 3, part = u & 7, dir = chain & 1, e = (part * 512 + F.tid) * 4, kd = e & 127;
        const bf16_t* KVT = WSP(bf16_t, WS_KVT) + (size_t)chain * NCHUNK * 16384 + e; bf16_t* SST = WSP(bf16_t, WS_SST) + (size_t)chain * NCHUNK * 16384 + e;
        const float* DEC = WSP(float, WS_DEC) + (size_t)chain * NCHUNK * 128 + kd; const float* RFX = WSP(float, WS_REFX) + (size_t)chain * NCHUNK * 128 + kd;
        f32x4 s = {0, 0, 0, 0};
        for (int n0 = 0; n0 < NCHUNK; n0 += 12) { u32x2 kv[12]; f32x4 d[12], rx[12]; int cc[12];
#pragma unroll
            for (int k = 0; k < 12; ++k) { const int n = n0 + k; cc[k] = dir ? (n < 4 ? 3 - n : NCHUNK + 3 - n) : n; kv[k] = *(const u32x2*)(KVT + (size_t)cc[k] * 16384); d[k] = *(const f32x4*)(DEC + (size_t)cc[k] * 128); rx[k] = *(const f32x4*)(RFX + (size_t)cc[k] * 128); }
#pragma unroll
            for (int k = 0; k < 12; ++k) { u32x2 w; w.x = pk2(s[0] * rx[k][0], s[1] * rx[k][1]); w.y = pk2(s[2] * rx[k][2], s[3] * rx[k][3]); *(u32x2*)(SST + (size_t)cc[k] * 16384) = w;
                s[0] = s[0] * d[k][0] + bflo(kv[k].x); s[1] = s[1] * d[k][1] + bfhi(kv[k].x); s[2] = s[2] * d[k][2] + bflo(kv[k].y); s[3] = s[3] * d[k][3] + bfhi(kv[k].y); } }
    }
}
DI void hgc_item(const Params& P, const Frame& F, int item) {
    const int c = item % NCHUNK, bh = item / NCHUNK, h = bh % HGH, b = bh / HGH, tid = F.tid, lane = F.lane, l15 = lane & 15, q = lane >> 4, w = F.wave;
    const size_t r0 = (size_t)(b * TT + c * 64);
    const bf16_t* P0 = WSP(bf16_t, WS_P0) + r0 * EVIN + h * 128;
    const float* LB = WSP(float, WS_LB);
    LAS float* BF = (LAS float*)F.lds;
    LAS bf16_t* QH = (LAS bf16_t*)(F.lds + 32768);
    LAS bf16_t* KH = (LAS bf16_t*)(F.lds + 50176);
    LAS bf16_t* VL = (LAS bf16_t*)(F.lds + 67584);
    LAS bf16_t* ST = (LAS bf16_t*)(F.lds + 84992);
    LAS bf16_t* ATT = (LAS bf16_t*)(F.lds + 119808);
    LAS float* REFV = (LAS float*)(F.lds + 129024);
    LAS float* SEG = (LAS float*)(F.lds + 129536);
    LAS float* OST = (LAS float*)F.lds;
#pragma unroll
    for (int i = 0; i < 2; ++i) { const int idx = tid + 512 * i, tok = idx >> 4, k0 = (idx & 15) * 8; *(LAS u32x4*)(VL + tok * 136 + k0) = *(const u32x4*)(P0 + (size_t)tok * EVIN + 3072 + k0); }
    const int mt = w >> 1, sseg = tid >> 7, skd = tid & 127;
    u32x4 pq[2], pf[2][2], pg[2];
#pragma unroll
    for (int i = 0; i < 2; ++i) { const int idx = tid + 512 * i, tok = idx >> 4, k0 = (idx & 15) * 8; const bf16_t* rp = P0 + (size_t)tok * EVIN + k0;
        pf[0][i] = *(const u32x4*)(rp + 1024); pf[1][i] = *(const u32x4*)(rp + 2048); pq[i] = *(const u32x4*)rp; }
    { const int t = tid >> 3, v0 = (tid & 7) * 16; pg[0] = *(const u32x4*)(P0 + (size_t)t * EVIN + 4096 + v0); pg[1] = *(const u32x4*)(P0 + (size_t)t * EVIN + 4096 + v0 + 8); }
    f32x4 lbv[2][2], gnv[4];
    { const int k0 = (tid & 15) * 8, v0 = (tid & 7) * 16;
#pragma unroll
      for (int d = 0; d < 2; ++d) { lbv[d][0] = *(const f32x4*)(LB + d * 1024 + h * 128 + k0); lbv[d][1] = *(const f32x4*)(LB + d * 1024 + h * 128 + k0 + 4); }
#pragma unroll
      for (int i = 0; i < 4; ++i) gnv[i] = *(const f32x4*)(P.in[I_HGNG] + v0 + 4 * i); }
    LAS unsigned char* IMG = F.lds + 131584; f32x4 wt[4]; const int tile0 = 4224 + 4 * item; const bool host = tile0 + 3 < 12288;
    TrTile tcur = tr_moe_desc(P, 0, host ? tile0 : 0, WSP(bf16_t, WS_WGU), WSP(bf16_t, WS_WDN)); if (host) t4_issue(tcur, wt, tid);
    f32x4 oacc[4]; for (int i = 0; i < 4; ++i) oacc[i] = (f32x4){0, 0, 0, 0};
#pragma unroll
    for (int dir = 0; dir < 2; ++dir) {
#pragma unroll
        for (int i = 0; i < 2; ++i) { const int idx = tid + 512 * i, tok = idx >> 4, k0 = (idx & 15) * 8; float x[8], kk[8]; cv8(pf[dir][i], x);
#pragma unroll
            for (int j = 0; j < 8; ++j) { const float lb = lbv[dir][j >> 2][j & 3], f = lb + (1.0f - lb) * sigmoidf_(x[j]); BF[tok * 128 + k0 + j] = __logf(f); kk[j] = 1.0f - f; }
            *(LAS u32x4*)(KH + tok * 136 + k0) = (u32x4){pk2(kk[0], kk[1]), pk2(kk[2], kk[3]), pk2(kk[4], kk[5]), pk2(kk[6], kk[7])}; }
        u32x4 stv[4];
        { asm volatile("" ::: "memory"); const bf16_t* SS = WSP(bf16_t, WS_SST) + (size_t)((bh * 2 + dir) * NCHUNK + c) * 16384;
#pragma unroll
          for (int i = 0; i < 4; ++i) { const int idx = tid + 512 * i; stv[i] = *(const u32x4*)(SS + (idx >> 4) * 128 + (idx & 15) * 8); } }
        __syncthreads();
        { float tot = 0.f;
#pragma unroll
          for (int s = 0; s < 16; ++s) { const int ss = sseg * 16 + s, t = dir ? 63 - ss : ss; tot += BF[t * 128 + skd]; }
          SEG[sseg * 128 + skd] = tot; }
        if (host) t4_lds(tcur, wt, IMG, tid);
        __syncthreads();
        if (host) t4_store(tcur, IMG, tid);
        { float run = 0.f;
#pragma unroll
          for (int k = 0; k < 3; ++k) run += (k < sseg) ? SEG[k * 128 + skd] : 0.f;
#pragma unroll
          for (int s = 0; s < 16; ++s) { const int ss = sseg * 16 + s, t = dir ? 63 - ss : ss; run += BF[t * 128 + skd]; BF[t * 128 + skd] = run; if (ss == 31) REFV[skd] = run; } }
#pragma unroll
        for (int i = 0; i < 4; ++i) { const int idx = tid + 512 * i; *(LAS u32x4*)(ST + (idx >> 4) * 136 + (idx & 15) * 8) = stv[i]; }
        if (host) { asm volatile("" ::: "memory"); tcur = tr_moe_desc(P, 0, tile0 + 2 * dir + 1, WSP(bf16_t, WS_WGU), WSP(bf16_t, WS_WDN)); t4_issue(tcur, wt, tid); }
        __syncthreads();
#pragma unroll
        for (int i = 0; i < 2; ++i) { const int idx = tid + 512 * i, tok = idx >> 4, k0 = (idx & 15) * 8; float xq[8], xk[8];
            cv8(pq[i], xq); { const u32x4 kw = *(const LAS u32x4*)(KH + tok * 136 + k0); xk[0] = bflo(kw.x); xk[1] = bfhi(kw.x); xk[2] = bflo(kw.y); xk[3] = bfhi(kw.y); xk[4] = bflo(kw.z); xk[5] = bfhi(kw.z); xk[6] = bflo(kw.w); xk[7] = bfhi(kw.w); }
            unsigned qw[4], kw2[4];
#pragma unroll
            for (int j = 0; j < 8; j += 2) { const float d0 = BF[tok * 128 + k0 + j] - REFV[k0 + j], d1 = BF[tok * 128 + k0 + j + 1] - REFV[k0 + j + 1];
                qw[j >> 1] = pk2(xq[j] * __expf(d0), xq[j + 1] * __expf(d1)); kw2[j >> 1] = pk2(xk[j] * __expf(-d0), xk[j + 1] * __expf(-d1)); }
            *(LAS u32x4*)(QH + tok * 136 + k0) = (u32x4){qw[0], qw[1], qw[2], qw[3]}; *(LAS u32x4*)(KH + tok * 136 + k0) = (u32x4){kw2[0], kw2[1], kw2[2], kw2[3]}; }
        __syncthreads();
#pragma unroll
        for (int tt = 0; tt < 2; ++tt) { const int nt = 2 * (w & 1) + tt; f32x4 acc = {0, 0, 0, 0};
#pragma unroll
            for (int ks = 0; ks < 4; ++ks) acc = mfma16(lds_frag(KH, 136, 16 * nt, 32 * ks, lane), lds_frag(QH, 136, 16 * mt, 32 * ks, lane), acc);
            float av[4];
#pragma unroll
            for (int r = 0; r < 4; ++r) { const int t = 16 * mt + l15, s = 16 * nt + 4 * q + r; const bool keep = dir ? (s >= t) : (s <= t); av[r] = keep ? acc[r] : 0.f; }
            *(LAS u32x2*)(ATT + (16 * mt + l15) * 72 + 16 * nt + 4 * q) = (u32x2){pk2(av[0], av[1]), pk2(av[2], av[3])}; }
        if (host) t4_lds(tcur, wt, IMG, tid);
        __syncthreads();
        if (host) { t4_store(tcur, IMG, tid); if (dir == 0) { tcur = tr_moe_desc(P, 0, tile0 + 2, WSP(bf16_t, WS_WGU), WSP(bf16_t, WS_WDN)); t4_issue(tcur, wt, tid); } }
#pragma unroll
        for (int tt = 0; tt < 4; ++tt) { const int nt = 4 * (w & 1) + tt;
#pragma unroll
            for (int ks = 0; ks < 2; ++ks) oacc[tt] = mfma16(tr_frag(VL, 136, 32 * ks, 16 * nt, lane), lds_frag(ATT, 72, 16 * mt, 32 * ks, lane), oacc[tt]);
#pragma unroll
            for (int ks = 0; ks < 4; ++ks) oacc[tt] = mfma16(lds_frag(ST, 136, 16 * nt, 32 * ks, lane), lds_frag(QH, 136, 16 * mt, 32 * ks, lane), oacc[tt]); }
        __syncthreads();
    }
#pragma unroll
    for (int tt = 0; tt < 4; ++tt) { const int nt = 4 * (w & 1) + tt;
        *(LAS f32x4*)(OST + (16 * mt + l15) * 132 + 16 * nt + 4 * q) = oacc[tt]; }
    __syncthreads();
    {   const int t = tid >> 3, v0 = (tid & 7) * 16; float o[16]; float ss = 0.f;
#pragma unroll
        for (int j = 0; j < 16; ++j) { o[j] = OST[t * 132 + v0 + j]; ss += o[j] * o[j]; }
        ss = row8_sum(ss);
        const float rs = rsqrtf(ss * (1.0f / 128.0f) + EPS);
        float gza[8], gzb[8]; cv8(pg[0], gza); cv8(pg[1], gzb);
        float ov[16];
#pragma unroll
        for (int j = 0; j < 16; ++j) { const float gn = gnv[j >> 2][j & 3]; const float z = j < 8 ? gza[j & 7] : gzb[j & 7]; ov[j] = o[j] * rs * gn * siluf_(z); }
        unsigned char* dst = WSP(unsigned char, WS_OCAT0) + (r0 + t) * DM + h * 128 + v0;
        *(u32x4*)dst = (u32x4){cvt4_fp8(ov[0], ov[1], ov[2], ov[3]), cvt4_fp8(ov[4], ov[5], ov[6], ov[7]), cvt4_fp8(ov[8], ov[9], ov[10], ov[11]), cvt4_fp8(ov[12], ov[13], ov[14], ov[15])}; }
    __syncthreads();
}
DI void s5y_group(const Params& P, const Frame& F, int gtask) {
    const int g = gtask / S5_NPART, part = gtask % S5_NPART;
    LAS bf16_t* WYh = (LAS bf16_t*)F.lds;
    const bf16_t* P0 = WSP(bf16_t, WS_P0); const bf16_t* WY = WSP(bf16_t, WS_S5WY) + (size_t)g * 256 * 512; const bf16_t* X0 = WSP(bf16_t, WS_X0);
    const int lane = F.lane, l15 = lane & 15, q = lane >> 4;
    const int mt = part < 8 ? 8 * part + F.wave : 64 + (F.wave >> 2), nt_lo = part < 8 ? 0 : 2 * (F.wave & 3), nt_n = part < 8 ? 8 : 2;
    bf16x8 gwa; { float t[4];
#pragma unroll
      for (int j = 0; j < 4; ++j) t[j] = P.in[I_S5GLUW][(g * 16 + 4 * q + j) * 16 + l15];
      gwa = __builtin_bit_cast(bf16x8, (u32x4){pk2(t[0], t[1]), pk2(t[2], t[3]), 0u, 0u}); }
    const f32x4 gbv = *(const f32x4*)(P.in[I_S5GLUB] + g * 16 + 4 * q);
    bf16x8 a[16];
#pragma unroll
    for (int ks = 0; ks < 8; ++ks) a[ks] = s5_ufrag(P0, g, mt, ks, lane);
    { const int cr = 16 * mt + l15, b = cr / S5NCH, n = cr % S5NCH; const bf16_t* xp = X0 + ((size_t)(b * 64 + g) * S5NCH + n) * 256 + 8 * q;
#pragma unroll
      for (int ks = 0; ks < 8; ++ks) a[8 + ks] = *(const bf16x8*)(xp + 32 * ks); }
    for (int nh = 0; nh < 2; ++nh) {
        __syncthreads();
#pragma unroll
        for (int hh = 0; hh < 2; ++hh) { u32x4 w[8];
#pragma unroll
            for (int i = 0; i < 8; ++i) { const int idx = F.tid + 512 * (8 * hh + i), row = idx >> 6, ch = idx & 63; w[i] = *(const u32x4*)(WY + (size_t)(nh * 128 + row) * 512 + ch * 8); }
#pragma unroll
            for (int i = 0; i < 8; ++i) { const int idx = F.tid + 512 * (8 * hh + i), row = idx >> 6, ch = idx & 63; *(LAS u32x4*)(WYh + row * 520 + ch * 8) = w[i]; } }
        __syncthreads();
#pragma unroll 1
        for (int k = 0; k < nt_n; ++k) { const int nt = nt_lo + k; f32x4 acc = {0, 0, 0, 0};
#pragma unroll
            for (int ks = 0; ks < 16; ++ks) acc = mfma16(lds_frag(WYh, 520, 16 * nt, 32 * ks, lane), a[ks], acc);
            float y[4];
#pragma unroll
            for (int r = 0; r < 4; ++r) { const float x = acc[r], u = 0.7978845608f * (x + 0.044715f * x * x * x); y[r] = 0.5f * x * (2.0f - 2.0f * rcpf_(1.0f + __expf(2.0f * u))); }
            const bf16x8 yb = __builtin_bit_cast(bf16x8, (u32x4){pk2(y[0], y[1]), pk2(y[2], y[3]), 0u, 0u});
            const f32x4 z = mfma16(gwa, yb, gbv);
            const int j = 8 * nh + nt, cr = 16 * mt + l15;
            float ov[4];
#pragma unroll
            for (int r = 0; r < 4; ++r) { ov[r] = y[r] * sigmoidf_(z[r]);
#ifdef MK_DBG_NO_S5
                ov[r] = 0.f;
#endif
            }
            *(unsigned*)(WSP(unsigned char, WS_OCAT0) + (size_t)(cr * 16 + j) * DM + 1024 + g * 16 + 4 * q) = cvt4_fp8(ov[0], ov[1], ov[2], ov[3]);
        }
    }
    __syncthreads();
}
DI void e2c(const Params& P, const Frame& F, int rep) {
    BLK_QUEUE_LOOP(WSP(unsigned, WS_CTL) + 192 + rep, S5_NTASK + NB * HGH * NCHUNK, { if (task < S5_NTASK) s5y_group(P, F, task); else hgc_item(P, F, task - S5_NTASK); });
}
DI void row_post_mixer(const Params& P, const Frame& F, int layer) {
    LAS float* RWT = (LAS float*)F.lds;
    { const float* rw = P.in[I_ROUTER] + (size_t)layer * DM * NEXP; f32x4 rv[16];
#pragma unroll
      for (int j = 0; j < 16; ++j) rv[j] = *(const f32x4*)(rw + (size_t)(F.tid + 512 * j) * 4);
#pragma unroll
      for (int j = 0; j < 16; ++j) { const int i4 = F.tid + 512 * j, k = i4 >> 2, e0 = (i4 & 3) * 4;
#pragma unroll
          for (int jj = 0; jj < 4; ++jj) RWT[(e0 + jj) * DM + k] = rv[j][jj]; } }
    __syncthreads();
    const float* modv = WSP(float, WS_MODV); const float* ng = P.in[I_NORMG] + (size_t)layer * 4 * DM;
    const int nrows = layer == 0 ? RR : NB * NLAT, lane = F.lane, stride = F.G * 8;
    for (int rr0 = F.bid * 8 + F.wave; rr0 < nrows; rr0 += 2 * stride) {
        int b[2], t[2]; bool ok[2]; f32x4 v[2][8], x[2][8]; const float* m[2]; float* xo[2];
#pragma unroll
        for (int u = 0; u < 2; ++u) { int rr = rr0 + u * stride; ok[u] = rr < nrows; if (!ok[u]) rr = rr0;
            const bf16_t* mix;
            if (layer == 0) { b[u] = rr / TT; t[u] = rr % TT; mix = WSP(bf16_t, WS_MIX) + (size_t)rr * DM; } else { b[u] = rr / NLAT; t[u] = LCTX + rr % NLAT; mix = WSP(bf16_t, WS_MIX1) + (size_t)rr * DM; }
            const int mi = t[u] < LCTX ? 2 : b[u]; m[u] = modv + (size_t)(layer * 3 + mi) * 12288; xo[u] = stream_row_out(P, b[u], t[u]);
#pragma unroll
            for (int i = 0; i < 8; ++i) { const u32x2 w2 = *(const u32x2*)(mix + i * 256 + lane * 4); v[u][i] = (f32x4){bflo(w2.x), bfhi(w2.x), bflo(w2.y), bfhi(w2.y)}; }
            row_load(stream_row_in(P, layer, b[u], t[u]), lane, x[u]); }
#pragma unroll
        for (int u = 0; u < 2; ++u) { const float rs = row_rs(v[u]);
#pragma unroll
            for (int i = 0; i < 8; ++i) { const int c = i * 256 + lane * 4; const f32x4 g = *(const f32x4*)(ng + 1 * DM + c), m2 = *(const f32x4*)(m[u] + 2 * DM + c);
#ifndef MK_DBG_NOUPD
                x[u][i] = x[u][i] + m2 * (v[u][i] * rs * g);
#endif
                if (ok[u]) *(f32x4*)(xo[u] + c) = x[u][i]; }
            row_norm_mod8(x[u], ng + 2 * DM, m[u] + 3 * DM, m[u] + 4 * DM, WSP(unsigned char, WS_HA8) + (size_t)(b[u] * TT + t[u]) * DM, lane, ok[u]); }
        float pa[2][16];
#pragma unroll
        for (int e = 0; e < 16; ++e) { f32x2 s0 = {0.f, 0.f}, s1 = {0.f, 0.f};
#pragma unroll
            for (int i = 0; i < 8; ++i) { const f32x4 w = *(const LAS f32x4*)(RWT + e * DM + i * 256 + lane * 4); const f32x2 wl = {w[0], w[1]}, wh = {w[2], w[3]};
                s0 += wl * (f32x2){x[0][i][0], x[0][i][1]}; s0 += wh * (f32x2){x[0][i][2], x[0][i][3]}; s1 += wl * (f32x2){x[1][i][0], x[1][i][1]}; s1 += wh * (f32x2){x[1][i][2], x[1][i][3]}; }
            pa[0][e] = s0[0] + s0[1]; pa[1][e] = s1[0] + s1[1]; asm volatile("" ::: "memory"); }
        float mine[2];
#pragma unroll
        for (int u = 0; u < 2; ++u) {
#pragma unroll
            for (int j = 0; j < 8; ++j) { const bool hi = lane & 1; const float keep = hi ? pa[u][2 * j + 1] : pa[u][2 * j], send = hi ? pa[u][2 * j] : pa[u][2 * j + 1]; pa[u][j] = keep + xor1f(send); }
#pragma unroll
            for (int j = 0; j < 4; ++j) { const bool hi = lane & 2; const float keep = hi ? pa[u][2 * j + 1] : pa[u][2 * j], send = hi ? pa[u][2 * j] : pa[u][2 * j + 1]; pa[u][j] = keep + xor2f(send); }
#pragma unroll
            for (int j = 0; j < 2; ++j) { const bool hi = lane & 4; const float keep = hi ? pa[u][2 * j + 1] : pa[u][2 * j], send = hi ? pa[u][2 * j] : pa[u][2 * j + 1]; pa[u][j] = keep + __shfl_xor(send, 4); }
            { const bool hi = lane & 8; const float keep = hi ? pa[u][1] : pa[u][0], send = hi ? pa[u][0] : pa[u][1]; float v = keep + __shfl_xor(send, 8); v += __shfl_xor(v, 16); v += __shfl_xor(v, 32); mine[u] = v; } }
#pragma unroll
        for (int u = 0; u < 2; ++u) { float mx = mine[u];
            mx = row16_max(mx);
            const float ex = __expf(mine[u] - mx); float den = ex;
            den = row16_sum(den);
            if (lane < 16 && ok[u]) { const float a = ex * rcpf_(den);
                if (t[u] < LCTX) WSP(float, WS_AFFC)[(size_t)(b[u] * 16 + lane) * LCTX + t[u]] = a; else WSP(float, WS_AFF)[(size_t)(b[u] * 16 + lane) * NLAT + (t[u] - LCTX)] = a; } }
    }
}
DI void topk_task(const Params& P, const Frame& F, const float* vals, int n, int K, int srow0  , int e, int stack0  ) {
    LAS unsigned* keys = (LAS unsigned*)F.lds;
    LAS unsigned* hist = (LAS unsigned*)(F.lds + 32768);
    LAS unsigned* wsum = (LAS unsigned*)(F.lds + 32768 + 1024);
    LAS unsigned* sel = (LAS unsigned*)(F.lds + 32768 + 1024 + 64);
    LAS int* srcl = (LAS int*)(F.lds + 36864);
    const int tid = F.tid;
    for (int i = tid; i < n; i += 512) keys[i] = __float_as_uint(vals[i]);
    if (tid == 0) { sel[0] = 0u; sel[1] = (unsigned)K; }
    unsigned mask = 0u;
#pragma unroll 1
    for (int shift = 24; shift >= 0; shift -= 8) {
        if (tid < 256) hist[tid] = 0u;
        __syncthreads();
        const unsigned prefix = sel[0];
        for (int i = tid; i < n; i += 512) { const unsigned k = keys[i]; if ((k & mask) == prefix) (void)__hip_atomic_fetch_add(&hist[(k >> shift) & 255u], 1u, __ATOMIC_RELAXED, __HIP_MEMORY_SCOPE_WORKGROUP); }
        __syncthreads();
        if (F.wave == 0) {
            const unsigned kk = sel[1]; const int l = F.lane; unsigned c[4];
#pragma unroll
            for (int j = 0; j < 4; ++j) c[j] = hist[255 - 4 * l - j];
            const unsigned mysum = (c[0] + c[1]) + (c[2] + c[3]); unsigned incl = mysum;
#pragma unroll
            for (int o = 1; o < 64; o <<= 1) { const unsigned v = __shfl_up(incl, o); if (l >= o) incl += v; }
            const unsigned long long bal = __ballot(incl >= kk); const int first = bal ? __builtin_ctzll(bal) : 63;
            if (l == first) { unsigned cum = incl - mysum; int j = 0;
#pragma unroll
                for (; j < 3; ++j) { if (cum + c[j] >= kk) break; cum += c[j]; }
                sel[0] = prefix | ((unsigned)(255 - 4 * l - j) << shift); sel[1] = kk - cum; } }
        mask |= 255u << shift;
        __syncthreads();
    }
    const unsigned thr = sel[0], need_eq = sel[1], total_gt = (unsigned)K - need_eq;
    const int per = (n + 511) / 512, i0 = tid * per;
    unsigned cnt = 0u;
    for (int j = 0; j < per; ++j) { const int i = i0 + j; if (i < n) { const unsigned k = keys[i]; cnt += (k > thr ? 1u : 0u) + (k == thr ? 65536u : 0u); } }
    unsigned inc = cnt;
#pragma unroll
    for (int o = 1; o < 64; o <<= 1) { const unsigned v = __shfl_up(inc, o); if (F.lane >= o) inc += v; }
    if (F.lane == 63) wsum[F.wave] = inc;
    __syncthreads();
    unsigned base = 0u;
    for (int w = 0; w < F.wave; ++w) base += wsum[w];
    unsigned run = base + inc - cnt;
    unsigned rgt = run & 0xffffu, req = run >> 16;
    float* gatev = WSP(float, WS_GATEV); int* idxo = WSP(int, WS_IDX); int* slot = WSP(int, WS_SLOT);
    for (int j = 0; j < per; ++j) { const int i = i0 + j; if (i < n) { const unsigned k = keys[i]; int s = -1;
        if (k > thr) { s = (int)rgt; ++rgt; } else if (k == thr) { if (req < need_eq) s = (int)(total_gt + req); ++req; }
        slot[(size_t)(srow0 + i) * 16 + e] = s;
        if (s >= 0) { gatev[stack0 + s] = __uint_as_float(k); idxo[stack0 + s] = srow0 + i; srcl[s] = srow0 + i; } } }
    __syncthreads();
    {
        unsigned* vt = WSP(unsigned, WS_VOFF); const int tile0 = stack0 >> 8, row00 = stack0 & 255, ntile = (K + 255) >> 8;
        for (int tl = 0; tl < ntile; ++tl)
#pragma unroll
            for (int hi = 0; hi < 4; ++hi) { int R, C; pg8::stage_rc(tid * 16 + (hi & 1) * 8192, R, C); const int row = tl * 256 + (hi >> 1) * 128 + R - row00;
                const bool mine = row >= 0 && row < K, dummy = (K < 256) && row00 == 0 && (row >= 64);
                if (mine || dummy) vt[((size_t)(tile0 + tl) * 512 + tid) * 4 + hi] = (unsigned)((mine ? srcl[row] : 0) * (DM / 2) + C) * 2u; }
    }
    __syncthreads();
}
DI void moe_topk(const Params& P, const Frame& F, int layer) {
    const int ntask = layer == 0 ? 64 : 32;
    for (int task = F.bid; task < ntask; task += F.G) {
        if (task < 32) { const int b = task >> 4, e = task & 15; topk_task(P, F, WSP(float, WS_AFF) + (size_t)task * NLAT, NLAT, CAPL, b * TT + LCTX, e, task * 1024); }
        else { const int t2 = task - 32, b = t2 >> 4, e = t2 & 15; topk_task(P, F, WSP(float, WS_AFFC) + (size_t)t2 * LCTX, LCTX, CAPC, b * TT, e, 32768 + e * 256 + b * 32); }
    }
}
DI void moe_gather(const Params& P, const Frame& F, int layer) {
    const int nrows = 32768 + (layer == 0 ? 1024 : 0); const int* idx = WSP(int, WS_IDX); const bf16_t* HA = WSP(bf16_t, WS_HA); bf16_t* XS = WSP(bf16_t, WS_XS);
    for (int r = F.bid * 8 + F.wave; r < nrows; r += F.G * 8) { int st = r; if (r >= 32768) { const int qq = r - 32768; st = 32768 + (qq >> 6) * 256 + (qq & 63); }
        const int srow = idx[st]; const u32x4* s = (const u32x4*)(HA + (size_t)srow * DM); u32x4* d = (u32x4*)(XS + (size_t)st * DM);
#pragma unroll
        for (int i = 0; i < 4; ++i) d[i * 64 + F.lane] = s[i * 64 + F.lane]; }
}
DI void moe_combine(const Params& P, const Frame& F, int layer) {
    const float* modv = WSP(float, WS_MODV); const float* ng = P.in[I_NORMG] + (size_t)layer * 4 * DM; const int* slot = WSP(int, WS_SLOT); const bf16_t* Y = WSP(bf16_t, WS_Y);
    const int nrows = layer == 0 ? RR : NB * NLAT, lane = F.lane, stride = F.G * 8;
    for (int rr0 = F.bid * 8 + F.wave; rr0 < nrows; rr0 += 2 * stride) {
        int b[2], t[2], r[2]; bool ok[2]; const float* m[2]; f32x4 acc[2][8], x[2][8];
#pragma unroll
        for (int u = 0; u < 2; ++u) { int rr = rr0 + u * stride; ok[u] = rr < nrows; if (!ok[u]) rr = rr0;
            if (layer == 0) { b[u] = rr / TT; t[u] = rr % TT; } else { b[u] = rr / NLAT; t[u] = LCTX + rr % NLAT; }
            r[u] = b[u] * TT + t[u]; const int mi = t[u] < LCTX ? 2 : b[u]; m[u] = modv + (size_t)(layer * 3 + mi) * 12288;
            row_load(stream_row_in(P, 1, b[u], t[u]), lane, x[u]);
#pragma unroll
            for (int i = 0; i < 8; ++i) acc[u][i] = (f32x4){0, 0, 0, 0}; }
        int sl[2][16];
#pragma unroll
        for (int u = 0; u < 2; ++u)
#pragma unroll
            for (int e = 0; e < 16; ++e) sl[u][e] = __builtin_amdgcn_readfirstlane(slot[(size_t)r[u] * 16 + e]);
#pragma unroll
        for (int e = 0; e < 16; ++e)
#pragma unroll
            for (int u = 0; u < 2; ++u) { const int s = sl[u][e];
                if (s >= 0) { const size_t yrow = t[u] >= LCTX ? (size_t)(b[u] * 16 + e) * 1024 + s : (size_t)32768 + e * 256 + b[u] * 32 + s; const bf16_t* yp = Y + yrow * DM + lane * 4;
#pragma unroll
                    for (int i = 0; i < 8; ++i) { const u32x2 w = *(const u32x2*)(yp + i * 256); acc[u][i][0] += bflo(w.x); acc[u][i][1] += bfhi(w.x); acc[u][i][2] += bflo(w.y); acc[u][i][3] += bfhi(w.y); } } }
#pragma unroll
        for (int u = 0; u < 2; ++u) { const float rs = row_rs(acc[u]); float* xo = stream_row_out(P, b[u], t[u]);
#pragma unroll
            for (int i = 0; i < 8; ++i) { const int c = i * 256 + lane * 4; const f32x4 g = *(const f32x4*)(ng + 3 * DM + c), m5 = *(const f32x4*)(m[u] + 5 * DM + c);
                x[u][i] = x[u][i] + m5 * (acc[u][i] * rs * g); if (ok[u]) *(f32x4*)(xo + c) = x[u][i]; }
            if (layer == 0) { const int mi = t[u] < LCTX ? 2 : b[u]; const float* m1 = modv + (size_t)(1 * 3 + mi) * 12288; row_norm_mod(x[u], P.in[I_NORMG] + (size_t)(1 * 4 + 0) * DM, m1, m1 + DM, WSP(bf16_t, WS_HA) + (size_t)r[u] * DM, lane, ok[u]);
                if (ok[u]) { unsigned char* d8 = WSP(unsigned char, WS_HA8B) + (size_t)r[u] * DM;
#pragma unroll
                    for (int i = 0; i < 8; ++i) *(unsigned*)(d8 + i * 256 + lane * 4) = cvt4_fp8(x[u][i][0], x[u][i][1], x[u][i][2], x[u][i][3]); } } }
    }
}
DI void cv_unpack(const u32x4& w, float (&o)[8]) { o[0] = bflo(w.x); o[1] = bfhi(w.x); o[2] = bflo(w.y); o[3] = bfhi(w.y); o[4] = bflo(w.z); o[5] = bfhi(w.z); o[6] = bflo(w.w); o[7] = bfhi(w.w); }
DI void dn_conv_walk(const Params& P, int b, int isctx, int gy, int cg, int xs, int lane) {
    const bf16_t* PQ = WSP(bf16_t, WS_PQ); bf16_t* QC = WSP(bf16_t, WS_QKVC); const float* CW = P.in[I_ODCONV];
    const int ch0 = (cg * 64 + lane) * 8, nx = isctx ? LCTX : 64;
    const size_t rowbase = (size_t)b * TT + (isctx ? 0 : LCTX + gy * 64);
    const bool up = !isctx && gy > 0, dn = !isctx && gy < 127;
    float wgt[9][8];
#pragma unroll
    for (int k = 0; k < 9; ++k) { const f32x4 w0 = *(const f32x4*)(CW + (size_t)k * DNQKV + ch0), w1 = *(const f32x4*)(CW + (size_t)k * DNQKV + ch0 + 4);
#pragma unroll
        for (int j = 0; j < 4; ++j) { wgt[k][j] = w0[j]; wgt[k][4 + j] = w1[j]; } }
#pragma unroll
    for (int kx = 0; kx < 3; ++kx)
#pragma unroll
        for (int j = 0; j < 8; ++j) { if (!up) wgt[kx][j] = 0.f; if (!dn) wgt[6 + kx][j] = 0.f; }
    const u32x4 zero = {0u, 0u, 0u, 0u};
    u32x4 raw[3][3];
    float fc[3][3][8];
#define CV_LOAD(dst, x) do { const int xc = (x) < 0 ? 0 : ((x) >= nx ? nx - 1 : (x)); const bf16_t* pp = PQ + (rowbase + xc) * DNQKV + ch0; \
        dst[0] = *(const u32x4*)(pp - (up ? (size_t)64 * DNQKV : 0)); dst[1] = *(const u32x4*)pp; dst[2] = *(const u32x4*)(pp + (dn ? (size_t)64 * DNQKV : 0)); } while (0)
#define CV_CONV(slot, x) do { cv_unpack(raw[slot][0], fc[slot][0]); cv_unpack(raw[slot][1], fc[slot][1]); cv_unpack(raw[slot][2], fc[slot][2]); \
        if (!((x) >= 0 && (x) < nx)) { _Pragma("unroll") for (int ky_ = 0; ky_ < 3; ++ky_) _Pragma("unroll") for (int e_ = 0; e_ < 8; ++e_) fc[slot][ky_][e_] = 0.f; } } while (0)
    CV_LOAD(raw[0], xs - 1); CV_LOAD(raw[1], xs); CV_LOAD(raw[2], xs + 1);
    CV_CONV(0, xs - 1); CV_CONV(1, xs); CV_CONV(2, xs + 1);
    CV_LOAD(raw[0], xs + 2); CV_LOAD(raw[1], xs + 3); CV_LOAD(raw[2], xs + 4);
#pragma unroll 1
    for (int x0 = xs; x0 < xs + 32; x0 += 3) {
#pragma unroll
        for (int j = 0; j < 3; ++j) { const int x = x0 + j;
            float acc[8];
#pragma unroll
            for (int e = 0; e < 8; e += 2) { f32x2 a2 = (f32x2){fc[j][0][e], fc[j][0][e + 1]} * (f32x2){wgt[0][e], wgt[0][e + 1]};
#pragma unroll
                for (int ky = 0; ky < 3; ++ky)
#pragma unroll
                    for (int kx = 0; kx < 3; ++kx) { if (ky == 0 && kx == 0) continue; const int sl = (j + kx) % 3;
                        a2 = __builtin_elementwise_fma((f32x2){fc[sl][ky][e], fc[sl][ky][e + 1]}, (f32x2){wgt[ky * 3 + kx][e], wgt[ky * 3 + kx][e + 1]}, a2); }
                acc[e] = a2[0]; acc[e + 1] = a2[1]; }
            CV_CONV(j, x + 2);
            CV_LOAD(raw[j], x + 5);
            float ss = 0.f;
#pragma unroll
            for (int e = 0; e < 8; ++e) { acc[e] = siluf_(acc[e]); ss += acc[e] * acc[e]; }
            if (cg < 8) { ss = row16_sum(ss); const float rs = rsqrtf(ss + EPS);
#pragma unroll
                for (int e = 0; e < 8; ++e) acc[e] *= rs; }
            if (x < xs + 32) { bf16_t* orow = QC + (rowbase + x) * DNQKV;
                if (cg < 8) {
                    const int cc = (ch0 & 31) >> 3; bf16_t* dst = orow + (ch0 & ~31) + 16 * (cc & 1) + 4 * (cc >> 1);
                    *(u32x2*)dst = (u32x2){pk2(acc[0], acc[1]), pk2(acc[2], acc[3])}; *(u32x2*)(dst + 8) = (u32x2){pk2(acc[4], acc[5]), pk2(acc[6], acc[7])}; }
                else *(u32x4*)(orow + ch0) = (u32x4){pk2(acc[0], acc[1]), pk2(acc[2], acc[3]), pk2(acc[4], acc[5]), pk2(acc[6], acc[7])}; }
        }
    }
#undef CV_CONV
#undef CV_LOAD
}
DI void dn_conv(const Params& P, const Frame& F, int rep) {
    const float* GA = WSP(float, WS_GATES); float* G2 = WSP(float, WS_G2); const int lane = F.lane;
    unsigned* ctr = WSP(unsigned, WS_CTL) + 64 + rep;
    for (;;) { unsigned t = 0; if (lane == 0) t = __hip_atomic_fetch_add(ctr, 1u, __ATOMIC_RELAXED, __HIP_MEMORY_SCOPE_AGENT); t = __builtin_amdgcn_readfirstlane(t);
        if (t >= 256u + 8192u) break;
        if (t < 256u) dn_conv_walk(P, (int)t >> 7, 1, 0, ((int)t >> 3) & 15, ((int)t & 7) * 32, lane);
        else { const int u = (int)t - 256; dn_conv_walk(P, u >> 12, 0, (u >> 5) & 127, (u >> 1) & 15, (u & 1) * 32, lane); } }
    for (int r = F.bid * 8 + F.wave; r < RR; r += F.G * 8) {
#pragma unroll
        for (int hh = 0; hh < 2; ++hh) { const int j = lane + 64 * hh; const float x = GA[(size_t)r * 128 + j]; float o;
            if (j < 64) o = sigmoidf_(x);
            else { const int dh = j - 64; const float y = x + P.in[I_ODDTB][dh]; const float sp = y > 20.f ? y : log1pf(__expf(y)); o = -__expf(P.in[I_ODALOG][dh]) * sp; }
            G2[(size_t)r * 128 + j] = o; }
    }
}
DI int dn_perm(int j) { return (j & ~31) + 8 * ((j & 15) >> 2) + 4 * ((j >> 4) & 1) + (j & 3); }
DI int dn_seq_to_chunk(int dir, int n) { return dir ? (n < 4 ? 3 - n : NCHUNK + 3 - n) : n; }
DI bf16x8 pp_pack(const f32x4& a, const f32x4& b) { return __builtin_bit_cast(bf16x8, (u32x4){pk2(a[0], a[1]), pk2(a[2], a[3]), pk2(b[0], b[1]), pk2(b[2], b[3])}); }
DI void dn_prep_variant(const Params& P, int vid, int lane) {
    const int chain = vid / NCHUNK, seq = vid % NCHUNK, dir = chain & 1, hv = (chain >> 1) & 31, b = chain >> 6, hqk = hv >> 1, c = dn_seq_to_chunk(dir, seq), l15 = lane & 15, q = lane >> 4;
    const size_t r0 = (size_t)b * TT + c * 64;
    const bf16_t* QC = WSP(bf16_t, WS_QKVC); const float* G2 = WSP(float, WS_G2);
    float gcs, bes;
    { const size_t rw = r0 + (dir ? 63 - lane : lane); const float g = G2[rw * 128 + 64 + dir * 32 + hv]; bes = G2[rw * 128 + dir * 32 + hv]; float inc = g;
#pragma unroll
      for (int o = 1; o < 64; o <<= 1) { const float v = __shfl_up(inc, o); if (lane >= o) inc += v; }
      gcs = inc; WSP(float, WS_GC)[(size_t)vid * 64 + lane] = inc; }
    float gcc[4], bec[4];
#pragma unroll
    for (int t = 0; t < 4; ++t) { gcc[t] = __shfl(gcs, 16 * t + l15); bec[t] = __shfl(bes, 16 * t + l15); }
    bf16x8 kf[4][4];
    {   bf16x8 qf[4][4];
#pragma unroll
        for (int t = 0; t < 4; ++t) { const int sr = 16 * t + l15; const unsigned ro = (((unsigned)r0 + (unsigned)(dir ? 63 - sr : sr)) * (unsigned)DNQKV + (unsigned)(hqk * 128 + 8 * q)) * 2u;
#pragma unroll
            for (int ks = 0; ks < 4; ++ks) { kf[t][ks] = *(const bf16x8*)((const char*)QC + ro + (unsigned)(DNQK + 32 * ks) * 2u); qf[t][ks] = *(const bf16x8*)((const char*)QC + ro + (unsigned)(32 * ks) * 2u); } }
        bf16_t* QM = WSP(bf16_t, WS_QKM) + (size_t)vid * 4096;
#pragma unroll
        for (int ja = 0; ja < 2; ++ja) { float gcrj[2][4];
#pragma unroll
            for (int h2 = 0; h2 < 2; ++h2)
#pragma unroll
                for (int r = 0; r < 4; ++r) gcrj[h2][r] = __shfl(gcs, 16 * (2 * ja + h2) + 4 * q + r);
#pragma unroll
            for (int it = 0; it < 4; ++it) { unsigned ow[4];
#pragma unroll
                for (int h2 = 0; h2 < 2; ++h2) { const int jt = 2 * ja + h2; f32x4 acc = {0, 0, 0, 0};
                    if (it >= jt) {
#pragma unroll
                        for (int ks = 0; ks < 4; ++ks) acc = mfma16(kf[jt][ks], qf[it][ks], acc); }
                    float o[4];
#pragma unroll
                    for (int r = 0; r < 4; ++r) { const int j = 16 * jt + 4 * q + r, i = 16 * it + l15; o[r] = (j <= i) ? 0.08838834764831845f * acc[r] * __expf(fminf(gcc[it] - gcrj[h2][r], 0.f)) : 0.f; }
                    ow[2 * h2] = pk2(o[0], o[1]); ow[2 * h2 + 1] = pk2(o[2], o[3]); }
                *(u32x4*)(QM + (16 * it + l15) * 64 + 32 * ja + 8 * q) = (u32x4){ow[0], ow[1], ow[2], ow[3]}; } }
    }
    f32x4 X[4][4], XT[4][4]; bf16x8 Mf[4][2];
#pragma unroll
    for (int rt = 0; rt < 4; ++rt) { float gcra[4], bera[4];
#pragma unroll
        for (int r = 0; r < 4; ++r) { gcra[r] = __shfl(gcs, 16 * rt + 4 * q + r); bera[r] = __shfl(bes, 16 * rt + 4 * q + r); }
#pragma unroll
        for (int ct = 0; ct < 4; ++ct) { f32x4 kk = {0, 0, 0, 0};
#pragma unroll
            for (int ks = 0; ks < 4; ++ks) kk = mfma16(kf[rt][ks], kf[ct][ks], kk);
#pragma unroll
            for (int r = 0; r < 4; ++r) { const int a = 16 * rt + 4 * q + r, bb = 16 * ct + l15;
                X[rt][ct][r] = (bb < a) ? -(bera[r] * kk[r] * __expf(fminf(gcra[r] - gcc[ct], 0.f))) : (a == bb ? 1.f : 0.f);
                XT[rt][ct][r] = (a < bb) ? -(bec[ct] * kk[r] * __expf(fminf(gcc[ct] - gcra[r], 0.f))) : (a == bb ? 1.f : 0.f); } } }
#pragma unroll
    for (int ib = 0; ib < 4; ++ib)
#pragma unroll
        for (int ks = 0; ks < 2; ++ks) { f32x4 m0, m1;
#pragma unroll
            for (int r = 0; r < 4; ++r) { m0[r] = ((16 * (2 * ks) + 4 * q + r) == (16 * ib + l15) ? 2.f : 0.f) - XT[2 * ks][ib][r]; m1[r] = ((16 * (2 * ks + 1) + 4 * q + r) == (16 * ib + l15) ? 2.f : 0.f) - XT[2 * ks + 1][ib][r]; }
            Mf[ib][ks] = pp_pack(m0, m1); }
#pragma unroll 1
    for (int it = 0; it < 5; ++it) {
        bf16x8 Xp[4][2], Xf[4][2], Qp[4][2];
#pragma unroll
        for (int t = 0; t < 4; ++t)
#pragma unroll
            for (int ks = 0; ks < 2; ++ks) { Xp[t][ks] = pp_pack(X[2 * ks][t], X[2 * ks + 1][t]); Xf[t][ks] = pp_pack(XT[2 * ks][t], XT[2 * ks + 1][t]); }
#pragma unroll
        for (int nt = 0; nt < 4; ++nt) { f32x4 qa[4];
#pragma unroll
            for (int ib = 0; ib < 4; ++ib) { f32x4 acc = {0, 0, 0, 0}; if (nt <= ib) { if (nt <= 1) acc = mfma16(Mf[ib][0], Xp[nt][0], acc); if (ib >= 2) acc = mfma16(Mf[ib][1], Xp[nt][1], acc); }
#pragma unroll
                for (int r = 0; r < 4; ++r) qa[ib][r] = ((16 * ib + 4 * q + r) == (16 * nt + l15) ? 2.f : 0.f) - acc[r]; }
            Qp[nt][0] = pp_pack(qa[0], qa[1]); Qp[nt][1] = pp_pack(qa[2], qa[3]); }
#pragma unroll
        for (int ib = 0; ib < 4; ++ib)
#pragma unroll
            for (int nt = 0; nt < 4; ++nt) { f32x4 a1 = {0, 0, 0, 0}, a2 = {0, 0, 0, 0};
                if (nt <= ib) {
                    if (nt <= 1) { a1 = mfma16(Xf[ib][0], Qp[nt][0], a1); a2 = mfma16(Qp[nt][0], Xf[ib][0], a2); }
                    if (ib >= 2) { a1 = mfma16(Xf[ib][1], Qp[nt][1], a1); a2 = mfma16(Qp[nt][1], Xf[ib][1], a2); } }
                X[ib][nt] = a1; XT[nt][ib] = a2; }
    }
    bf16_t* TM = WSP(bf16_t, WS_TM) + (size_t)vid * 4096;
#pragma unroll
    for (int na = 0; na < 2; ++na)
#pragma unroll
        for (int ib = 0; ib < 4; ++ib) *(u32x4*)(TM + (16 * ib + l15) * 64 + 32 * na + 8 * q) = (u32x4){pk2(XT[2 * na][ib][0], XT[2 * na][ib][1]), pk2(XT[2 * na][ib][2], XT[2 * na][ib][3]), pk2(XT[2 * na + 1][ib][0], XT[2 * na + 1][ib][1]), pk2(XT[2 * na + 1][ib][2], XT[2 * na + 1][ib][3])};
}
DI void dn_prep(const Params& P, const Frame& F) { for (int vid = F.wave * F.G + F.bid; vid < NB * 32 * 2 * NCHUNK; vid += F.G * 8) dn_prep_variant(P, vid, F.lane); }


constexpr int RC_K = 0, RC_Q = 17408, RC_V = 34816, RC_T = 44032, RC_QK = 53248, RC_SC = 62464, RC_STAGE = 63488;
struct RcG { u32x4 k[4], q[4], v[2], t[2], qk[2]; float be, gc, gcl; };
DI int rc_row(int b, int dir, int n, int s) { const int c = dn_seq_to_chunk(dir, n); return b * TT + c * 64 + (dir ? 63 - s : s); }
DI void rc_load(const Params& P, RcG& g, int b, int hv, int dir, int vhalf, int chain, int n, int ht) {
    const bf16_t* QC = WSP(bf16_t, WS_QKVC); const int hqk = hv >> 1;
#pragma unroll
    for (int i = 0; i < 4; ++i) { const int idx = ht + 256 * i, s = idx >> 4, ch = (idx & 15) * 8; const size_t r = rc_row(b, dir, n, s);
        g.k[i] = *(const u32x4*)(QC + r * DNQKV + DNQK + hqk * 128 + ch); g.q[i] = *(const u32x4*)(QC + r * DNQKV + hqk * 128 + ch); }
#pragma unroll
    for (int i = 0; i < 2; ++i) { const int idx = ht + 256 * i, s = idx >> 3, ch = (idx & 7) * 8; const size_t r = rc_row(b, dir, n, s);
        g.v[i] = *(const u32x4*)(QC + r * DNQKV + 2 * DNQK + hv * 128 + vhalf * 64 + ch); }
    const bf16_t* TM = WSP(bf16_t, WS_TM) + ((size_t)chain * NCHUNK + n) * 4096; const bf16_t* QM = WSP(bf16_t, WS_QKM) + ((size_t)chain * NCHUNK + n) * 4096;
#pragma unroll
    for (int i = 0; i < 2; ++i) { const int idx = ht + 256 * i; g.t[i] = *(const u32x4*)(TM + idx * 8); g.qk[i] = *(const u32x4*)(QM + idx * 8); }
#ifdef MK_PROBE_RCBW
    { u32x4 dk[4];
#pragma unroll
      for (int i = 0; i < 4; ++i) { const int idx = ht + 256 * i, s = idx >> 4, ch = (idx & 15) * 8; const size_t r = rc_row(b, dir, n, s); dk[i] = *(const u32x4*)(QC + r * DNQKV + 2 * DNQK + ((hv + 7) & 31) * 128 + ch); }
      asm volatile("" :: "v"(dk[0]), "v"(dk[1]), "v"(dk[2]), "v"(dk[3])); }
#endif
    { const int s = ht & 63; const float* gc = WSP(float, WS_GC) + ((size_t)chain * NCHUNK + n) * 64;
      g.be = WSP(float, WS_G2)[(size_t)rc_row(b, dir, n, s) * 128 + dir * 32 + hv]; g.gc = gc[s]; g.gcl = gc[63]; }
}
DI void rc_store(const RcG& g, LAS unsigned char* st, int ht) {
    LAS bf16_t* KL = (LAS bf16_t*)(st + RC_K); LAS bf16_t* QL = (LAS bf16_t*)(st + RC_Q); LAS bf16_t* VL = (LAS bf16_t*)(st + RC_V); LAS bf16_t* TL = (LAS bf16_t*)(st + RC_T); LAS bf16_t* QKL = (LAS bf16_t*)(st + RC_QK); LAS float* SC = (LAS float*)(st + RC_SC);
#pragma unroll
    for (int i = 0; i < 4; ++i) { const int idx = ht + 256 * i, s = idx >> 4, ch = (idx & 15) * 8; *(LAS u32x4*)(KL + s * 136 + ch) = g.k[i]; *(LAS u32x4*)(QL + s * 136 + ch) = g.q[i]; }
#pragma unroll
    for (int i = 0; i < 2; ++i) { const int idx = ht + 256 * i, s = idx >> 3, ch = (idx & 7) * 8; *(LAS u32x4*)(VL + s * 72 + ch) = g.v[i]; *(LAS u32x4*)(TL + s * 72 + ch) = g.t[i]; *(LAS u32x4*)(QKL + s * 72 + ch) = g.qk[i]; }
    if (ht < 64) { SC[ht] = g.be; SC[64 + ht] = __expf(g.gc); SC[128 + ht] = __expf(g.gcl - g.gc); if (ht == 0) SC[192] = __expf(g.gcl); }
#ifdef MK_PROBE_RCST2
    asm volatile("" ::: "memory");
#pragma unroll
    for (int i = 0; i < 4; ++i) { const int idx = ht + 256 * i, s = idx >> 4, ch = (idx & 15) * 8; *(LAS u32x4*)(KL + s * 136 + ch) = g.k[i]; *(LAS u32x4*)(QL + s * 136 + ch) = g.q[i]; }
#pragma unroll
    for (int i = 0; i < 2; ++i) { const int idx = ht + 256 * i, s = idx >> 3, ch = (idx & 7) * 8; *(LAS u32x4*)(VL + s * 72 + ch) = g.v[i]; *(LAS u32x4*)(TL + s * 72 + ch) = g.t[i]; *(LAS u32x4*)(QKL + s * 72 + ch) = g.qk[i]; }
#endif
}
DI bf16x8 rc_afrag(const LAS bf16_t* base, int ld, int row0, int k0, int lane) { return *(const LAS bf16x8*)(base + (row0 + (lane & 15)) * ld + k0 + 8 * (lane >> 4)); }
DI bf16x8 rc_afrag_tr(const LAS bf16_t* base, int ld, int mt, int k0, int lane) { const int g = lane >> 4, qq = (lane & 15) >> 2, pp = lane & 3; const LAS bf16_t* p = base + (k0 + 4 * g + qq) * ld + 32 * (mt >> 1) + 8 * pp + 4 * (mt & 1);
    const s16x4 a = __builtin_amdgcn_ds_read_tr16_b64_v4i16((LAS s16x4*)p), b = __builtin_amdgcn_ds_read_tr16_b64_v4i16((LAS s16x4*)(p + 16 * ld));
#ifdef MK_PROBE_TR2
    { const s16x4 a2 = __builtin_amdgcn_ds_read_tr16_b64_v4i16((LAS s16x4*)(p + 8)), b2 = __builtin_amdgcn_ds_read_tr16_b64_v4i16((LAS s16x4*)(p + 16 * ld + 8));
      asm volatile("" :: "v"(a2), "v"(b2)); }
#endif
    return (bf16x8){a[0], a[1], a[2], a[3], b[0], b[1], b[2], b[3]}; }
DI bf16x8 rc_pack(const f32x4& a, const f32x4& b) { return __builtin_bit_cast(bf16x8, (u32x4){pk2(a[0], a[1]), pk2(a[2], a[3]), pk2(b[0], b[1]), pk2(b[2], b[3])}); }
#define RC_BAR() asm volatile("s_waitcnt lgkmcnt(0)\n\ts_barrier" ::: "memory")
DI void dn_recur_unit(const Params& P, const Frame& F, int unit) {
    const int vhalf = unit & 1, chain = unit >> 1, dir = chain & 1, hv = (chain >> 1) & 31, b = chain >> 6, lane = F.lane, l15 = lane & 15, q = lane >> 4, w = F.wave;
    LAS unsigned char* lds = F.lds;
    __syncthreads();
    if (w >= 4) {
        const int ht = F.tid - 256; RcG g0, g1;
        rc_load(P, g0, b, hv, dir, vhalf, chain, 0, ht); rc_store(g0, lds, ht);
        rc_load(P, g0, b, hv, dir, vhalf, chain, 1, ht); rc_load(P, g1, b, hv, dir, vhalf, chain, 2, ht);
        RC_BAR();
#pragma unroll 1
        for (int n = 0; n < NCHUNK; n += 2) {
            rc_store(g0, lds + RC_STAGE, ht);
            rc_load(P, g0, b, hv, dir, vhalf, chain, n + 3 < NCHUNK ? n + 3 : NCHUNK - 1, ht);
            RC_BAR();
            rc_store(g1, lds, ht);
            rc_load(P, g1, b, hv, dir, vhalf, chain, n + 4 < NCHUNK ? n + 4 : NCHUNK - 1, ht);
            RC_BAR();
        }
    } else {
        __builtin_amdgcn_s_setprio(3);
        f32x4 S[8];
#pragma unroll
        for (int i = 0; i < 8; ++i) S[i] = (f32x4){0, 0, 0, 0};
        char* ODu = (char*)(WSP(bf16_t, WS_ODIR) + (size_t)dir * RR * DNV + hv * 128 + vhalf * 64 + 16 * w);
        RC_BAR();
#pragma unroll 1
        for (int n = 0; n < NCHUNK; ++n) {
            int lane = F.lane; asm volatile("" : "+v"(lane)); const int l15 = lane & 15, q = lane >> 4;
            const LAS unsigned char* st = lds + (n & 1) * RC_STAGE;
            const LAS bf16_t* KL = (const LAS bf16_t*)(st + RC_K); const LAS bf16_t* QL = (const LAS bf16_t*)(st + RC_Q); const LAS bf16_t* VL = (const LAS bf16_t*)(st + RC_V);
            const LAS bf16_t* TL = (const LAS bf16_t*)(st + RC_T); const LAS bf16_t* QKL = (const LAS bf16_t*)(st + RC_QK); const LAS float* SC = (const LAS float*)(st + RC_SC);
            f32x4 ks_[4], qs_[4];
#define RC_SCHED() __builtin_amdgcn_sched_barrier(0)
            bf16x8 fa[8], fb[8];
#pragma unroll
            for (int m = 0; m < 4; ++m) { fa[m] = rc_afrag(KL, 136, 16 * m, 0, lane); fa[4 + m] = rc_afrag(QL, 136, 16 * m, 0, lane); }
            RC_SCHED();
#pragma unroll
            for (int kk = 0; kk < 4; ++kk) {
                if (kk < 3) {
#pragma unroll
                    for (int m = 0; m < 4; ++m) { fb[m] = rc_afrag(KL, 136, 16 * m, 32 * (kk + 1), lane); fb[4 + m] = rc_afrag(QL, 136, 16 * m, 32 * (kk + 1), lane); } }
                else {
#pragma unroll
                    for (int m = 0; m < 4; ++m) { fb[m] = rc_afrag(TL, 72, 16 * m, 0, lane); if (m >= 2) fb[4 + m] = rc_afrag(TL, 72, 16 * m, 32, lane); } }
                const bf16x8 sb = rc_pack(S[2 * kk], S[2 * kk + 1]);
                RC_SCHED();
#pragma unroll
                for (int m = 0; m < 4; ++m) { ks_[m] = mfma16(fa[m], sb, kk == 0 ? (f32x4){0, 0, 0, 0} : ks_[m]); qs_[m] = mfma16(sb, fa[4 + m], kk == 0 ? (f32x4){0, 0, 0, 0} : qs_[m]); }
                RC_SCHED();
#pragma unroll
                for (int m = 0; m < 8; ++m) fa[m] = fb[m];
            }
            f32x4 rr_[4];
            {   const int gq = lane >> 4, qq = (lane & 15) >> 2, pp = lane & 3;
#pragma unroll
                for (int m = 0; m < 4; ++m) { fb[m] = rc_afrag(QKL, 72, 16 * m, 0, lane); if (m >= 2) fb[4 + m] = rc_afrag(QKL, 72, 16 * m, 32, lane); }
#pragma unroll
                for (int m = 0; m < 4; ++m) { const s16x4 vv = __builtin_amdgcn_ds_read_tr16_b64_v4i16((LAS s16x4*)(VL + (16 * m + 4 * gq + qq) * 72 + 16 * w + 4 * pp));
                    const f32x4 be = *(const LAS f32x4*)(SC + 16 * m + 4 * q), eg = *(const LAS f32x4*)(SC + 64 + 16 * m + 4 * q);
#pragma unroll
                    for (int e = 0; e < 4; ++e) rr_[m][e] = be[e] * (bf2f((unsigned short)vv[e]) - eg[e] * ks_[m][e]);
                    qs_[m] = qs_[m] * (SC[64 + 16 * m + l15] * 0.08838834764831845f); }
            }
            f32x4 vn[4];
            { const bf16x8 rb0 = rc_pack(rr_[0], rr_[1]), rb1 = rc_pack(rr_[2], rr_[3]);
              RC_SCHED();
#pragma unroll
              for (int m = 0; m < 4; ++m) { vn[m] = mfma16(fa[m], rb0, (f32x4){0, 0, 0, 0}); if (m >= 2) vn[m] = mfma16(fa[4 + m], rb1, vn[m]); }
              RC_SCHED(); }
#pragma unroll
            for (int mt = 0; mt < 4; ++mt) { fa[mt] = rc_afrag_tr(KL, 136, mt, 0, lane); fa[4 + mt] = rc_afrag_tr(KL, 136, mt, 32, lane); }
            { const bf16x8 vb0 = rc_pack(vn[0], vn[1]), vb1 = rc_pack(vn[2], vn[3]);
              RC_SCHED();
#pragma unroll
              for (int m = 0; m < 4; ++m) { qs_[m] = mfma16(vb0, fb[m], qs_[m]); if (m >= 2) qs_[m] = mfma16(vb1, fb[4 + m], qs_[m]); }
              RC_SCHED(); }
#pragma unroll
            for (int mt = 0; mt < 4; ++mt) { fb[mt] = rc_afrag_tr(KL, 136, 4 + mt, 0, lane); fb[4 + mt] = rc_afrag_tr(KL, 136, 4 + mt, 32, lane); }
#pragma unroll
            for (int m = 0; m < 4; ++m) vn[m] = vn[m] * *(const LAS f32x4*)(SC + 128 + 16 * m + 4 * q);
            const float gl = SC[192];
            const bf16x8 nb0 = rc_pack(vn[0], vn[1]), nb1 = rc_pack(vn[2], vn[3]);
#pragma unroll
            for (int mt = 0; mt < 8; ++mt) S[mt] = S[mt] * gl;
            RC_SCHED();
#pragma unroll
            for (int mt = 0; mt < 4; ++mt) { S[mt] = mfma16(fa[mt], nb0, S[mt]); S[mt] = mfma16(fa[4 + mt], nb1, S[mt]); }
            RC_SCHED();
            { const int cch = dn_seq_to_chunk(dir, n); char* obase = ODu + ((size_t)b * TT + cch * 64) * (DNV * 2);
#pragma unroll
              for (int m = 0; m < 4; ++m) { const int s = 16 * m + l15; *(u32x2*)(obase + (unsigned)((dir ? 63 - s : s) * (DNV * 2) + q * 8)) = (u32x2){pk2(qs_[m][0], qs_[m][1]), pk2(qs_[m][2], qs_[m][3])}; } }
            RC_SCHED();
#pragma unroll
            for (int mt = 0; mt < 4; ++mt) { S[4 + mt] = mfma16(fb[mt], nb0, S[4 + mt]); S[4 + mt] = mfma16(fb[4 + mt], nb1, S[4 + mt]); }
            RC_BAR();
        }
        __builtin_amdgcn_s_setprio(0);
    }
}
DI void dn_recur(const Params& P, const Frame& F) {
    for (int i = F.bid; i < 256; i += F.G) { int u = i;
        if (F.G == 256) { const int x = i & 7, j = i >> 3, grp = (j >> 2) * 8 + x, mem = j & 3, dir = grp & 1, bq = grp >> 1;
            const int hv = 2 * (bq & 15) + (mem >> 1), b = bq >> 4; u = (((b * 32 + hv) * 2 + dir) << 1) | (mem & 1); }
        dn_recur_unit(P, F, u); }
}
DI void dn_post(const Params& P, const Frame& F) {
    const bf16_t* OD = WSP(bf16_t, WS_ODIR); const bf16_t* PZ = WSP(bf16_t, WS_PZ); unsigned char* OC = WSP(unsigned char, WS_OCAT1); const int lane = F.lane;
    const int w0 = F.bid * 8 + F.wave, stride = F.G * 8, ntrip = w0 < NB * NLAT ? ((NB * NLAT - 1 - w0) / stride + 1) * 8 : 0;
    const f32x4 g0 = *(const f32x4*)(P.in[I_ODNG] + ((lane * 8) & 127)), g1 = *(const f32x4*)(P.in[I_ODNG] + ((lane * 8) & 127) + 4);
    u32x4 xa0, xc0, xz0, xa1, xc1, xz1, xa2, xc2, xz2;
#define DP_LOAD(t_, A_, C_, Z_) do { const int rr_ = w0 + ((t_) >> 3) * stride, b_ = rr_ / NLAT, tok_ = rr_ % NLAT; const size_t e_ = ((size_t)b_ * TT + LCTX + tok_) * DNV + (((t_) & 7) * 64 + lane) * 8; \
        A_ = *(const u32x4*)(OD + e_); C_ = *(const u32x4*)(OD + (size_t)RR * DNV + e_); Z_ = *(const u32x4*)(PZ + e_); } while (0)
    if (ntrip > 0) {
        int i0 = 0, i1 = 1 < ntrip ? 1 : ntrip - 1, i2 = 0;
        DP_LOAD(i0, xa0, xc0, xz0); DP_LOAD(i1, xa1, xc1, xz1);
#define DP_STEP(I_, A_, C_, Z_, NI_, NA_, NC_, NZ_, nidx_) do { NI_ = (nidx_) < ntrip ? (nidx_) : ntrip - 1; __builtin_amdgcn_sched_barrier(0); DP_LOAD(NI_, NA_, NC_, NZ_); __builtin_amdgcn_sched_barrier(0); \
        float a[8], c2[8], z[8]; cv8(A_, a); cv8(C_, c2); cv8(Z_, z); float ss = 0.f; \
        _Pragma("unroll") for (int j = 0; j < 8; ++j) { a[j] += c2[j]; ss += a[j] * a[j]; } \
        ss = row16_sum(ss); const float rs = rsqrtf(ss * (1.0f / 128.0f) + EPS); \
        _Pragma("unroll") for (int j = 0; j < 8; ++j) a[j] = a[j] * rs * (j < 4 ? g0[j & 3] : g1[j & 3]) * siluf_(z[j]); \
        const int rr = w0 + ((I_) >> 3) * stride; \
        *(u32x2*)(OC + (size_t)rr * DNV + (((I_) & 7) * 64 + lane) * 8) = (u32x2){cvt4_fp8(a[0], a[1], a[2], a[3]), cvt4_fp8(a[4], a[5], a[6], a[7])}; } while (0)
#pragma unroll 1
        for (int t = 0; t < ntrip; t += 3) {
            DP_STEP(i0, xa0, xc0, xz0, i2, xa2, xc2, xz2, t + 2);
            DP_STEP(i1, xa1, xc1, xz1, i0, xa0, xc0, xz0, t + 3);
            DP_STEP(i2, xa2, xc2, xz2, i1, xa1, xc1, xz1, t + 4);
        }
#undef DP_STEP
    }
#undef DP_LOAD
    l1w_from_queue(P, F, -1);
}
#ifndef MK_FUSED
#define MK_FUSED 1
#endif
#ifndef MK_LAST_PHASE
#define MK_LAST_PHASE 22
#endif
enum { PH_PRO = 0, PH_H0, PH_EVIN, PH_E2A, PH_E2B, PH_E2C, PH_EVOUT, PH_ROW0, PH_TOPK0, PH_GU0, PH_DN0, PH_COMB0, PH_ODIN, PH_CONV, PH_PREP, PH_REC, PH_POST, PH_ODOUT, PH_ROW1, PH_TOPK1, PH_GU1, PH_DN1, PH_COMB1, NPH_ALL };
constexpr int NPH = MK_LAST_PHASE + 1;

__global__ void __launch_bounds__(512, 2) fwd_kernel(Params P) {
    extern __shared__ __attribute__((aligned(16))) unsigned char shm[];
    Frame F; F.lds = (LAS unsigned char*)shm; F.tid = threadIdx.x; F.lane = F.tid & 63; F.wave = __builtin_amdgcn_readfirstlane(F.tid >> 6); F.G = gridDim.x; F.bid = blockIdx.x;
    volatile LAS unsigned* xbw = (volatile LAS unsigned*)(F.lds + LDS_MISC);
    if (F.tid < 4) xbw[F.tid] = 0u;
    __syncthreads();
    XcdBarrier bar; bar.bar = WSP(unsigned, WS_CTL) + 1024; bar.x = 0; bar.st = xbw;
    if (MK_FUSED) bar = xcd_barrier_post(WSP(unsigned, WS_CTL) + 1024, xbw);
    const int lo = P.ph_lo, hi = P.ph_hi;
#ifndef MK_ONLY
#define MK_ONLY -1
#endif
#define IN(k) ((MK_ONLY < 0 || (k) == MK_ONLY) && lo <= (k) && (k) < hi)
#ifndef MK_REPMASK
#define MK_REPMASK 0u
#endif
#ifndef MK_REPN
#define MK_REPN 2
#endif
#define NREP(k) (((MK_REPMASK >> (k)) & 1u) ? 1 + MK_REPN : 1)
#define SEAM(k) do { if (MK_FUSED && (IN((k) + 1) || rep + 1 < NREP(k))) xcd_barrier(bar); } while (0)
    if (IN(PH_PRO)) _Pragma("unroll") for (int rep = 0; rep < NREP(PH_PRO); ++rep) { p0_prologue(P, F, rep); SEAM(PH_PRO); }
    if (IN(PH_H0)) _Pragma("unroll") for (int rep = 0; rep < NREP(PH_H0); ++rep) { p1_hall0(P, F); SEAM(PH_H0); }
    if (IN(PH_EVIN)) _Pragma("unroll") for (int rep = 0; rep < NREP(PH_EVIN); ++rep) { pg8::Gemm g{WSP(bf16_t, WS_HA), WSP(bf16_t, WS_WEVIN), RR, EVIN, DM}; pg8::StaticOrder S; S.init(RR, EVIN, F.G, F.bid);
        pg8::EpiBf E{WSP(bf16_t, WS_P0), EVIN, 1.0f}; pg8::gemm_phase<pg8::EpiBf, pg8::StaticOrder>(F.lds, g, S, E); if ((int)F.bid >= (RR / 256 * (EVIN / 256)) % F.G) l1w_from_queue(P, F, 14); SEAM(PH_EVIN); }
    if (IN(PH_E2A)) _Pragma("unroll") for (int rep = 0; rep < NREP(PH_E2A); ++rep) { e2a(P, F, rep); SEAM(PH_E2A); }
    if (IN(PH_E2B)) _Pragma("unroll") for (int rep = 0; rep < NREP(PH_E2B); ++rep) { e2b(P, F); SEAM(PH_E2B); }
    if (IN(PH_E2C)) _Pragma("unroll") for (int rep = 0; rep < NREP(PH_E2C); ++rep) { e2c(P, F, rep); SEAM(PH_E2C); }
    if (IN(PH_EVOUT)) _Pragma("unroll") for (int rep = 0; rep < NREP(PH_EVOUT); ++rep) { pg8::Gemm g{WSP(bf16_t, WS_OCAT0), WSP(bf16_t, WS_WEVOUT), RR, DM, DM / 2}; pg8::StaticOrder S; S.init(RR, DM, F.G, F.bid);
        pg8::EpiBf E{WSP(bf16_t, WS_MIX), DM, 1.0f / W8_GU}; pg8::gemm_phase<pg8::EpiBf, pg8::StaticOrder, false, true>(F.lds, g, S, E); if ((int)F.bid >= (RR / 256 * (DM / 256)) % F.G) l1w_from_queue(P, F, 14); SEAM(PH_EVOUT); }
    if (IN(PH_ROW0)) _Pragma("unroll") for (int rep = 0; rep < NREP(PH_ROW0); ++rep) { row_post_mixer(P, F, 0); SEAM(PH_ROW0); }
    if (IN(PH_TOPK0)) _Pragma("unroll") for (int rep = 0; rep < NREP(PH_TOPK0); ++rep) { moe_topk(P, F, 0); SEAM(PH_TOPK0); }
    if (IN(PH_GU0)) _Pragma("unroll") for (int rep = 0; rep < NREP(PH_GU0); ++rep) { pg8::Gemm g{WSP(bf16_t, WS_HA8), WSP(bf16_t, WS_WGU), MOE_ROWS, 0, DM / 2}; pg8::MoeOrder S{F.G, F.bid, 128, WSP(unsigned, WS_VOFF)};
        pg8::EpiSwiGlu E{WSP(unsigned char, WS_HID), 1.0f / W8_GU}; pg8::gemm_phase<pg8::EpiSwiGlu, pg8::MoeOrder, true, true>(F.lds, g, S, E); if ((int)F.bid >= (1024 + 128) % F.G) l1w_from_queue(P, F, 7); SEAM(PH_GU0); }
    if (IN(PH_DN0)) _Pragma("unroll") for (int rep = 0; rep < NREP(PH_DN0); ++rep) { pg8::Gemm g{WSP(bf16_t, WS_HID), WSP(bf16_t, WS_WDN), MOE_ROWS, 0, EFF / 2}; pg8::MoeOrder S{F.G, F.bid, 128, nullptr};
        pg8::EpiDown E{WSP(bf16_t, WS_Y), WSP(float, WS_GATEV), 1.0f / W8_DN}; pg8::gemm_phase<pg8::EpiDown, pg8::MoeOrder, false, true>(F.lds, g, S, E); if ((int)F.bid >= (1024 + 128) % F.G) l1w_from_queue(P, F, 3); SEAM(PH_DN0); }
    if (IN(PH_COMB0)) _Pragma("unroll") for (int rep = 0; rep < NREP(PH_COMB0); ++rep) { moe_combine(P, F, 0); SEAM(PH_COMB0); }
    if (IN(PH_ODIN)) _Pragma("unroll") for (int rep = 0; rep < NREP(PH_ODIN); ++rep) {
        { pg8::Gemm g{WSP(bf16_t, WS_HA), WSP(bf16_t, WS_WODIN), RR, ODA_N, DM}; pg8::StaticOrder S; S.init(RR, ODA_N, F.G, F.bid);
          pg8::EpiOdA E{WSP(bf16_t, WS_PQ), WSP(float, WS_GATES)}; pg8::gemm_phase<pg8::EpiOdA, pg8::StaticOrder>(F.lds, g, S, E); }
        { pg8::Gemm g{WSP(bf16_t, WS_HA8B), WSP(bf16_t, WS_WODIN8), RR, ODB_N, DM / 2}; pg8::HeldOrder S; S.init(RR, ODB_N, F.G, F.G - 1 - F.bid);
          const int nbf = RR / 256 * (ODA_N / 256); S.nheld = (OD8_MODE == 3 && nbf < F.G) ? nbf : 0; S.r0 = S.nheld ? 11 : (1 << 20);
          pg8::EpiOdB E{WSP(bf16_t, WS_PQ), WSP(bf16_t, WS_PZ), 1.0f / W8_GU}; pg8::gemm_phase<pg8::EpiOdB, pg8::HeldOrder, false, true>(F.lds, g, S, E); }
        if (OD8_MODE == 3 ? ((int)F.bid >= 66 && (int)F.bid < 94) : (int)(F.G - 1 - F.bid) >= (RR / 256 * (ODB_N / 256)) % F.G) l1w_from_queue(P, F, 14); SEAM(PH_ODIN); }
    if (IN(PH_CONV)) _Pragma("unroll") for (int rep = 0; rep < NREP(PH_CONV); ++rep) { dn_conv(P, F, rep); SEAM(PH_CONV); }
    if (IN(PH_PREP)) _Pragma("unroll") for (int rep = 0; rep < NREP(PH_PREP); ++rep) { dn_prep(P, F); SEAM(PH_PREP); }
    if (IN(PH_REC)) _Pragma("unroll") for (int rep = 0; rep < NREP(PH_REC); ++rep) { dn_recur(P, F); SEAM(PH_REC); }
    if (IN(PH_POST)) _Pragma("unroll") for (int rep = 0; rep < NREP(PH_POST); ++rep) { dn_post(P, F); SEAM(PH_POST); }
    if (IN(PH_ODOUT)) _Pragma("unroll") for (int rep = 0; rep < NREP(PH_ODOUT); ++rep) { pg8::Gemm g{WSP(bf16_t, WS_OCAT1), WSP(bf16_t, WS_WODOUT), NB * NLAT, DM, DNV / 2}; pg8::StaticOrder S; S.init(NB * NLAT, DM, F.G, F.bid);
        pg8::EpiBf E{WSP(bf16_t, WS_MIX1), DM, 1.0f / W8_GU}; pg8::gemm_phase<pg8::EpiBf, pg8::StaticOrder, false, true>(F.lds, g, S, E); SEAM(PH_ODOUT); }
    if (IN(PH_ROW1)) _Pragma("unroll") for (int rep = 0; rep < NREP(PH_ROW1); ++rep) { row_post_mixer(P, F, 1); SEAM(PH_ROW1); }
    if (IN(PH_TOPK1)) _Pragma("unroll") for (int rep = 0; rep < NREP(PH_TOPK1); ++rep) { moe_topk(P, F, 1); SEAM(PH_TOPK1); }
    if (IN(PH_GU1)) _Pragma("unroll") for (int rep = 0; rep < NREP(PH_GU1); ++rep) { pg8::Gemm g{WSP(bf16_t, WS_HA8), WSP(bf16_t, WS_WGU1), MOE_ROWS, 0, DM / 2}; pg8::MoeOrder S{F.G, F.bid, 0, WSP(unsigned, WS_VOFF)};
        pg8::EpiSwiGlu E{WSP(unsigned char, WS_HID), 1.0f / W8_GU}; pg8::gemm_phase<pg8::EpiSwiGlu, pg8::MoeOrder, true, true>(F.lds, g, S, E); SEAM(PH_GU1); }
    if (IN(PH_DN1)) _Pragma("unroll") for (int rep = 0; rep < NREP(PH_DN1); ++rep) { pg8::Gemm g{WSP(bf16_t, WS_HID), WSP(bf16_t, WS_WDN1), MOE_ROWS, 0, EFF / 2}; pg8::MoeOrder S{F.G, F.bid, 0, nullptr};
        pg8::EpiDown E{WSP(bf16_t, WS_Y), WSP(float, WS_GATEV), 1.0f / W8_DN}; pg8::gemm_phase<pg8::EpiDown, pg8::MoeOrder, false, true>(F.lds, g, S, E); SEAM(PH_DN1); }
    if (IN(PH_COMB1)) _Pragma("unroll") for (int rep = 0; rep < NREP(PH_COMB1); ++rep) { moe_combine(P, F, 1); SEAM(PH_COMB1); }
#undef IN
#undef SEAM
}

extern "C" void kernel_launch(void* const* d_in, const int* in_sizes, int n_in, void* d_out, int out_size, void* d_ws, size_t ws_size, hipStream_t stream) {
    static int grid = 0;
    if (grid == 0) {
        if (n_in != 31 || out_size != NB * NLAT * DM || ws_size < WS_END) { fprintf(stderr, "kernel_launch: unexpected shapes (n_in %d, out %d, ws %zu < %zu); nothing launched\n", n_in, out_size, ws_size, (size_t)WS_END); grid = -1; return; }
        int dev = 0, cus = 0, per_cu = 0;
        if (hipGetDevice(&dev) != hipSuccess || hipDeviceGetAttribute(&cus, hipDeviceAttributeMultiprocessorCount, dev) != hipSuccess) { grid = -1; return; }
        if (hipFuncSetAttribute((const void*)fwd_kernel, hipFuncAttributeMaxDynamicSharedMemorySize, LDS_BYTES) != hipSuccess) { fprintf(stderr, "kernel_launch: hipFuncSetAttribute failed\n"); grid = -1; return; }
        if (hipOccupancyMaxActiveBlocksPerMultiprocessor(&per_cu, (const void*)fwd_kernel, 512, LDS_BYTES) != hipSuccess || per_cu < 1) { fprintf(stderr, "kernel_launch: occupancy query reports %d\n", per_cu); (void)hipGetLastError(); grid = -1; return; }
        grid = cus;
    }
    if (grid < 0) return;
    if (hipMemsetAsync((char*)d_ws + WS_CTL, 0, CTL_ZERO_BYTES, stream) != hipSuccess) return;
    Params p{};
    for (int i = 0; i < 31; ++i) p.in[i] = (const float*)d_in[i];
    p.out = (float*)d_out; p.ws = (unsigned char*)d_ws;
#if MK_FUSED
    p.ph_lo = 0; p.ph_hi = NPH;
    hipLaunchKernelGGL(fwd_kernel, dim3(grid), dim3(512), LDS_BYTES, stream, p);
#else
    for (int k = 0; k < NPH; ++k) { p.ph_lo = k; p.ph_hi = k + 1; hipLaunchKernelGGL(fwd_kernel, dim3(grid), dim3(512), LDS_BYTES, stream, p); }
#endif
}
```
